# Optimizing an MI355X kernel written in HIP

```python
import functools
import jax, jax.numpy as jnp
from jax import lax
import numpy as np

D_MODEL = 4096
BATCH = 4
SEQ = 2048
DEPTH = 2
DEC_BATCH = 32
DEC_SEQ = 1
PAST_LEN = 16384
PAGE_SIZE = 128

EPS = 1e-6
SWA_HD = 64
SWA_HQ = (D_MODEL // 2) // SWA_HD
SWA_KV = SWA_HQ // 8
SWA_G = SWA_HQ // SWA_KV
SWA_W = SWA_HQ * SWA_HD
SWA_KVW = SWA_KV * SWA_HD
WINDOW = 128
ROPE_THETA = 10000.0
GLA_H = 4
GLA_W = D_MODEL // 4
GLA_DV = GLA_W // GLA_H
GLA_DK = GLA_DV // 2
GLA_KW = GLA_H * GLA_DK
GLA_RANK = 16
GLA_TAU = 16.0
GLA_CHUNK = 64
MEM_LEN = 256
MEM_H = 4
MEM_W = D_MODEL // 4
MEM_HD = MEM_W // MEM_H
IN_SIZES = (SWA_W, SWA_KVW, SWA_KVW, SWA_W, GLA_KW, GLA_KW, GLA_W, GLA_RANK, GLA_W, MEM_W, MEM_W)
N_IN = int(sum(IN_SIZES))
SPLIT_IDX = [int(i) for i in np.cumsum(IN_SIZES)[:-1]]

kernel_name = "hybrid_swa_sink_gla_memxattn_step"


def rmsnorm(x, g):
    xf = x.astype(jnp.float32)
    y = xf * lax.rsqrt(jnp.mean(xf * xf, axis=-1, keepdims=True) + EPS)
    return (y * g.astype(jnp.float32)).astype(x.dtype)


def rope(x, pos):
    half = x.shape[-1] // 2
    inv = ROPE_THETA ** (-jnp.arange(half, dtype=jnp.float32) / half)
    ang = pos.astype(jnp.float32)[:, None] * inv[None, :]
    cos, sin = jnp.cos(ang)[:, None, :], jnp.sin(ang)[:, None, :]
    xf = x.astype(jnp.float32)
    x1, x2 = xf[..., :half], xf[..., half:]
    return jnp.concatenate([x1 * cos - x2 * sin, x2 * cos + x1 * sin], axis=-1).astype(x.dtype)


def sink_softmax(s, mask, sinks):
    sk = sinks.astype(jnp.float32).reshape(SWA_KV, SWA_G, 1, 1)
    s = jnp.where(mask, s, -jnp.inf)
    m = jnp.maximum(jnp.max(s, axis=-1, keepdims=True), sk)
    p = jnp.exp(s - m)
    return p / (jnp.sum(p, axis=-1, keepdims=True) + jnp.exp(sk - m))


def swa_prompt(q, k, v, sinks):
    B, T = q.shape[:2]
    nb = T // WINDOW
    qb = q.reshape(B, nb, WINDOW, SWA_KV, SWA_G, SWA_HD)

    def band(t):
        tb = t.reshape(B, nb, WINDOW, SWA_KV, SWA_HD)
        prev = jnp.concatenate([jnp.zeros_like(tb[:, :1]), tb[:, :-1]], axis=1)
        return jnp.concatenate([prev, tb], axis=2)

    kw, vw = band(k), band(v)
    s = jnp.einsum('bnqkgd,bnskd->bnkgqs', qb, kw).astype(jnp.float32) * (SWA_HD ** -0.5)
    qi = jnp.arange(WINDOW)[:, None]
    sj = jnp.arange(2 * WINDOW)[None, :]
    diff = qi + WINDOW - sj
    blk = jnp.arange(nb)[:, None, None]
    mask = (diff >= 0) & (diff < WINDOW) & ((blk > 0) | (sj >= WINDOW))
    p = sink_softmax(s, mask[:, None, None], sinks)
    o = jnp.einsum('bnkgqs,bnskd->bnqkgd', p.astype(vw.dtype), vw).reshape(B, T, SWA_W)
    return o, k[:, T - WINDOW:], v[:, T - WINDOW:]


def swa_sample(q, k, v, sinks, kbuf, vbuf):
    B, T = q.shape[:2]
    WB = kbuf.shape[1]
    kall = jnp.concatenate([kbuf, k.astype(kbuf.dtype)], axis=1)
    vall = jnp.concatenate([vbuf, v.astype(vbuf.dtype)], axis=1)
    qpos = PAST_LEN + jnp.arange(T)
    kpos = PAST_LEN - WB + jnp.arange(WB + T)
    d = qpos[:, None] - kpos[None, :]
    mask = (d >= 0) & (d < WINDOW)
    qg = q.reshape(B, T, SWA_KV, SWA_G, SWA_HD)
    s = jnp.einsum('btkgd,bskd->bkgts', qg, kall.astype(q.dtype)).astype(jnp.float32) * (SWA_HD ** -0.5)
    p = sink_softmax(s, mask, sinks)
    o = jnp.einsum('bkgts,bskd->btkgd', p.astype(q.dtype), vall.astype(q.dtype)).reshape(B, T, SWA_W)
    return o, kall[:, -WB:], vall[:, -WB:]


def gla(q, k, v, g, s0):
    B, T = q.shape[:2]
    C = GLA_CHUNK if T >= GLA_CHUNK else T
    pad = (-T) % C
    n = (T + pad) // C

    def prep(t):
        t = jnp.pad(t.astype(jnp.float32), ((0, 0), (0, pad), (0, 0), (0, 0)))
        return jnp.moveaxis(t.reshape(B, n, C, *t.shape[2:]), 1, 0)

    qs, ks, vs, gs = prep(q * (GLA_DK ** -0.5)), prep(k), prep(v), prep(g)
    tri = jnp.tril(jnp.ones((C, C), dtype=bool))[None, :, :, None, None]

    def step(S, inp):
        qc, kc, vc, gc = inp
        b = jnp.cumsum(gc, axis=1)
        o_inter = jnp.einsum('bihk,bhkv->bihv', qc * jnp.exp(b), S)
        decay = jnp.exp(jnp.where(tri, b[:, :, None] - b[:, None, :], -jnp.inf))
        a = jnp.einsum('bihk,bjhk,bijhk->bijh', qc, kc, decay)
        o_intra = jnp.einsum('bijh,bjhv->bihv', a, vc)
        bl = b[:, -1]
        S = S * jnp.exp(bl)[..., None] + jnp.einsum('bjhk,bjhv->bhkv', kc * jnp.exp(bl[:, None] - b), vc)
        return S, o_inter + o_intra

    S, o = lax.scan(step, s0.astype(jnp.float32), (qs, ks, vs, gs))
    o = jnp.moveaxis(o, 0, 1).reshape(B, n * C, GLA_H, GLA_DV)[:, :T]
    return o, S.astype(s0.dtype)


def mem_kv(mem, g, w):
    B, M, _ = mem.shape
    h = rmsnorm(mem, g) @ w
    mk, mv = jnp.split(h, 2, axis=-1)
    return mk.reshape(B, M, MEM_H, MEM_HD), mv.reshape(B, M, MEM_H, MEM_HD)


def mem_attn(q, mk, mv):
    B, T = q.shape[:2]
    s = jnp.einsum('bthd,bmhd->bhtm', q, mk.astype(q.dtype)).astype(jnp.float32) * (MEM_HD ** -0.5)
    p = jax.nn.softmax(s, axis=-1)
    return jnp.einsum('bhtm,bmhd->bthd', p.astype(q.dtype), mv.astype(q.dtype)).reshape(B, T, MEM_W)


def mixer_layer(x, pos, mk, mv, swa_fn, gla_s0, norm_g, w_in, sinks, gla_w_gate, gla_b_gate, gla_norm_g, w_out):
    B, T, _ = x.shape
    h = rmsnorm(x, norm_g) @ w_in
    sq, sk, sv, sgate, gq, gk, gv, glr, ggate, mq, mgate = jnp.split(h, SPLIT_IDX, axis=-1)
    sq = rope(sq.reshape(B, T, SWA_HQ, SWA_HD), pos)
    sk = rope(sk.reshape(B, T, SWA_KV, SWA_HD), pos)
    sv = sv.reshape(B, T, SWA_KV, SWA_HD)
    o_swa, kbuf, vbuf = swa_fn(sq, sk, sv, sinks)
    glog = jax.nn.log_sigmoid((glr @ gla_w_gate + gla_b_gate).astype(jnp.float32)) / GLA_TAU
    o_gla, S = gla(gq.reshape(B, T, GLA_H, GLA_DK), gk.reshape(B, T, GLA_H, GLA_DK),
                   gv.reshape(B, T, GLA_H, GLA_DV), glog.reshape(B, T, GLA_H, GLA_DK), gla_s0)
    o_gla = rmsnorm(o_gla.astype(x.dtype), gla_norm_g.reshape(GLA_H, GLA_DV)).reshape(B, T, GLA_W)
    o_mem = mem_attn(mq.reshape(B, T, MEM_H, MEM_HD), mk, mv)
    y = jnp.concatenate([o_swa * jax.nn.silu(sgate), o_gla * jax.nn.silu(ggate),
                         o_mem * jax.nn.silu(mgate)], axis=-1) @ w_out
    return x + y, kbuf, vbuf, S


def setup_inputs(seed: int = 0) -> dict:
    key = jax.random.key(seed)
    ks = jax.random.split(key, 20)
    f32 = jnp.float32
    nrm = lambda k, shape, sc: jax.random.normal(k, shape, f32) * sc
    wb = min(WINDOW, PAST_LEN)
    return {
        "x_prompt": nrm(ks[0], (BATCH, SEQ, D_MODEL), 1.0),
        "mem_prompt": nrm(ks[1], (BATCH, MEM_LEN, D_MODEL), 1.0),
        "x_sample": nrm(ks[2], (DEC_BATCH, DEC_SEQ, D_MODEL), 1.0),
        "cache_swa_k": nrm(ks[3], (DEPTH, DEC_BATCH, wb, SWA_KV, SWA_HD), 1.0),
        "cache_swa_v": nrm(ks[4], (DEPTH, DEC_BATCH, wb, SWA_KV, SWA_HD), 1.0),
        "state_gla": nrm(ks[5], (DEPTH, DEC_BATCH, GLA_H, GLA_DK, GLA_DV), 0.3),
        "cache_mem_k": nrm(ks[6], (DEPTH, DEC_BATCH, MEM_LEN, MEM_H, MEM_HD), 1.0),
        "cache_mem_v": nrm(ks[7], (DEPTH, DEC_BATCH, MEM_LEN, MEM_H, MEM_HD), 1.0),
        "norm_g": 1.0 + nrm(ks[8], (DEPTH, D_MODEL), 0.02),
        "w_in": nrm(ks[9], (DEPTH, D_MODEL, N_IN), D_MODEL ** -0.5),
        "attn_sinks": nrm(ks[10], (DEPTH, SWA_HQ), 0.5),
        "gla_w_gate": nrm(ks[11], (DEPTH, GLA_RANK, GLA_KW), GLA_RANK ** -0.5),
        "gla_b_gate": nrm(ks[12], (DEPTH, GLA_KW), 0.1),
        "gla_norm_g": 1.0 + nrm(ks[13], (DEPTH, GLA_W), 0.02),
        "mem_norm_g": 1.0 + nrm(ks[14], (DEPTH, D_MODEL), 0.02),
        "w_mem_kv": nrm(ks[15], (DEPTH, D_MODEL, 2 * MEM_W), D_MODEL ** -0.5),
        "w_out": nrm(ks[16], (DEPTH, D_MODEL, D_MODEL), D_MODEL ** -0.5),
        "final_norm_g": 1.0 + nrm(ks[17], (D_MODEL,), 0.02),
    }


def reference(x_prompt, mem_prompt, x_sample, cache_swa_k, cache_swa_v, state_gla, cache_mem_k, cache_mem_v,
              norm_g, w_in, attn_sinks, gla_w_gate, gla_b_gate, gla_norm_g, mem_norm_g, w_mem_kv, w_out,
              final_norm_g):
    B, T = x_prompt.shape[:2]
    Bd, Td = x_sample.shape[:2]
    pos_p = jnp.arange(T)
    pos_s = PAST_LEN + jnp.arange(Td)
    xp, xs = x_prompt, x_sample
    kp_l, vp_l, sp_l, mkp_l, mvp_l, ks_l, vs_l, ss_l = [], [], [], [], [], [], [], []
    for l in range(DEPTH):
        lw = (norm_g[l], w_in[l], attn_sinks[l], gla_w_gate[l], gla_b_gate[l], gla_norm_g[l], w_out[l])
        mk_p, mv_p = mem_kv(mem_prompt, mem_norm_g[l], w_mem_kv[l])
        s0_p = jnp.zeros((B, GLA_H, GLA_DK, GLA_DV), xp.dtype)
        xp, kb, vb, Sp = mixer_layer(xp, pos_p, mk_p, mv_p, swa_prompt, s0_p, *lw)
        swa_s = functools.partial(swa_sample, kbuf=cache_swa_k[l], vbuf=cache_swa_v[l])
        xs, kbs, vbs, Ss = mixer_layer(xs, pos_s, cache_mem_k[l], cache_mem_v[l], swa_s, state_gla[l], *lw)
        kp_l.append(kb); vp_l.append(vb); sp_l.append(Sp); mkp_l.append(mk_p); mvp_l.append(mv_p)
        ks_l.append(kbs); vs_l.append(vbs); ss_l.append(Ss)
    y_prompt = rmsnorm(xp, final_norm_g)
    y_sample = rmsnorm(xs, final_norm_g)
    return (y_prompt, y_sample, jnp.stack(kp_l), jnp.stack(vp_l), jnp.stack(sp_l), jnp.stack(mkp_l),
            jnp.stack(mvp_l), jnp.stack(ks_l), jnp.stack(vs_l), jnp.stack(ss_l))
```

```cpp
#include <hip/hip_runtime.h>
#include <hip/hip_cooperative_groups.h>
#include <cstdio>
#include <cstdint>
namespace cg = cooperative_groups;
#define MK_ONE_LAUNCH 1
namespace pg8 {
#define PG8_LAS __attribute__((address_space(3)))
typedef unsigned short bf16_t;
typedef short bf16x8 __attribute__((ext_vector_type(8)));
typedef float f32x4 __attribute__((ext_vector_type(4)));
typedef unsigned u32x4 __attribute__((ext_vector_type(4)));
constexpr int BM = 256, BK = 64, HALF = 128, HTB = HALF * BK * 2  , STAGE_BYTES = 8 * HTB, NXCD = 8, WGM = 8;

__host__ __device__ __forceinline__ int lds_byte(int r, int c) { const int st = (r >> 4) * 2 + (c >> 5), rr = r & 15, cc = c & 31, ob = rr * 64 + cc * 2; return st * 1024 + (ob ^ (((ob >> 9) & 1) << 5)); }
__host__ __device__ __forceinline__ void stage_rc(int b, int& R, int& C) { const int st = b / 1024, sb = b % 1024, swz = sb ^ (((sb >> 9) & 1) << 5); R = (st >> 1) * 16 + swz / 64; C = (st & 1) * 32 + (swz % 64) / 2; }
__host__ __device__ __forceinline__ int perm32(int rho) { const int n = rho >> 4, i = rho & 15; return 8 * (i >> 2) + 4 * n + (i & 3); }

struct Unit { int pm, pn; };
struct Gemm { const bf16_t* A; const bf16_t* Bt; int M, N, K; };

struct StaticOrder {
    int nM, nN, nwg, G, c;
    __host__ __device__ void init(int M, int N, int G_, int c_) { nM = M / BM; nN = N / BM; nwg = nM * nN; G = G_; c = c_; }
    __host__ __device__ bool next(int i, Unit& u) const {
        const long L = (long)i * G + c; if (L >= nwg) return false;
        int wgid = (int)L; { const int q = nwg / NXCD, r = nwg % NXCD, xcd = wgid % NXCD, off = wgid / NXCD; wgid = (xcd < r ? xcd * (q + 1) : r * (q + 1) + (xcd - r) * q) + off; }
        const int nig = WGM * nN, gid = wgid / nig, fm = gid * WGM, gsz = (nM - fm) < WGM ? (nM - fm) : WGM;
        u.pm = fm + ((wgid % nig) % gsz); u.pn = (wgid % nig) / gsz; return true;
    }
    __device__ __forceinline__ void a_ready(const Unit&) const {}
    __device__ __forceinline__ void done(const Unit&) const {}
};

__device__ __forceinline__ unsigned cvt_pk_bf16(float lo, float hi) { unsigned r; asm volatile("v_cvt_pk_bf16_f32 %0, %1, %2" : "=v"(r) : "v"(lo), "v"(hi)); return r; }
typedef float f32x2 __attribute__((ext_vector_type(2)));
template <class Epi, class Sched, bool ALIGN_EPI = false, bool SP2 = false>
__device__ __forceinline__ void gemm_phase(PG8_LAS unsigned char* lds, const Gemm g, const Sched& S, const Epi& E) {
    int tid_ = threadIdx.x; asm volatile("" : "+v"(tid_));
    const int tid = tid_, wid = __builtin_amdgcn_readfirstlane(tid >> 6), lane = tid & 63, wr = wid >> 2, wc = wid & 3, fr = lane & 15, fq = lane >> 4;
    const int K = g.K, nt = K / BK;
    unsigned voffA[2], voffB[2];
#pragma unroll
    for (int i = 0; i < 2; ++i) { int R, C; stage_rc(tid * 16 + i * 8192, R, C); const int Rb = Epi::PERM ? ((R & ~31) + perm32(R & 31)) : R;
        voffA[i] = (unsigned)(R * K + C) * 2u; voffB[i] = (unsigned)(Rb * K + C) * 2u; }
    const size_t kstep = (size_t)(BK * 2);
    const size_t hstep = (size_t)HALF * K * 2;
    const size_t tstep = 2 * hstep;
    const unsigned ldsw = (unsigned)wid * 1024u;
    const int aoff = lds_byte(wr * 64 + fr, fq * 8), boff = lds_byte(wc * 32 + fr, fq * 8);
#define PG8_SA(b, h) (((b) * 2 + (h)) * HTB)
#define PG8_SB(b, h) ((4 + (b) * 2 + (h)) * HTB)
#define PG8_STAGE(bufoff, gbase, voff) do { _Pragma("unroll") for (int _i = 0; _i < 2; ++_i) \
        __builtin_amdgcn_global_load_lds((const unsigned*)((const char*)(gbase) + (voff)[_i]), (PG8_LAS unsigned*)(lds + (bufoff) + ldsw + _i * 8192), 16, 0, 0); } while (0)
#define PG8_LDA(dst, b, h) do { _Pragma("unroll") for (int m = 0; m < 4; ++m) _Pragma("unroll") for (int k = 0; k < 2; ++k) dst[m][k] = *(const PG8_LAS bf16x8*)(lds + PG8_SA(b, h) + aoff + m * 2048 + k * 1024); } while (0)
#define PG8_LDB(dst, b, h) do { _Pragma("unroll") for (int n = 0; n < 2; ++n) _Pragma("unroll") for (int k = 0; k < 2; ++k) dst[n][k] = *(const PG8_LAS bf16x8*)(lds + PG8_SB(b, h) + boff + n * 2048 + k * 1024); } while (0)
#define PG8_MMA(ai, bj, At, Bt) do { __builtin_amdgcn_s_setprio(1); _Pragma("unroll") for (int m = 0; m < 4; ++m) _Pragma("unroll") for (int n = 0; n < 2; ++n) _Pragma("unroll") for (int k = 0; k < 2; ++k) \
        acc[ai][bj][m][n] = __builtin_amdgcn_mfma_f32_16x16x32_bf16(Bt[n][k], At[m][k], acc[ai][bj][m][n], 0, 0, 0); __builtin_amdgcn_s_setprio(0); } while (0)
#define PG8_WAIT_V(n) asm volatile("s_waitcnt vmcnt(" #n ")" ::: "memory")
#define PG8_WAIT_L(n) asm volatile("s_waitcnt lgkmcnt(" #n ")" ::: "memory")
#define PG8_BAR __builtin_amdgcn_s_barrier()
#define PG8_SCHED __builtin_amdgcn_sched_barrier(0)
    Unit cur, nxt; int ui = 0;
    if (!S.next(0, cur)) return;
    f32x4 acc[2][2][4][2];
#pragma unroll
    for (int a = 0; a < 2; ++a)
#pragma unroll
        for (int b = 0; b < 2; ++b)
#pragma unroll
            for (int m = 0; m < 4; ++m)
#pragma unroll
                for (int n = 0; n < 2; ++n) acc[a][b][m][n] = (f32x4){0.f, 0.f, 0.f, 0.f};
    bf16x8 At[4][2], B0[2][2], B1[2][2];
    const char* cA = (const char*)g.A + (size_t)cur.pm * tstep; const char* cB = (const char*)g.Bt + (size_t)cur.pn * tstep;
    S.a_ready(cur);
    if constexpr (SP2) {
        PG8_STAGE(PG8_SB(0, 0), cB, voffB); PG8_STAGE(PG8_SB(0, 1), cB + hstep, voffB); PG8_STAGE(PG8_SA(0, 0), cA, voffA); PG8_STAGE(PG8_SA(0, 1), cA + hstep, voffA);
        if (wr == 1) PG8_BAR;
        PG8_WAIT_V(2); PG8_BAR;
        PG8_STAGE(PG8_SB(1, 0), cB + kstep, voffB); PG8_STAGE(PG8_SA(1, 0), cA + kstep, voffA); PG8_STAGE(PG8_SB(1, 1), cB + hstep + kstep, voffB);
        PG8_WAIT_V(6); PG8_BAR;
    } else {
        PG8_STAGE(PG8_SB(0, 0), cB, voffB); PG8_STAGE(PG8_SA(0, 0), cA, voffA); PG8_STAGE(PG8_SB(0, 1), cB + hstep, voffB); PG8_STAGE(PG8_SA(0, 1), cA + hstep, voffA);
        if (wr == 1) PG8_BAR;
        PG8_WAIT_V(4); PG8_BAR;
        PG8_STAGE(PG8_SB(1, 0), cB + kstep, voffB); PG8_STAGE(PG8_SA(1, 0), cA + kstep, voffA); PG8_STAGE(PG8_SB(1, 1), cB + hstep + kstep, voffB);
        PG8_WAIT_V(6); PG8_BAR;
    }
    for (;;) {
        const bool has_next = S.next(ui + 1, nxt);
        const char* nA = has_next ? (const char*)g.A + (size_t)nxt.pm * tstep : cA; const char* nB = has_next ? (const char*)g.Bt + (size_t)nxt.pn * tstep : cB;
        for (int t = 0; t < nt; t += 2) {
            const bool last = (t == nt - 2);
            const char* a1 = cA + (size_t)(t + 1) * kstep;
            const char* a2 = last ? nA : cA + (size_t)(t + 2) * kstep; const char* b2 = last ? nB : cB + (size_t)(t + 2) * kstep;
            const char* a3 = a2 + kstep; const char* b3 = b2 + kstep;
            if (last && has_next) S.a_ready(nxt);
            if constexpr (SP2) {
            PG8_LDB(B0, 0, 0); PG8_LDB(B1, 0, 1); PG8_SCHED; PG8_LDA(At, 0, 0); PG8_STAGE(PG8_SA(1, 1), a1 + hstep, voffA);
            PG8_WAIT_V(8); PG8_WAIT_L(0); PG8_BAR; PG8_MMA(0, 0, At, B0); PG8_MMA(0, 1, At, B1); PG8_BAR; PG8_SCHED;
            PG8_LDA(At, 0, 1); PG8_STAGE(PG8_SB(0, 0), b2, voffB); PG8_STAGE(PG8_SB(0, 1), b2 + hstep, voffB); PG8_STAGE(PG8_SA(0, 0), a2, voffA);
            PG8_WAIT_V(8); PG8_WAIT_L(0); PG8_BAR; PG8_MMA(1, 0, At, B0); PG8_MMA(1, 1, At, B1); PG8_BAR; PG8_SCHED;
            PG8_LDB(B0, 1, 0); PG8_LDB(B1, 1, 1); PG8_SCHED; PG8_LDA(At, 1, 0); PG8_STAGE(PG8_SA(0, 1), a2 + hstep, voffA);
            PG8_WAIT_V(8); PG8_WAIT_L(0); PG8_BAR; PG8_MMA(0, 0, At, B0); PG8_MMA(0, 1, At, B1); PG8_BAR; PG8_SCHED;
            PG8_LDA(At, 1, 1); PG8_STAGE(PG8_SB(1, 0), b3, voffB); PG8_STAGE(PG8_SB(1, 1), b3 + hstep, voffB); PG8_STAGE(PG8_SA(1, 0), a3, voffA);
            PG8_WAIT_V(8); PG8_WAIT_L(0); PG8_BAR; PG8_MMA(1, 0, At, B0); PG8_MMA(1, 1, At, B1); PG8_BAR; PG8_SCHED;
            } else {
            PG8_LDB(B0, 0, 0); PG8_SCHED; PG8_LDA(At, 0, 0); PG8_STAGE(PG8_SA(1, 1), a1 + hstep, voffA);
            PG8_WAIT_L(8); PG8_BAR; PG8_WAIT_L(0); PG8_MMA(0, 0, At, B0); PG8_BAR; PG8_SCHED;
            PG8_LDB(B1, 0, 1); PG8_STAGE(PG8_SB(0, 0), b2, voffB);
            PG8_BAR; PG8_WAIT_L(0); PG8_MMA(0, 1, At, B1); PG8_BAR;
            PG8_LDA(At, 0, 1); PG8_STAGE(PG8_SA(0, 0), a2, voffA);
            PG8_BAR; PG8_WAIT_L(0); PG8_MMA(1, 0, At, B0); PG8_BAR; PG8_SCHED;
            PG8_STAGE(PG8_SB(0, 1), b2 + hstep, voffB);
            PG8_WAIT_V(6); PG8_BAR; PG8_MMA(1, 1, At, B1); PG8_BAR;
            PG8_LDB(B0, 1, 0); PG8_SCHED; PG8_LDA(At, 1, 0); PG8_STAGE(PG8_SA(0, 1), a2 + hstep, voffA);
            PG8_WAIT_L(8); PG8_BAR; PG8_WAIT_L(0); PG8_MMA(0, 0, At, B0); PG8_BAR; PG8_SCHED;
            PG8_LDB(B1, 1, 1); PG8_STAGE(PG8_SB(1, 0), b3, voffB);
            PG8_BAR; PG8_WAIT_L(0); PG8_MMA(0, 1, At, B1); PG8_BAR;
            PG8_LDA(At, 1, 1); PG8_STAGE(PG8_SA(1, 0), a3, voffA);
            PG8_BAR; PG8_WAIT_L(0); PG8_MMA(1, 0, At, B0); PG8_BAR; PG8_SCHED;
            PG8_STAGE(PG8_SB(1, 1), b3 + hstep, voffB);
            PG8_WAIT_V(6); PG8_BAR; PG8_MMA(1, 1, At, B1); PG8_BAR;
            }
        }
        if constexpr (ALIGN_EPI) { if (wr == 0) PG8_BAR; }
        if constexpr (!Epi::AFTER_DRAIN) { E(acc, cur, wr, wc, fr, fq); S.done(cur); }
        if (!has_next) break;
#pragma unroll
        for (int a = 0; a < 2; ++a)
#pragma unroll
            for (int b = 0; b < 2; ++b)
#pragma unroll
                for (int m = 0; m < 4; ++m)
#pragma unroll
                    for (int n = 0; n < 2; ++n) acc[a][b][m][n] = (f32x4){0.f, 0.f, 0.f, 0.f};
        cur = nxt; cA = nA; cB = nB; ++ui;
        if constexpr (ALIGN_EPI) { if (wr == 1) PG8_BAR; }
    }
    PG8_WAIT_V(0);
    if constexpr (!ALIGN_EPI) { if (wr == 0) PG8_BAR; }
    PG8_BAR;
    if constexpr (Epi::AFTER_DRAIN) { E.fused(acc, cur, wr, wc, fr, fq, lds, wid, lane); S.done(cur); }
#undef PG8_SA
#undef PG8_SB
#undef PG8_STAGE
#undef PG8_LDA
#undef PG8_LDB
#undef PG8_MMA
#undef PG8_WAIT_V
#undef PG8_WAIT_L
#undef PG8_BAR
#undef PG8_SCHED
}
}
#define LAS __attribute__((address_space(3)))
#define XB_TMO      128
#define XB_XCNT(j)  (256  + 64 * (j))
#define XB_XSUB(j)  (1280 + 64 * (j))
#define XB_XGEN(j)  (2304 + 64 * (j))
#define XB_TOP      3328
#define XB_TOPGEN   3392
#define XCD_BAR_WORDS 3456
#define XB_SPIN_CAP (1u << 18)

__device__ __forceinline__ unsigned xb_ld(unsigned* p)              { return __hip_atomic_load(p, __ATOMIC_RELAXED, __HIP_MEMORY_SCOPE_AGENT); }
__device__ __forceinline__ unsigned xb_add(unsigned* p, unsigned v) { return __hip_atomic_fetch_add(p, v, __ATOMIC_RELAXED, __HIP_MEMORY_SCOPE_AGENT); }
__device__ __forceinline__ unsigned xb_xcc_id() { return (unsigned)__builtin_amdgcn_s_getreg((3 << 11) | 20) & 0xFu; }
#define XB_SPIN(cond, bar) do { unsigned _sp = 0; while (cond) { __builtin_amdgcn_s_sleep(1); \
    if ((++_sp & 255u) == 0u) { if (xb_ld(&(bar)[XB_TMO])) break; if (_sp > XB_SPIN_CAP) { atomicAdd(&(bar)[XB_TMO], 1u); break; } } } } while (0)

struct XcdBarrier {
    unsigned* bar; unsigned x;
    volatile LAS unsigned* st;
};

__device__ __forceinline__ XcdBarrier xcd_barrier_post(unsigned* bar, volatile LAS unsigned* st) {
    XcdBarrier b; b.bar = bar; b.x = xb_xcc_id(); b.st = st;
    if (threadIdx.x == 0) (void)xb_add(&bar[XB_XCNT(b.x)], 1u);
    return b;
}
__device__ __forceinline__ void xcd_barrier_complete(unsigned* bar, unsigned x, unsigned& nloc, unsigned& nx) {
    const unsigned G = gridDim.x * gridDim.y * gridDim.z;
    unsigned sum, cnt, mine, sp = 0u;
    for (;;) {
        sum = 0u; cnt = 0u; mine = 0u;
#pragma unroll
        for (unsigned j = 0; j < 16; ++j) { const unsigned c = xb_ld(&bar[XB_XCNT(j)]); sum += c; cnt += (c > 0u) ? 1u : 0u; mine = (j == x) ? c : mine; }
        if (sum == G) break;
        __builtin_amdgcn_s_sleep(1);
        if ((++sp & 255u) == 0u) { if (xb_ld(&bar[XB_TMO])) break; if (sp > XB_SPIN_CAP) { atomicAdd(&bar[XB_TMO], 1u); break; } }
    }
    nloc = mine > 0u ? mine : 1u; nx = cnt > 0u ? cnt : 1u;
}

__device__ __forceinline__ void xcd_barrier(const XcdBarrier& b) {
    asm volatile("s_waitcnt vmcnt(0)" ::: "memory");
    __syncthreads();
    if (threadIdx.x == 0) {
        unsigned* bar = b.bar;
        __builtin_amdgcn_s_waitcnt(0);
        unsigned nloc = b.st[0], nx = b.st[1];
        if (nloc == 0u) { xcd_barrier_complete(bar, b.x, nloc, nx); b.st[0] = nloc; b.st[1] = nx; }
        const unsigned old = xb_add(&bar[XB_XSUB(b.x)], 1u);
        const unsigned gen = old / nloc;
        if (old + 1u == (gen + 1u) * nloc) {
            __builtin_amdgcn_fence(__ATOMIC_RELEASE, "agent");
            asm volatile("s_waitcnt vmcnt(0)" ::: "memory");
            const unsigned og = xb_add(&bar[XB_TOP], 1u);
            const unsigned tg = og / nx;
            if (og + 1u == (tg + 1u) * nx) xb_add(&bar[XB_TOPGEN], 1u);
            else XB_SPIN(xb_ld(&bar[XB_TOPGEN]) == tg, bar);
            __builtin_amdgcn_fence(__ATOMIC_ACQUIRE, "agent");
            xb_add(&bar[XB_XGEN(b.x)], 1u);
            asm volatile("s_waitcnt vmcnt(0)" ::: "memory");
        } else {
            XB_SPIN(xb_ld(&bar[XB_XGEN(b.x)]) == gen, bar);
            __builtin_amdgcn_fence(__ATOMIC_ACQUIRE, "agent");
            asm volatile("s_waitcnt vmcnt(0)" ::: "memory");
        }
    }
    __syncthreads();
}

#define DI __device__ __forceinline__
typedef unsigned short bf16_t;
typedef short bf16x8 __attribute__((ext_vector_type(8)));
typedef short s16x4 __attribute__((ext_vector_type(4)));
typedef float f32x4 __attribute__((ext_vector_type(4)));
typedef unsigned u32x4 __attribute__((ext_vector_type(4)));
typedef unsigned u32x2 __attribute__((ext_vector_type(2)));
typedef float f32x2_t __attribute__((ext_vector_type(2)));
typedef __bf16 bf16x2_t __attribute__((ext_vector_type(2)));

constexpr int DM = 4096, TP = 8192, SEQ = 2048, NBATCH = 4, TS = 32, MR = 8448, MREAL = 8224, NP = 9984, NIN = 9744;
constexpr int C_SQ = 0, C_SK = 2048, C_SV = 2304, C_SG = 2560, C_GQ = 4608, C_GK = 5120, C_GV = 5632, C_GG = 6656, C_MQ = 7680, C_MG = 8704, C_LR = 9728;
constexpr float EPS = 1e-6f;
constexpr size_t O_YP = 0, O_YS = 33554432, O_KP = 33685504, O_VP = 33947648, O_SP = 34209792, O_MKP = 35258368, O_MVP = 37355520, O_KS = 39452672, O_VS = 41549824, O_SS = 43646976, O_END = 52035584;
constexpr size_t MiB = 1u << 20;
constexpr size_t WS_WIN = 0;
constexpr size_t SZ_WIN = (size_t)NP * DM * 2;
constexpr size_t WS_WOUT = 160 * MiB;
constexpr size_t SZ_WOUT = (size_t)DM * DM * 2;
constexpr size_t WS_WMEM = 224 * MiB;
constexpr size_t SZ_WMEM = (size_t)2048 * DM * 2;
constexpr size_t WS_XN = 256 * MiB;
constexpr size_t WS_MN = 324 * MiB;
constexpr size_t SZ_MN = (size_t)1024 * DM * 2;
constexpr size_t WS_H = 340 * MiB;
constexpr size_t WS_MKV = 502 * MiB;
constexpr size_t SZ_MKV = (size_t)1024 * 2048 * 2;
constexpr size_t WS_G = 510 * MiB;
constexpr size_t WS_X1 = 576 * MiB;
constexpr size_t WS_ROPE = 708 * MiB;
constexpr size_t WS_U = 710 * MiB;
constexpr size_t WS_SF = 774 * MiB;
constexpr size_t WS_IMG = 806 * MiB;
constexpr size_t WS_EBL = 838 * MiB;
constexpr size_t WS_RS = 838 * MiB + 524288;
constexpr size_t WS_CTL = 839 * MiB;
constexpr size_t CTL_BYTES = 65536;
constexpr size_t WS_END = 840 * MiB;
static_assert(WS_WIN + 2 * SZ_WIN <= WS_WOUT && WS_XN + (size_t)MR * DM * 2 <= WS_MN && WS_H + (size_t)MR * NP * 2 <= WS_MKV && WS_G + (size_t)MR * DM * 2 <= WS_X1 && WS_X1 + (size_t)MR * DM * 4 <= WS_ROPE, "ws map");

constexpr int LDS_BYTES = 147456;

DI float bf2f(unsigned short u) { return __uint_as_float((unsigned)u << 16); }
DI float bflo(unsigned w) { return __uint_as_float(w << 16); }
DI float bfhi(unsigned w) { return __uint_as_float(w & 0xffff0000u); }
DI unsigned pk2(float lo, float hi) { f32x2_t v = {lo, hi}; bf16x2_t b = __builtin_convertvector(v, bf16x2_t); return __builtin_bit_cast(unsigned, b); }
DI unsigned short f2bf(float f) { return (unsigned short)(pk2(f, 0.f) & 0xffffu); }
DI float silu(float x) { return x * __builtin_amdgcn_rcpf(1.f + __expf(-x)); }
DI float wave_sum(float v) {
#pragma unroll
    for (int o = 1; o < 64; o <<= 1) v += __shfl_xor(v, o);
    return v;
}
DI float wave_max(float v) {
#pragma unroll
    for (int o = 1; o < 64; o <<= 1) v = fmaxf(v, __shfl_xor(v, o));
    return v;
}
DI f32x4 mfma16(bf16x8 a, bf16x8 b, f32x4 c) { return __builtin_amdgcn_mfma_f32_16x16x32_bf16(a, b, c, 0, 0, 0); }
DI bf16x8 pack8(f32x4 a, f32x4 b) { u32x4 p; p.x = pk2(a[0], a[1]); p.y = pk2(a[2], a[3]); p.z = pk2(b[0], b[1]); p.w = pk2(b[2], b[3]); return __builtin_bit_cast(bf16x8, p); }
DI bf16x8 cat4(s16x4 lo, s16x4 hi) { return __builtin_shufflevector(lo, hi, 0, 1, 2, 3, 4, 5, 6, 7); }

struct Args {
    const float* in[18]; float* out; unsigned char* ws; int ph_lo, ph_hi;
};

struct EpiIn {
    static constexpr bool PERM = true, AFTER_DRAIN = false;
    bf16_t* H; const float* rope; float* kp; float* vp; const float* RSin;
    DI void operator()(const f32x4 (&acc)[2][2][4][2], const pg8::Unit& u, int wr, int wc, int fr, int fq) const {
        const int pn = u.pn;
        const bool do_rope = pn < 9;
        float sc = 1.f;
        if (pn < 8) sc = 0.125f; else if (pn == 18 || pn == 19) sc = 0.08838834764831845f; else if (pn >= 30 && pn < 34) sc = 0.0625f;
        const int row0 = u.pm * 256 + wr * 64 + fr;
        const int colt = wc * 32 + 8 * fq;
#pragma unroll
        for (int ai = 0; ai < 2; ++ai) {
            f32x4 tr[4][2];
#pragma unroll
            for (int m = 0; m < 4; ++m) {
                tr[m][0] = (f32x4){1.f, 0.f, 1.f, 0.f}; tr[m][1] = (f32x4){1.f, 0.f, 1.f, 0.f};
                if (do_rope) {
                    const f32x4* rp = (const f32x4*)(rope + ((size_t)((row0 + ai * 128 + m * 16) & (SEQ - 1)) * 32 + 16 * (wc & 1) + 4 * fq) * 2);
                    tr[m][0] = rp[0]; tr[m][1] = rp[1];
                }
            }
            float rsv[4];
#pragma unroll
            for (int m = 0; m < 4; ++m) { rsv[m] = sc; if (RSin) rsv[m] = sc * __builtin_amdgcn_rsqf(RSin[row0 + ai * 128 + m * 16] * (1.f / DM) + EPS); }
#pragma unroll
            for (int m = 0; m < 4; ++m) {
                const int row = row0 + ai * 128 + m * 16;
                const f32x4 t0 = tr[m][0], t1 = tr[m][1];
#pragma unroll
                for (int bj = 0; bj < 2; ++bj) {
                    f32x4 v0 = acc[ai][bj][m][0], v1 = acc[ai][bj][m][1];
                    if (do_rope) {
                        float a, b;
                        a = v0[0]; b = v0[1]; v0[0] = a * t0[0] - b * t0[1]; v0[1] = b * t0[0] + a * t0[1];
                        a = v0[2]; b = v0[3]; v0[2] = a * t0[2] - b * t0[3]; v0[3] = b * t0[2] + a * t0[3];
                        a = v1[0]; b = v1[1]; v1[0] = a * t1[0] - b * t1[1]; v1[1] = b * t1[0] + a * t1[1];
                        a = v1[2]; b = v1[3]; v1[2] = a * t1[2] - b * t1[3]; v1[3] = b * t1[2] + a * t1[3];
                    }
                    v0 = v0 * rsv[m]; v1 = v1 * rsv[m];
                    u32x4 w4; w4.x = pk2(v0[0], v0[1]); w4.y = pk2(v0[2], v0[3]); w4.z = pk2(v1[0], v1[1]); w4.w = pk2(v1[2], v1[3]);
                    *(u32x4*)(H + (size_t)row * NP + pn * 256 + bj * 128 + colt) = w4;
                    if (pn == 8 || pn == 9) {
                        const int t = row & (SEQ - 1);
                        if (t >= SEQ - 128) {
                            const int kvh = bj * 2 + (wc >> 1);
                            float* dst = (pn == 8 ? kp : vp) + ((size_t)((row >> 11) * 128 + (t - (SEQ - 128))) * 4 + kvh) * 64;
                            if (pn == 8) {
                                const int d0 = 16 * (wc & 1) + 4 * fq;
                                *(f32x4*)(dst + d0) = (f32x4){v0[0], v0[2], v1[0], v1[2]};
                                *(f32x4*)(dst + d0 + 32) = (f32x4){v0[1], v0[3], v1[1], v1[3]};
                            } else {
                                const int p0 = 32 * (wc & 1) + 8 * fq;
                                *(f32x4*)(dst + p0) = v0; *(f32x4*)(dst + p0 + 4) = v1;
                            }
                        }
                    }
                }
            }
        }
    }
};
struct EpiInS {
    bf16_t* H; const float* rope; float* ks; float* vs; const float* RSin;
    DI void operator()(f32x4 v, int m, int n) const {
        const int pn = n >> 8;
        if (pn < 9) {
            const f32x4 t = *(const f32x4*)(rope + ((size_t)SEQ * 32 + ((n & 63) >> 1)) * 2);
            float a, b;
            a = v[0]; b = v[1]; v[0] = a * t[0] - b * t[1]; v[1] = b * t[0] + a * t[1];
            a = v[2]; b = v[3]; v[2] = a * t[2] - b * t[3]; v[3] = b * t[2] + a * t[3];
        }
        float sc = 1.f;
        if (pn < 8) sc = 0.125f; else if (pn == 18 || pn == 19) sc = 0.08838834764831845f; else if (pn >= 30 && pn < 34) sc = 0.0625f;
        if (RSin) sc *= __builtin_amdgcn_rsqf(RSin[TP + m] * (1.f / DM) + EPS);
        v = v * sc;
        u32x2 w2; w2.x = pk2(v[0], v[1]); w2.y = pk2(v[2], v[3]);
        *(u32x2*)(H + (size_t)(TP + m) * NP + n) = w2;
        if (pn == 8) {
            float* dst = ks + ((size_t)(m * 128 + 127) * 4 + ((n - C_SK) >> 6)) * 64; const int d0 = (n & 63) >> 1;
            dst[d0] = v[0]; dst[d0 + 32] = v[1]; dst[d0 + 1] = v[2]; dst[d0 + 33] = v[3];
        } else if (pn == 9) {
            float* dst = vs + ((size_t)(m * 128 + 127) * 4 + ((n - C_SV) >> 6)) * 64 + (n & 63);
            *(f32x4*)dst = v;
        }
    }
};
struct EpiResS {
    const float* base; float* X; const float* gnext; bf16_t* XNo; float* RS; int fin;
    DI void operator()(f32x4 v, int m, int n) const {
        const f32x4 x = *(const f32x4*)(base + (size_t)m * DM + n) + v;
        if (!fin) *(f32x4*)(X + (size_t)m * DM + n) = x;
        if (gnext) {
            const f32x4 y = x * *(const f32x4*)(gnext + n);
            if (fin) *(f32x4*)(X + (size_t)m * DM + n) = y;
            else { u32x2 w2; w2.x = pk2(y[0], y[1]); w2.y = pk2(y[2], y[3]); *(u32x2*)(XNo + (size_t)(TP + m) * DM + n) = w2; }
            float q = (x[0] * x[0] + x[1] * x[1]) + (x[2] * x[2] + x[3] * x[3]);
            q += __shfl_xor(q, 16); q += __shfl_xor(q, 32);
            if (((n >> 2) & 3) == 0) atomicAdd(RS + TP + m, q);
        }
    }
};
template <class EpiS>
DI void skinny_task(unsigned char* lds, const bf16_t* X, const bf16_t* Wt, int task, int tid, const EpiS& E) {
    const int lane = tid & 63, w = tid >> 6, c16 = lane & 15, quad = lane >> 4;
    const int ntl = w & 1, ksp = w >> 1;
    const int n0 = task * 32 + ntl * 16;
    f32x4 acc0 = {0.f, 0.f, 0.f, 0.f}, acc1 = {0.f, 0.f, 0.f, 0.f};
    const bf16_t* wp = Wt + (size_t)(n0 + c16) * DM + ksp * 1024 + quad * 8;
    const bf16_t* xp0 = X + (size_t)c16 * DM + ksp * 1024 + quad * 8;
    const bf16_t* xp1 = xp0 + 16 * DM;
    for (int k0 = 0; k0 < 32; k0 += 16) {
        bf16x8 av[16], b0v[16], b1v[16];
#pragma unroll
        for (int j = 0; j < 16; ++j) { av[j] = *(const bf16x8*)(wp + (k0 + j) * 32); b0v[j] = *(const bf16x8*)(xp0 + (k0 + j) * 32); b1v[j] = *(const bf16x8*)(xp1 + (k0 + j) * 32); }
#pragma unroll
        for (int j = 0; j < 16; ++j) { acc0 = mfma16(av[j], b0v[j], acc0); acc1 = mfma16(av[j], b1v[j], acc1); }
    }
    f32x4* red = (f32x4*)lds;
    __syncthreads();
    red[(w * 2 + 0) * 64 + lane] = acc0; red[(w * 2 + 1) * 64 + lane] = acc1;
    __syncthreads();
    if (w < 2) {
#pragma unroll
        for (int mt = 0; mt < 2; ++mt) {
            f32x4 v = red[((0 * 2 + w) * 2 + mt) * 64 + lane];
#pragma unroll
            for (int kp = 1; kp < 4; ++kp) v += red[((kp * 2 + w) * 2 + mt) * 64 + lane];
            E(v, mt * 16 + c16, n0 + quad * 4);
        }
    }
}
struct EpiMem {
    static constexpr bool PERM = true, AFTER_DRAIN = false;
    bf16_t* MKV; float* outk; float* outv;
    DI void operator()(const f32x4 (&acc)[2][2][4][2], const pg8::Unit& u, int wr, int wc, int fr, int fq) const {
        const int row0 = u.pm * 256 + wr * 64 + fr;
#pragma unroll
        for (int ai = 0; ai < 2; ++ai)
#pragma unroll
            for (int m = 0; m < 4; ++m) {
                const int row = row0 + ai * 128 + m * 16;
#pragma unroll
                for (int bj = 0; bj < 2; ++bj) {
                    const int col = u.pn * 256 + bj * 128 + wc * 32 + 8 * fq;
                    const f32x4 v0 = acc[ai][bj][m][0], v1 = acc[ai][bj][m][1];
                    u32x4 w4; w4.x = pk2(v0[0], v0[1]); w4.y = pk2(v0[2], v0[3]); w4.z = pk2(v1[0], v1[1]); w4.w = pk2(v1[2], v1[3]);
                    *(u32x4*)(MKV + (size_t)row * 2048 + col) = w4;
                    float* dst = (col < 1024) ? (outk + (size_t)row * 1024 + col) : (outv + (size_t)row * 1024 + (col - 1024));
                    *(f32x4*)dst = v0; *(f32x4*)(dst + 4) = v1;
                }
            }
    }
};
struct EpiRes {
    static constexpr bool PERM = true, AFTER_DRAIN = false;
    const float* baseP; float* X; const float* gnext; bf16_t* XNo; float* RS; int fin;
    DI void operator()(const f32x4 (&acc)[2][2][4][2], const pg8::Unit& u, int wr, int wc, int fr, int fq) const {
        const int row0 = u.pm * 256 + wr * 64 + fr;
        const int col0 = u.pn * 256 + wc * 32 + 8 * fq;
        f32x4 gv[2][2];
#pragma unroll
        for (int bj = 0; bj < 2; ++bj) { gv[bj][0] = (f32x4){0.f, 0.f, 0.f, 0.f}; gv[bj][1] = gv[bj][0];
            if (gnext) { gv[bj][0] = *(const f32x4*)(gnext + col0 + bj * 128); gv[bj][1] = *(const f32x4*)(gnext + col0 + bj * 128 + 4); } }
#pragma unroll
        for (int am = 0; am < 4; ++am) {
            const int ai = am >> 1, mb = (am & 1) * 2;
            f32x4 bv[2][2][2];
#pragma unroll
            for (int mm = 0; mm < 2; ++mm)
#pragma unroll
                for (int bj = 0; bj < 2; ++bj) {
                    const float* bp = baseP + (size_t)(row0 + ai * 128 + (mb + mm) * 16) * DM + col0 + bj * 128;
                    bv[mm][bj][0] = *(const f32x4*)bp; bv[mm][bj][1] = *(const f32x4*)(bp + 4);
                }
#pragma unroll
            for (int mm = 0; mm < 2; ++mm) {
                const int m = mb + mm;
                const int row = row0 + ai * 128 + m * 16;
                float q = 0.f;
#pragma unroll
                for (int bj = 0; bj < 2; ++bj) {
                    float* xp = X + (size_t)row * DM + col0 + bj * 128;
                    const f32x4 x0 = bv[mm][bj][0] + acc[ai][bj][m][0], x1 = bv[mm][bj][1] + acc[ai][bj][m][1];
                    if (!fin) { *(f32x4*)xp = x0; *(f32x4*)(xp + 4) = x1; }
                    if (gnext) {
                        const f32x4 y0 = x0 * gv[bj][0], y1 = x1 * gv[bj][1];
                        if (fin) { *(f32x4*)xp = y0; *(f32x4*)(xp + 4) = y1; }
                        else { u32x4 w4; w4.x = pk2(y0[0], y0[1]); w4.y = pk2(y0[2], y0[3]); w4.z = pk2(y1[0], y1[1]); w4.w = pk2(y1[2], y1[3]);
                               *(u32x4*)(XNo + (size_t)row * DM + col0 + bj * 128) = w4; }
                        q += ((x0[0] * x0[0] + x0[1] * x0[1]) + (x0[2] * x0[2] + x0[3] * x0[3])) + ((x1[0] * x1[0] + x1[1] * x1[1]) + (x1[2] * x1[2] + x1[3] * x1[3]));
                    }
                }
                if (gnext) { q += __shfl_xor(q, 16); q += __shfl_xor(q, 32); if (fq == 0) atomicAdd(RS + row, q); }
            }
        }
    }
};

struct EpiFin {
    static constexpr bool PERM = true, AFTER_DRAIN = false;
    const float* baseP; float* Y; const float* g; float* RS; unsigned* pcnt;
    DI void operator()(const f32x4 (&acc_)[2][2][4][2], const pg8::Unit& u, int wr, int wc, int fr, int fq) const {
        f32x4 (&acc)[2][2][4][2] = const_cast<f32x4 (&)[2][2][4][2]>(acc_);
        const int row0 = u.pm * 256 + wr * 64 + fr;
        const int col0 = u.pn * 256 + wc * 32 + 8 * fq;
        f32x4 gv[2][2];
#pragma unroll
        for (int bj = 0; bj < 2; ++bj) { gv[bj][0] = *(const f32x4*)(g + col0 + bj * 128); gv[bj][1] = *(const f32x4*)(g + col0 + bj * 128 + 4); }
#pragma unroll
        for (int am = 0; am < 4; ++am) {
            const int ai = am >> 1, mb = (am & 1) * 2;
            f32x4 bv[2][2][2];
#pragma unroll
            for (int mm = 0; mm < 2; ++mm)
#pragma unroll
                for (int bj = 0; bj < 2; ++bj) {
                    const float* bp = baseP + (size_t)(row0 + ai * 128 + (mb + mm) * 16) * DM + col0 + bj * 128;
                    bv[mm][bj][0] = *(const f32x4*)bp; bv[mm][bj][1] = *(const f32x4*)(bp + 4);
                }
#pragma unroll
            for (int mm = 0; mm < 2; ++mm) {
                const int m = mb + mm;
                float q = 0.f;
#pragma unroll
                for (int bj = 0; bj < 2; ++bj) {
                    const f32x4 x0 = bv[mm][bj][0] + acc[ai][bj][m][0], x1 = bv[mm][bj][1] + acc[ai][bj][m][1];
                    q += ((x0[0] * x0[0] + x0[1] * x0[1]) + (x0[2] * x0[2] + x0[3] * x0[3])) + ((x1[0] * x1[0] + x1[1] * x1[1]) + (x1[2] * x1[2] + x1[3] * x1[3]));
                    acc[ai][bj][m][0] = x0 * gv[bj][0]; acc[ai][bj][m][1] = x1 * gv[bj][1];
                }
                q += __shfl_xor(q, 16); q += __shfl_xor(q, 32);
                if (fq == 0) atomicAdd(RS + row0 + ai * 128 + m * 16, q);
            }
        }
        asm volatile("s_waitcnt vmcnt(0)" ::: "memory");
        unsigned* pc = pcnt + 64 * u.pm;
        if (fr == 0 && fq == 0) __hip_atomic_fetch_add(pc, 1u, __ATOMIC_RELAXED, __HIP_MEMORY_SCOPE_AGENT);
        { unsigned sp = 0; while (__hip_atomic_load(pc, __ATOMIC_RELAXED, __HIP_MEMORY_SCOPE_AGENT) < 128u) { __builtin_amdgcn_s_sleep(2); if (++sp > (1u << 21)) break; } }
        asm volatile("" ::: "memory");
#pragma unroll
        for (int ai = 0; ai < 2; ++ai)
#pragma unroll
            for (int m = 0; m < 4; ++m) {
                const int row = row0 + ai * 128 + m * 16;
                const float rs = __builtin_amdgcn_rsqf(__hip_atomic_load(RS + row, __ATOMIC_RELAXED, __HIP_MEMORY_SCOPE_AGENT) * (1.f / DM) + EPS);
#pragma unroll
                for (int bj = 0; bj < 2; ++bj) {
                    float* yp = Y + (size_t)row * DM + col0 + bj * 128;
                    *(f32x4*)yp = acc[ai][bj][m][0] * rs; *(f32x4*)(yp + 4) = acc[ai][bj][m][1] * rs;
                }
            }
    }
};
struct PanelOrder {
    int G, c;
    DI void init(int G_, int c_) { G = G_; c = c_; }
    DI bool next(int i, pg8::Unit& u) const {
        if (G == 256) { if (i >= 2) return false; const int xcd = c & 7, r = c >> 3, j = xcd >> 1, hx = xcd & 1; u.pm = 16 * i + 4 * j + (r & 3); u.pn = 8 * hx + (r >> 2); return true; }
        const long L = (long)i * G + c; if (L >= 512) return false; u.pm = (int)(L >> 4); u.pn = (int)(L & 15); return true;
    }
    DI void a_ready(const pg8::Unit&) const {}
    DI void done(const pg8::Unit&) const {}
};

DI int dst_row_in(int s) {
    if (s < 2304) { const int d = s & 63; return (s & ~63) + 2 * (d & 31) + (d >> 5); }
    if (s < 6656) return s;
    if (s < 6672) return 9728 + (s - 6656);
    return s - 16;
}
struct TrItem { const float* W; bf16_t* WT; int N, item, inmap; };
DI void tr_load(const TrItem& t, f32x4 (&tv)[16], int lane) {
    const int nblk = (t.N + 63) >> 6, kb = t.item / nblk, nb = t.item - kb * nblk, k0 = 64 * kb, n0 = 64 * nb;
    const int cl = (lane & 15) * 4, rl = lane >> 4;
    const bool okc = (n0 + cl) < t.N;
#pragma unroll
    for (int i = 0; i < 16; ++i) { tv[i] = (f32x4){0.f, 0.f, 0.f, 0.f}; if (okc) tv[i] = *(const f32x4*)(t.W + (size_t)(k0 + 4 * i + rl) * t.N + n0 + cl); }
}
DI void tr_store(const TrItem& t, const f32x4 (&tv)[16], float* scr, int lane) {
    const int nblk = (t.N + 63) >> 6, kb = t.item / nblk, nb = t.item - kb * nblk, k0 = 64 * kb, n0 = 64 * nb;
    const int cl = (lane & 15) * 4, rl = lane >> 4;
#pragma unroll
    for (int i = 0; i < 16; ++i) { float* s = scr + (4 * i + rl) * 65 + cl; s[0] = tv[i][0]; s[1] = tv[i][1]; s[2] = tv[i][2]; s[3] = tv[i][3]; }
    asm volatile("s_waitcnt lgkmcnt(0)" ::: "memory");
    const int c = lane & 7;
#pragma unroll
    for (int j = 0; j < 8; ++j) {
        const int n = (lane >> 3) + 8 * j;
        if (n0 + n < t.N) {
            const float* s = scr + (8 * c) * 65 + n;
            u32x4 o; o.x = pk2(s[0], s[65]); o.y = pk2(s[2 * 65], s[3 * 65]); o.z = pk2(s[4 * 65], s[5 * 65]); o.w = pk2(s[6 * 65], s[7 * 65]);
            const int row = t.inmap ? dst_row_in(n0 + n) : (n0 + n);
            *(u32x4*)(t.WT + (size_t)row * DM + k0 + 8 * c) = o;
        }
    }
    asm volatile("s_waitcnt lgkmcnt(0)" ::: "memory");
}
DI void norm_row(const float* src, const float* g, bf16_t* dstb, float* dstf, int lane) {
    const f32x4* xr = (const f32x4*)src + lane;
    f32x4 v[16]; float s = 0.f;
#pragma unroll
    for (int j = 0; j < 16; ++j) { v[j] = xr[64 * j]; s += (v[j][0] * v[j][0] + v[j][1] * v[j][1]) + (v[j][2] * v[j][2] + v[j][3] * v[j][3]); }
    const f32x4* gr = (const f32x4*)g + lane;
    f32x4 gv[16];
#pragma unroll
    for (int j = 0; j < 16; ++j) gv[j] = gr[64 * j];
    const float rs = __builtin_amdgcn_rsqf(wave_sum(s) * (1.f / DM) + EPS);
#pragma unroll
    for (int j = 0; j < 16; ++j) {
        const f32x4 o = v[j] * rs * gv[j];
        if (dstb) { u32x2 w2; w2.x = pk2(o[0], o[1]); w2.y = pk2(o[2], o[3]); *((u32x2*)dstb + lane + 64 * j) = w2; }
        else *((f32x4*)dstf + lane + 64 * j) = o;
    }
}
DI void rope_entry(float* tab, int idx) {
    const int pi = idx >> 5, i = idx & 31;
    const double pos = pi < SEQ ? (double)pi : 16384.0;
    double inv = 1.0; for (int k = 0; k < i; ++k) inv *= 0.7498942093324559;
    const double a = pos * inv;
    const double q = __builtin_rint(a * 0.6366197723675814);
    const double r = (a - q * 1.5707963267948966) - q * 6.123233995736766e-17;
    const int qi = ((int)q) & 3;
    const double r2 = r * r;
    const double sn = r * (1.0 + r2 * (-1.0 / 6 + r2 * (1.0 / 120 + r2 * (-1.0 / 5040 + r2 * (1.0 / 362880 + r2 * (-1.0 / 39916800 + r2 * (1.0 / 6227020800.0)))))));
    const double cs = 1.0 + r2 * (-0.5 + r2 * (1.0 / 24 + r2 * (-1.0 / 720 + r2 * (1.0 / 40320 + r2 * (-1.0 / 3628800 + r2 * (1.0 / 479001600 + r2 * (-1.0 / 87178291200.0)))))));
    double c, s;
    if (qi == 0) { c = cs; s = sn; } else if (qi == 1) { c = -sn; s = cs; } else if (qi == 2) { c = -cs; s = -sn; } else { c = sn; s = -cs; }
    tab[2 * idx] = (float)c; tab[2 * idx + 1] = (float)s;
}

DI void swa_unit(unsigned char* lds, const bf16_t* H, bf16_t* Gt, const float* sinks, int u, int tid) {
    const int kvh = u & 3, blk = (u >> 2) & 15, b = u >> 6;
    bf16_t* Ks = (bf16_t*)lds;
    bf16_t* Vt = (bf16_t*)(lds + 39168);
    const int lane = tid & 63, w = tid >> 6, c16 = lane & 15, quad = lane >> 4;
    const int qi = w * 16 + c16;
    const size_t qrow = (size_t)(b * SEQ + blk * 128 + qi);
    bf16x8 qc0 = *(const bf16x8*)(H + qrow * NP + C_SQ + kvh * 512 + quad * 8), qc1 = *(const bf16x8*)(H + qrow * NP + C_SQ + kvh * 512 + 32 + quad * 8);
    __syncthreads();
    {
        const int r = tid >> 1, half = tid & 1;
        const int tok = blk * 128 - 128 + r;
        u32x4 kv[4], vv[4];
#pragma unroll
        for (int i = 0; i < 4; ++i) { kv[i] = (u32x4){0u, 0u, 0u, 0u}; vv[i] = (u32x4){0u, 0u, 0u, 0u}; }
        if (tok >= 0) {
            const bf16_t* src = H + (size_t)(b * SEQ + tok) * NP + kvh * 64 + half * 32;
#pragma unroll
            for (int i = 0; i < 4; ++i) { kv[i] = *(const u32x4*)(src + C_SK + i * 8); vv[i] = *(const u32x4*)(src + C_SV + i * 8); }
        }
#pragma unroll
        for (int i = 0; i < 4; ++i) *(u32x4*)(Ks + r * 72 + half * 32 + i * 8) = kv[i];
#pragma unroll
        for (int i = 0; i < 4; ++i)
#pragma unroll
            for (int e = 0; e < 4; ++e) {
                const unsigned wv = vv[i][e];
                Vt[(half * 32 + i * 8 + 2 * e) * 280 + r] = (bf16_t)(wv & 0xffffu);
                Vt[(half * 32 + i * 8 + 2 * e + 1) * 280 + r] = (bf16_t)(wv >> 16);
            }
        for (int i = tid; i < 576; i += 512) ((unsigned*)(Ks + 256 * 72))[i] = 0u;
        { const int d = tid >> 3, cc = 256 + (tid & 7) * 2; *(unsigned*)(Vt + d * 280 + cc) = 0u; }
    }
    __syncthreads();
    for (int g = 0; g < 8; ++g) {
        const int head = kvh * 8 + g;
        bf16x8 qf[2]; qf[0] = qc0; qf[1] = qc1;
        { const int hn = kvh * 8 + (g < 7 ? g + 1 : g);
          qc0 = *(const bf16x8*)(H + qrow * NP + C_SQ + hn * 64 + quad * 8); qc1 = *(const bf16x8*)(H + qrow * NP + C_SQ + hn * 64 + 32 + quad * 8); }
        u32x2 gwv[4];
#pragma unroll
        for (int mt = 0; mt < 4; ++mt) gwv[mt] = *(const u32x2*)(H + qrow * NP + C_SG + head * 64 + mt * 16 + quad * 4);
        f32x4 s[10];
#pragma unroll
        for (int i = 0; i < 10; ++i) {
            s[i] = (f32x4){0.f, 0.f, 0.f, 0.f};
            const bf16_t* kp = Ks + ((w + i) * 16 + c16) * 72 + quad * 8;
#pragma unroll
            for (int ks = 0; ks < 2; ++ks) s[i] = mfma16(*(const bf16x8*)(kp + ks * 32), qf[ks], s[i]);
        }
        const float sink = sinks[head];
        float mx = sink;
        int qiv = qi + 128 - (w * 16 + quad * 4); asm volatile("" : "+v"(qiv));
        const int lowlim = blk > 0 ? 0 : 128;
#pragma unroll
        for (int i = 0; i < 10; ++i)
#pragma unroll
            for (int j = 0; j < 4; ++j) {
                const int sj = (w + i) * 16 + quad * 4 + j, diff = qiv - (i * 16 + j);
                const bool valid = (unsigned)diff < 128u && sj >= lowlim;
                s[i][j] = valid ? s[i][j] : -INFINITY;
                mx = fmaxf(mx, s[i][j]);
            }
        mx = fmaxf(mx, __shfl_xor(mx, 16)); mx = fmaxf(mx, __shfl_xor(mx, 32));
        float sum = 0.f;
#pragma unroll
        for (int i = 0; i < 10; ++i)
#pragma unroll
            for (int j = 0; j < 4; ++j) { const float p = __expf(s[i][j] - mx); s[i][j] = p; sum += p; }
        sum += __shfl_xor(sum, 16); sum += __shfl_xor(sum, 32);
        sum += __expf(sink - mx);
        const float inv = __builtin_amdgcn_rcpf(sum);
        f32x4 o[4];
#pragma unroll
        for (int mt = 0; mt < 4; ++mt) o[mt] = (f32x4){0.f, 0.f, 0.f, 0.f};
#pragma unroll
        for (int st = 0; st < 5; ++st) {
            const bf16x8 pb = pack8(s[2 * st], s[2 * st + 1]);
#pragma unroll
            for (int mt = 0; mt < 4; ++mt) {
                const bf16_t* vp = Vt + (mt * 16 + c16) * 280 + (w + 2 * st) * 16 + quad * 4;
                o[mt] = mfma16(cat4(*(const s16x4*)vp, *(const s16x4*)(vp + 16)), pb, o[mt]);
            }
        }
#pragma unroll
        for (int mt = 0; mt < 4; ++mt) {
            const int d = mt * 16 + quad * 4;
            const u32x2 gw = gwv[mt];
            u32x2 ow;
            ow.x = pk2(o[mt][0] * inv * silu(bflo(gw.x)), o[mt][1] * inv * silu(bfhi(gw.x)));
            ow.y = pk2(o[mt][2] * inv * silu(bflo(gw.y)), o[mt][3] * inv * silu(bfhi(gw.y)));
            *(u32x2*)(Gt + qrow * DM + head * 64 + d) = ow;
        }
    }
}

DI void mem_unit(unsigned char* lds, const bf16_t* H, const bf16_t* MKV, bf16_t* Gt, int u, int tid) {
    const int qt = u & 15, h = (u >> 4) & 3, b = u >> 6;
    const int lane = tid & 63, w = tid >> 6, c16 = lane & 15, quad = lane >> 4;
    const size_t qrow = (size_t)(b * SEQ + qt * 128 + w * 16 + c16);
    const int srow = tid >> 3, seg = tid & 7;
    const bf16_t* ksrc = MKV + (size_t)(b * 256 + srow) * 2048 + h * 256 + seg * 32;
    const bf16_t* vsrc = MKV + (size_t)(b * 256 + lane) * 2048 + 1024 + h * 256 + w * 32;
#define MEM_KBUF(i) ((bf16_t*)(lds + (i) * 33792))
#define MEM_VBUF(i) ((bf16_t*)(lds + 67584 + (i) * 36864))
#define MEM_WRITE_K(buf) do { _Pragma("unroll") for (int i_ = 0; i_ < 4; ++i_) *(u32x4*)(MEM_KBUF(buf) + srow * 264 + seg * 32 + i_ * 8) = pre[i_]; } while (0)
#define MEM_WRITE_V(buf) do { _Pragma("unroll") for (int i_ = 0; i_ < 4; ++i_) _Pragma("unroll") for (int e_ = 0; e_ < 4; ++e_) { \
        MEM_VBUF(buf)[(w * 32 + i_ * 8 + 2 * e_) * 72 + lane] = (bf16_t)(pre[i_][e_] & 0xffffu); MEM_VBUF(buf)[(w * 32 + i_ * 8 + 2 * e_ + 1) * 72 + lane] = (bf16_t)(pre[i_][e_] >> 16); } } while (0)
#define MEM_LOAD_K(c) do { _Pragma("unroll") for (int i_ = 0; i_ < 4; ++i_) pre[i_] = *(const u32x4*)(ksrc + (size_t)(c) * 64 * 2048 + i_ * 8); } while (0)
#define MEM_LOAD_V(c) do { _Pragma("unroll") for (int i_ = 0; i_ < 4; ++i_) pre[i_] = *(const u32x4*)(vsrc + (size_t)(c) * 64 * 2048 + i_ * 8); } while (0)
    u32x4 pre[4];
    MEM_LOAD_K(0);
    bf16x8 qf[8];
#pragma unroll
    for (int ks = 0; ks < 8; ++ks) qf[ks] = *(const bf16x8*)(H + qrow * NP + C_MQ + h * 256 + ks * 32 + quad * 8);
    __syncthreads();
    MEM_WRITE_K(0); MEM_LOAD_K(1);
    f32x4 s[16];
#pragma unroll
    for (int c = 0; c < 4; ++c) {
        __syncthreads();
        if (c == 0) { MEM_WRITE_K(1); MEM_LOAD_K(2); }
        else if (c == 1) { MEM_WRITE_K(0); MEM_LOAD_K(3); }
        else if (c == 2) { MEM_WRITE_K(1); MEM_LOAD_V(0); }
        else { MEM_WRITE_V(0); MEM_LOAD_V(1); }
#pragma unroll
        for (int kt = 0; kt < 4; ++kt) {
            f32x4 a = {0.f, 0.f, 0.f, 0.f};
            const bf16_t* kp = MEM_KBUF(c & 1) + (kt * 16 + c16) * 264 + quad * 8;
#pragma unroll
            for (int ks = 0; ks < 8; ++ks) a = mfma16(*(const bf16x8*)(kp + ks * 32), qf[ks], a);
            s[c * 4 + kt] = a;
        }
    }
    u32x2 gwv[16];
#pragma unroll
    for (int mt = 0; mt < 16; ++mt) gwv[mt] = *(const u32x2*)(H + qrow * NP + C_MG + h * 256 + mt * 16 + quad * 4);
    float mx = -INFINITY;
#pragma unroll
    for (int i = 0; i < 16; ++i)
#pragma unroll
        for (int j = 0; j < 4; ++j) mx = fmaxf(mx, s[i][j]);
    mx = fmaxf(mx, __shfl_xor(mx, 16)); mx = fmaxf(mx, __shfl_xor(mx, 32));
    float sum = 0.f;
#pragma unroll
    for (int i = 0; i < 16; ++i)
#pragma unroll
        for (int j = 0; j < 4; ++j) { const float p = __expf(s[i][j] - mx); s[i][j] = p; sum += p; }
    sum += __shfl_xor(sum, 16); sum += __shfl_xor(sum, 32);
    const float inv = __builtin_amdgcn_rcpf(sum);
    bf16x8 pbv[8];
#pragma unroll
    for (int i = 0; i < 8; ++i) pbv[i] = pack8(s[2 * i], s[2 * i + 1]);
    f32x4 o[16];
#pragma unroll
    for (int mt = 0; mt < 16; ++mt) o[mt] = (f32x4){0.f, 0.f, 0.f, 0.f};
#pragma unroll
    for (int c = 0; c < 4; ++c) {
        __syncthreads();
        if (c == 0) { MEM_WRITE_V(1); MEM_LOAD_V(2); }
        else if (c == 1) { MEM_WRITE_V(0); MEM_LOAD_V(3); }
        else if (c == 2) { MEM_WRITE_V(1); }
#pragma unroll
        for (int st = 0; st < 2; ++st) {
            const bf16x8 pb = pbv[c * 2 + st];
#pragma unroll
            for (int mt = 0; mt < 16; ++mt) {
                const bf16_t* vp = MEM_VBUF(c & 1) + (mt * 16 + c16) * 72 + (2 * st) * 16 + quad * 4;
                o[mt] = mfma16(cat4(*(const s16x4*)vp, *(const s16x4*)(vp + 16)), pb, o[mt]);
            }
        }
    }
#pragma unroll
    for (int mt = 0; mt < 16; ++mt) {
        const int d = mt * 16 + quad * 4;
        const u32x2 gw = gwv[mt];
        u32x2 ow;
        ow.x = pk2(o[mt][0] * inv * silu(bflo(gw.x)), o[mt][1] * inv * silu(bfhi(gw.x)));
        ow.y = pk2(o[mt][2] * inv * silu(bflo(gw.y)), o[mt][3] * inv * silu(bfhi(gw.y)));
        *(u32x2*)(Gt + qrow * DM + 3072 + h * 256 + d) = ow;
    }
#undef MEM_KBUF
#undef MEM_VBUF
#undef MEM_WRITE_K
#undef MEM_WRITE_V
#undef MEM_LOAD_K
#undef MEM_LOAD_V
}

DI float logsig16(float z) { return (fminf(z, 0.f) - __logf(1.f + __expf(-fabsf(z)))) * 0.0625f; }

constexpr int GI_QS = 0, GI_AS = 17408, GI_VT = 26624, GI_BYTES = 63488;
DI void gla_prep_unit(unsigned char* lds, const bf16_t* H, const float* wg, const float* bg, f32x4* Ug, float* EBLg, unsigned char* IMG, int u, int tid) {
    const int ch = u & 31, h = (u >> 5) & 3, b = u >> 7;
    bf16_t* Qs = (bf16_t*)(lds + GI_QS);
    bf16_t* As = (bf16_t*)(lds + GI_AS);
    bf16_t* Vt = (bf16_t*)(lds + GI_VT);
    bf16_t* Ks = (bf16_t*)(lds + 63488);
    bf16_t* Kt = (bf16_t*)(lds + 80896);
    float* LR = (float*)(lds + 99328);
    float* WgL = (float*)(lds + 103424);
    float* GT = (float*)(lds + 111616);
    const int lane = tid & 63, w = tid >> 6, c16 = lane & 15, quad = lane >> 4;
    const size_t row0 = (size_t)(b * SEQ + ch * 64);
    __syncthreads();
    { const int i = tid >> 3, r2 = (tid & 7) * 2; const unsigned wv = *(const unsigned*)(H + (row0 + i) * NP + C_LR + r2); LR[i * 16 + r2] = bflo(wv); LR[i * 16 + r2 + 1] = bfhi(wv); }
#pragma unroll
    for (int r = 0; r < 4; ++r) { const int idx = tid + 512 * r; WgL[idx] = wg[(idx >> 7) * 512 + h * 128 + (idx & 127)]; }
    const int dk = tid & 127, ig = tid >> 7;
    const float bgc = bg[h * 128 + dk];
    unsigned short qr[16], kr[16];
#pragma unroll
    for (int ii = 0; ii < 16; ++ii) { const bf16_t* src = H + (row0 + ig * 16 + ii) * NP + h * 128 + dk; qr[ii] = src[C_GQ]; kr[ii] = src[C_GK]; }
    u32x4 vpre[4];
#pragma unroll
    for (int i = 0; i < 4; ++i) vpre[i] = *(const u32x4*)(H + (row0 + lane) * NP + C_GV + h * 256 + w * 32 + i * 8);
    __syncthreads();
    float bb[16];
    {
        float wgc[16];
#pragma unroll
        for (int r = 0; r < 16; ++r) wgc[r] = WgL[r * 128 + dk];
        float run = 0.f;
#pragma unroll
        for (int ii = 0; ii < 16; ++ii) {
            const int i = ig * 16 + ii;
            float z = bgc;
#pragma unroll
            for (int r = 0; r < 16; ++r) z += LR[i * 16 + r] * wgc[r];
            run += logsig16(z); bb[ii] = run;
        }
        GT[ig * 128 + dk] = run;
    }
#pragma unroll
    for (int i = 0; i < 4; ++i)
#pragma unroll
        for (int e = 0; e < 4; ++e) {
            Vt[(w * 32 + i * 8 + 2 * e) * 72 + lane] = (bf16_t)(vpre[i][e] & 0xffffu);
            Vt[(w * 32 + i * 8 + 2 * e + 1) * 72 + lane] = (bf16_t)(vpre[i][e] >> 16);
        }
    __syncthreads();
    {
        const float t0 = GT[dk], t1 = GT[128 + dk], t2 = GT[256 + dk], t3 = GT[384 + dk];
        const float bl = (t0 + t1) + (t2 + t3);
        const float off = (ig > 0 ? t0 : 0.f) + (ig > 1 ? t1 : 0.f) + (ig > 2 ? t2 : 0.f);
#pragma unroll
        for (int ii = 0; ii < 16; ++ii) {
            const int i = ig * 16 + ii;
            const float bv = off + bb[ii], q = bf2f(qr[ii]), k = bf2f(kr[ii]);
            Qs[i * 136 + dk] = f2bf(q * __expf(bv));
            Ks[i * 136 + dk] = f2bf(k * __expf(-bv));
            Kt[dk * 72 + i] = f2bf(k * __expf(bl - bv));
        }
        if (ig == 0) EBLg[(size_t)u * 128 + dk] = __expf(bl);
    }
    __syncthreads();
#pragma unroll
    for (int tt = 0; tt < 2; ++tt) {
        const int t = 2 * w + tt, mt = t >> 2, nt = t & 3;
        f32x4 a = {0.f, 0.f, 0.f, 0.f};
        if (nt <= mt) {
#pragma unroll
            for (int ks = 0; ks < 4; ++ks)
                a = mfma16(*(const bf16x8*)(Qs + (mt * 16 + c16) * 136 + ks * 32 + quad * 8), *(const bf16x8*)(Ks + (nt * 16 + c16) * 136 + ks * 32 + quad * 8), a);
        }
#pragma unroll
        for (int jj = 0; jj < 4; ++jj) { const int i = mt * 16 + quad * 4 + jj, j = nt * 16 + c16; As[i * 72 + j] = f2bf(j <= i ? a[jj] : 0.f); }
    }
#pragma unroll
    for (int kt = 0; kt < 8; ++kt) {
        f32x4 s0 = {0.f, 0.f, 0.f, 0.f}, s1 = {0.f, 0.f, 0.f, 0.f};
#pragma unroll
        for (int ks = 0; ks < 2; ++ks) {
            const bf16x8 a = *(const bf16x8*)(Kt + (kt * 16 + c16) * 72 + ks * 32 + quad * 8);
            s0 = mfma16(a, *(const bf16x8*)(Vt + ((2 * w) * 16 + c16) * 72 + ks * 32 + quad * 8), s0);
            s1 = mfma16(a, *(const bf16x8*)(Vt + ((2 * w + 1) * 16 + c16) * 72 + ks * 32 + quad * 8), s1);
        }
        Ug[((size_t)(u * 8 + kt) * 16 + 2 * w) * 64 + lane] = s0;
        Ug[((size_t)(u * 8 + kt) * 16 + 2 * w + 1) * 64 + lane] = s1;
    }
    __syncthreads();
    { u32x4* dst = (u32x4*)(IMG + (size_t)u * GI_BYTES); const u32x4* srcl = (const u32x4*)lds;
      for (int i = tid; i < GI_BYTES / 16; i += 512) dst[i] = srcl[i]; }
}
DI void gla_scan_task(const f32x4* Ug, const float* EBLg, u32x2* SF2, float* state_out, int t, int lane) {
    const int nt = t & 15, kt = (t >> 4) & 7, bh = t >> 7;
    const int c16 = lane & 15, quad = lane >> 4;
    f32x4 s0 = {0.f, 0.f, 0.f, 0.f};
    for (int n0 = 0; n0 < 32; n0 += 16) {
        f32x4 ev[16], uv[16];
#pragma unroll
        for (int j = 0; j < 16; ++j) {
            const size_t u = (size_t)bh * 32 + n0 + j;
            ev[j] = *(const f32x4*)(EBLg + u * 128 + kt * 16 + quad * 4);
            uv[j] = Ug[((u * 8 + kt) * 16 + nt) * 64 + lane];
        }
#pragma unroll
        for (int j = 0; j < 16; ++j) {
            const size_t u = (size_t)bh * 32 + n0 + j;
            u32x2 pk; pk.x = pk2(s0[0], s0[1]); pk.y = pk2(s0[2], s0[3]);
            SF2[(((u * 4 + (kt >> 1)) * 16 + nt) * 64 + lane) * 2 + (kt & 1)] = pk;
            s0 = s0 * ev[j] + uv[j];
        }
    }
#pragma unroll
    for (int jj = 0; jj < 4; ++jj) state_out[((size_t)bh * 128 + kt * 16 + quad * 4 + jj) * 256 + nt * 16 + c16] = s0[jj];
}
DI void gla_out_unit(unsigned char* lds, const bf16_t* H, bf16_t* Gt, const float* gng, const u32x4* SF, const unsigned char* IMG, int u, int tid) {
    const int ch = u & 31, h = (u >> 5) & 3, b = u >> 7;
    const bf16_t* Qs = (const bf16_t*)(lds + GI_QS);
    const bf16_t* As = (const bf16_t*)(lds + GI_AS);
    const bf16_t* Vt = (const bf16_t*)(lds + GI_VT);
    float* SSw = (float*)(lds + GI_BYTES);
    const int lane = tid & 63, w = tid >> 6, c16 = lane & 15, quad = lane >> 4;
    const size_t row0 = (size_t)(b * SEQ + ch * 64);
    unsigned short gtv[4][4][2];
#pragma unroll
    for (int mt = 0; mt < 4; ++mt)
#pragma unroll
        for (int jj = 0; jj < 4; ++jj)
#pragma unroll
            for (int n = 0; n < 2; ++n) gtv[mt][jj][n] = H[(row0 + mt * 16 + quad * 4 + jj) * NP + C_GG + h * 256 + (2 * w + n) * 16 + c16];
    __syncthreads();
    { const u32x4* src = (const u32x4*)(IMG + (size_t)u * GI_BYTES); u32x4* dstl = (u32x4*)lds;
      for (int i = tid; i < GI_BYTES / 16; i += 512) dstl[i] = src[i]; }
    bf16x8 sb[4][2];
#pragma unroll
    for (int ks = 0; ks < 4; ++ks)
#pragma unroll
        for (int n = 0; n < 2; ++n) sb[ks][n] = __builtin_bit_cast(bf16x8, SF[(((size_t)u * 4 + ks) * 16 + 2 * w + n) * 64 + lane]);
    __syncthreads();
    f32x4 o[4][2];
#pragma unroll
    for (int mt = 0; mt < 4; ++mt) {
        o[mt][0] = (f32x4){0.f, 0.f, 0.f, 0.f}; o[mt][1] = (f32x4){0.f, 0.f, 0.f, 0.f};
#pragma unroll
        for (int ks = 0; ks < 4; ++ks) {
            const bf16_t* qp = Qs + (mt * 16 + c16) * 136 + (2 * ks) * 16 + quad * 4;
            const bf16x8 a = cat4(*(const s16x4*)qp, *(const s16x4*)(qp + 16));
            o[mt][0] = mfma16(a, sb[ks][0], o[mt][0]); o[mt][1] = mfma16(a, sb[ks][1], o[mt][1]);
        }
#pragma unroll
        for (int ks = 0; ks < 2; ++ks) {
            const bf16x8 a = *(const bf16x8*)(As + (mt * 16 + c16) * 72 + ks * 32 + quad * 8);
#pragma unroll
            for (int n = 0; n < 2; ++n) o[mt][n] = mfma16(a, *(const bf16x8*)(Vt + ((2 * w + n) * 16 + c16) * 72 + ks * 32 + quad * 8), o[mt][n]);
        }
    }
#pragma unroll
    for (int mt = 0; mt < 4; ++mt)
#pragma unroll
        for (int jj = 0; jj < 4; ++jj) {
            float q = o[mt][0][jj] * o[mt][0][jj] + o[mt][1][jj] * o[mt][1][jj];
            q += __shfl_xor(q, 1); q += __shfl_xor(q, 2); q += __shfl_xor(q, 4); q += __shfl_xor(q, 8);
            if (c16 == 0) SSw[w * 64 + mt * 16 + quad * 4 + jj] = q;
        }
    __syncthreads();
    const float gn0 = gng[h * 256 + (2 * w) * 16 + c16], gn1 = gng[h * 256 + (2 * w + 1) * 16 + c16];
#pragma unroll
    for (int mt = 0; mt < 4; ++mt)
#pragma unroll
        for (int jj = 0; jj < 4; ++jj) {
            const int i = mt * 16 + quad * 4 + jj;
            float tot = 0.f;
#pragma unroll
            for (int ww = 0; ww < 8; ++ww) tot += SSw[ww * 64 + i];
            const float rs = __builtin_amdgcn_rsqf(tot * (1.f / 256.f) + EPS);
#pragma unroll
            for (int n = 0; n < 2; ++n) {
                const int dv = (2 * w + n) * 16 + c16;
                const float gate = bf2f(gtv[mt][jj][n]);
                Gt[(row0 + i) * DM + 2048 + h * 256 + dv] = f2bf(o[mt][n][jj] * rs * (n ? gn1 : gn0) * silu(gate));
            }
        }
}

DI void s_swa_unit(unsigned char* lds, const bf16_t* H, bf16_t* Gt, const float* ck, const float* cv, const float* sinks, float* kout, float* vout, int u, int tid) {
    const int kvh = u & 3, b = u >> 2;
    float* Kl = (float*)lds;
    float* Vl = Kl + 128 * 65;
    float* Ql = Vl + 128 * 64;
    float* Pl = Ql + 512;
    const int lane = tid & 63, w = tid >> 6;
    const bf16_t* hrow = H + (size_t)(TP + b) * NP;
    __syncthreads();
    {
        float kr[16], vr[16];
#pragma unroll
        for (int i = 0; i < 16; ++i) {
            const int kk = w + 8 * i;
            if (kk < 127) { const size_t o = ((size_t)(b * 128 + kk + 1) * 4 + kvh) * 64 + lane; kr[i] = ck[o]; vr[i] = cv[o]; }
            else { const int p = 2 * (lane & 31) + (lane >> 5); kr[i] = bf2f(hrow[C_SK + kvh * 64 + p]); vr[i] = bf2f(hrow[C_SV + kvh * 64 + lane]); }
        }
#pragma unroll
        for (int i = 0; i < 16; ++i) {
            const int kk = w + 8 * i;
            if (kk < 127) { const size_t oo = ((size_t)(b * 128 + kk) * 4 + kvh) * 64 + lane; kout[oo] = kr[i]; vout[oo] = vr[i]; }
            Kl[kk * 65 + lane] = kr[i]; Vl[kk * 64 + lane] = vr[i];
        }
    }
    { const int p = 2 * (lane & 31) + (lane >> 5); Ql[w * 64 + lane] = bf2f(hrow[C_SQ + (kvh * 8 + w) * 64 + p]); }
    __syncthreads();
    float s0 = 0.f, s1 = 0.f;
    for (int d = 0; d < 64; ++d) { const float qd = Ql[w * 64 + d]; s0 += qd * Kl[lane * 65 + d]; s1 += qd * Kl[(lane + 64) * 65 + d]; }
    const float sink = sinks[kvh * 8 + w];
    const float mx = fmaxf(wave_max(fmaxf(s0, s1)), sink);
    const float p0 = __expf(s0 - mx), p1 = __expf(s1 - mx);
    const float inv = __builtin_amdgcn_rcpf(wave_sum(p0 + p1) + __expf(sink - mx));
    Pl[w * 128 + lane] = p0 * inv; Pl[w * 128 + lane + 64] = p1 * inv;
    __syncthreads();
    float o = 0.f;
    for (int kk = 0; kk < 128; ++kk) o += Pl[w * 128 + kk] * Vl[kk * 64 + lane];
    const float gate = bf2f(hrow[C_SG + (kvh * 8 + w) * 64 + lane]);
    Gt[(size_t)(TP + b) * DM + (kvh * 8 + w) * 64 + lane] = f2bf(o * silu(gate));
}
DI void s_gla_unit(unsigned char* lds, const bf16_t* H, bf16_t* Gt, const float* wg, const float* bg, const float* gng, const float* sin_, float* sout, int u, int tid) {
    const int h = u & 3, b = u >> 2;
    float* gE = (float*)lds; float* qv = gE + 128; float* kv = qv + 128; float* vv = kv + 128; float* Osum = vv + 256; float* red = Osum + 2048;
    const int lane = tid & 63, w = tid >> 6;
    const bf16_t* hrow = H + (size_t)(TP + b) * NP;
    __syncthreads();
    if (tid < 128) {
        float z = bg[h * 128 + tid];
#pragma unroll
        for (int r = 0; r < 16; ++r) z += bf2f(hrow[C_LR + r]) * wg[r * 512 + h * 128 + tid];
        gE[tid] = __expf(logsig16(z)); qv[tid] = bf2f(hrow[C_GQ + h * 128 + tid]); kv[tid] = bf2f(hrow[C_GK + h * 128 + tid]);
    }
    if (tid < 256) vv[tid] = bf2f(hrow[C_GV + h * 256 + tid]);
    __syncthreads();
    const float* S0 = sin_ + (size_t)(b * 4 + h) * 128 * 256;
    float* S1 = sout + (size_t)(b * 4 + h) * 128 * 256;
    const f32x4 v4 = *(const f32x4*)(vv + lane * 4);
    f32x4 oacc = {0.f, 0.f, 0.f, 0.f};
    f32x4 srow[16];
#pragma unroll
    for (int r = 0; r < 16; ++r) srow[r] = *(const f32x4*)(S0 + (16 * w + r) * 256 + lane * 4);
#pragma unroll
    for (int r = 0; r < 16; ++r) {
        const int dk = 16 * w + r;
        const f32x4 sv = srow[r] * gE[dk] + v4 * kv[dk];
        *(f32x4*)(S1 + dk * 256 + lane * 4) = sv;
        oacc += sv * qv[dk];
    }
    *(f32x4*)(Osum + w * 256 + lane * 4) = oacc;
    __syncthreads();
    float o = 0.f;
    if (tid < 256) {
#pragma unroll
        for (int ww = 0; ww < 8; ++ww) o += Osum[ww * 256 + tid];
        const float q = wave_sum(o * o);
        if (lane == 0) red[w] = q;
    }
    __syncthreads();
    if (tid < 256) {
        const float rs = __builtin_amdgcn_rsqf((red[0] + red[1] + red[2] + red[3]) * (1.f / 256.f) + EPS);
        const float gate = bf2f(hrow[C_GG + h * 256 + tid]);
        Gt[(size_t)(TP + b) * DM + 2048 + h * 256 + tid] = f2bf(o * rs * gng[h * 256 + tid] * silu(gate));
    }
}
DI void s_mem_unit(unsigned char* lds, const bf16_t* H, bf16_t* Gt, const float* mk, const float* mv, int u, int tid) {
    const int h = u & 3, b = u >> 2;
    float* Sc = (float*)lds; float* Osum = Sc + 256;
    const int lane = tid & 63, w = tid >> 6;
    const bf16_t* hrow = H + (size_t)(TP + b) * NP;
    __syncthreads();
    const u32x2 qw = *(const u32x2*)(hrow + C_MQ + h * 256 + lane * 4);
    const f32x4 q4 = {bflo(qw.x), bfhi(qw.x), bflo(qw.y), bfhi(qw.y)};
    const float* kbase = mk + ((size_t)(b * 256 + w * 32) * 4 + h) * 256 + lane * 4;
    const float* vbase = mv + ((size_t)(b * 256 + w * 32) * 4 + h) * 256 + lane * 4;
    float vals[32];
    {
        f32x4 kr[32];
#pragma unroll
        for (int r = 0; r < 32; ++r) kr[r] = *(const f32x4*)(kbase + (size_t)r * 1024);
#pragma unroll
        for (int r = 0; r < 32; ++r) vals[r] = (q4[0] * kr[r][0] + q4[1] * kr[r][1]) + (q4[2] * kr[r][2] + q4[3] * kr[r][3]);
    }
#pragma unroll
    for (int i = 0; i < 16; ++i) { const bool hi = lane & 32; const float send = hi ? vals[i] : vals[i + 16], keep = hi ? vals[i + 16] : vals[i]; vals[i] = keep + __shfl_xor(send, 32); }
#pragma unroll
    for (int i = 0; i < 8; ++i) { const bool hi = lane & 16; const float send = hi ? vals[i] : vals[i + 8], keep = hi ? vals[i + 8] : vals[i]; vals[i] = keep + __shfl_xor(send, 16); }
#pragma unroll
    for (int i = 0; i < 4; ++i) { const bool hi = lane & 8; const float send = hi ? vals[i] : vals[i + 4], keep = hi ? vals[i + 4] : vals[i]; vals[i] = keep + __shfl_xor(send, 8); }
#pragma unroll
    for (int i = 0; i < 2; ++i) { const bool hi = lane & 4; const float send = hi ? vals[i] : vals[i + 2], keep = hi ? vals[i + 2] : vals[i]; vals[i] = keep + __shfl_xor(send, 4); }
    { const bool hi = lane & 2; const float send = hi ? vals[0] : vals[1], keep = hi ? vals[1] : vals[0]; vals[0] = keep + __shfl_xor(send, 2); }
    vals[0] += __shfl_xor(vals[0], 1);
    if ((lane & 1) == 0) Sc[w * 32 + (lane >> 1)] = vals[0];
    f32x4 vr[32];
#pragma unroll
    for (int r = 0; r < 32; ++r) vr[r] = *(const f32x4*)(vbase + (size_t)r * 1024);
    __syncthreads();
    const f32x4 sv = *(const f32x4*)(Sc + lane * 4);
    const float mx = wave_max(fmaxf(fmaxf(sv[0], sv[1]), fmaxf(sv[2], sv[3])));
    const float inv = __builtin_amdgcn_rcpf(wave_sum((__expf(sv[0] - mx) + __expf(sv[1] - mx)) + (__expf(sv[2] - mx) + __expf(sv[3] - mx))));
    f32x4 oacc = {0.f, 0.f, 0.f, 0.f};
#pragma unroll
    for (int r = 0; r < 32; ++r) oacc += vr[r] * (__expf(Sc[w * 32 + r] - mx) * inv);
    *(f32x4*)(Osum + w * 256 + lane * 4) = oacc;
    __syncthreads();
    if (tid < 256) {
        float o = 0.f;
#pragma unroll
        for (int ww = 0; ww < 8; ++ww) o += Osum[ww * 256 + tid];
        const float gate = bf2f(hrow[C_MG + h * 256 + tid]);
        Gt[(size_t)(TP + b) * DM + 3072 + h * 256 + tid] = f2bf(o * silu(gate));
    }
}

#ifndef MK_ONE_LAUNCH
#define MK_ONE_LAUNCH 1
#endif
constexpr int N_PHASES = 12;
#ifndef PH_MASK
#define PH_MASK 0xFFFF
#endif
#define PHM(b) ((PH_MASK >> (b)) & 1)
#ifndef DUP_PH
#define DUP_PH 0
#endif
#ifndef DUP_SEL
#define DUP_SEL 0
#endif
#ifndef DUP_SYNC
#define DUP_SYNC 0
#endif
#ifndef DUP_P0
#define DUP_P0 0
#endif

__global__ void __launch_bounds__(512, 2) mk_fwd(Args a) {
    extern __shared__ __attribute__((aligned(16))) unsigned char lds[];
    const int G = gridDim.x, bid = blockIdx.x;
    unsigned char* ws = a.ws;
    bf16_t* XN = (bf16_t*)(ws + WS_XN);
    bf16_t* Hb = (bf16_t*)(ws + WS_H);
    bf16_t* Gt = (bf16_t*)(ws + WS_G);
    float* X1 = (float*)(ws + WS_X1);
    float* rope = (float*)(ws + WS_ROPE);
    float* RSq = (float*)(ws + WS_RS);
    const float* x_prompt = a.in[0]; const float* mem_prompt = a.in[1]; const float* x_sample = a.in[2];
    volatile LAS unsigned* bst = (volatile LAS unsigned*)((LAS unsigned char*)lds + (LDS_BYTES - 16));
    if (threadIdx.x < 4) bst[threadIdx.x] = 0u;
    __syncthreads();
    XcdBarrier xbar = xcd_barrier_post((unsigned*)(ws + WS_CTL), bst);
#define GRID_SYNC() xcd_barrier(xbar)

    if (a.ph_lo == 0) {
        int tidp = threadIdx.x; asm volatile("" : "+v"(tidp));
        const int tid = tidp, lane = tid & 63, wave = __builtin_amdgcn_readfirstlane(tid >> 6);
        for (int rep0 = 0; rep0 <= DUP_P0; ++rep0) if (PHM(0)) {
            float* scr = (float*)(lds + wave * 16640);
            const int gw = bid * 8 + wave, NGW = G * 8;
            constexpr int I_IN = 64 * 153, I_OUT = 64 * 64, I_MEM = 64 * 32, I_L = I_IN + I_OUT + I_MEM;
            auto mk_item = [&](int it) {
                TrItem t; const int l = it / I_L; int r = it - l * I_L;
                if (r < I_IN) { t.W = a.in[9] + (size_t)l * DM * NIN; t.WT = (bf16_t*)(ws + WS_WIN + l * SZ_WIN); t.N = NIN; t.item = r; t.inmap = 1; return t; }
                r -= I_IN;
                if (r < I_OUT) { t.W = a.in[16] + (size_t)l * DM * DM; t.WT = (bf16_t*)(ws + WS_WOUT + l * SZ_WOUT); t.N = DM; t.item = r; t.inmap = 0; return t; }
                r -= I_OUT;
                t.W = a.in[15] + (size_t)l * DM * 2048; t.WT = (bf16_t*)(ws + WS_WMEM + l * SZ_WMEM); t.N = 2048; t.item = r; t.inmap = 0; return t;
            };
            {
                int it = gw;
                f32x4 tv[16];
                TrItem cur = mk_item(it < 2 * I_L ? it : 0);
                if (it < 2 * I_L) tr_load(cur, tv, lane);
                while (it < 2 * I_L) {
                    const int nx = it + NGW;
                    f32x4 tn[16]; TrItem nxt = cur;
                    if (nx < 2 * I_L) { nxt = mk_item(nx); tr_load(nxt, tn, lane); }
                    tr_store(cur, tv, scr, lane);
#pragma unroll
                    for (int i = 0; i < 16; ++i) tv[i] = tn[i];
                    cur = nxt; it = nx;
                }
            }
            for (int i = bid * 512 + tid; i < 2 * 240 * 512; i += G * 512) {
                const int l = i / (240 * 512), r = i - l * 240 * 512;
                ((u32x4*)(ws + WS_WIN + l * SZ_WIN + (size_t)NIN * DM * 2))[r] = (u32x4){0u, 0u, 0u, 0u};
            }
            for (int i = bid * 512 + tid; i < 2049 * 32; i += G * 512) rope_entry(rope, i);
            for (int i = bid * 512 + tid; i < 2 * MR; i += G * 512) RSq[i] = 0.f;
            for (int m = gw; m < MREAL + 2048; m += NGW) {
                if (m < TP) norm_row(x_prompt + (size_t)m * DM, a.in[8], XN + (size_t)m * DM, nullptr, lane);
                else if (m < MREAL) norm_row(x_sample + (size_t)(m - TP) * DM, a.in[8], XN + (size_t)m * DM, nullptr, lane);
                else { const int mm = m - MREAL, l = mm >> 10, r = mm & 1023;
                       norm_row(mem_prompt + (size_t)r * DM, a.in[14] + l * DM, (bf16_t*)(ws + WS_MN + l * SZ_MN) + (size_t)r * DM, nullptr, lane); }
            }
        }
        if (a.ph_hi > 1) GRID_SYNC();
        if (a.ph_hi > 1000) cg::this_grid().sync();
    }
    for (int ph = a.ph_lo < 1 ? 1 : a.ph_lo, rep = 0; ph < a.ph_hi; ) {
        int tidp = threadIdx.x; asm volatile("" : "+v"(tidp));
        const int tid = tidp, lane = tid & 63, wave = __builtin_amdgcn_readfirstlane(tid >> 6);
        {
            const int l = (ph - 1) / 6, k = (ph - 1) % 6;
            if (k == 5 && l == 0) { ++ph; continue; }
            if (k == 0) {
                if (PHM(1)) {
                    pg8::Gemm g{XN, (const bf16_t*)(ws + WS_WIN + l * SZ_WIN), TP, NP, DM};
                    pg8::StaticOrder S; S.init(TP, NP, G, bid);
                    EpiIn E{Hb, rope, a.out + O_KP + (size_t)l * 131072, a.out + O_VP + (size_t)l * 131072, l == 0 ? nullptr : RSq};
                    pg8::gemm_phase<EpiIn, pg8::StaticOrder, true, true>((PG8_LAS unsigned char*)lds, g, S, E);
                }
                if (PHM(2)) {
                    pg8::Gemm g{(const bf16_t*)(ws + WS_MN + l * SZ_MN), (const bf16_t*)(ws + WS_WMEM + l * SZ_WMEM), 1024, 2048, DM};
                    const int nwg1 = (TP / 256) * (NP / 256);
                    pg8::StaticOrder S; S.init(1024, 2048, G, (bid + G - (nwg1 % G)) % G);
                    EpiMem E{(bf16_t*)(ws + WS_MKV + l * SZ_MKV), a.out + O_MKP + (size_t)l * 1048576, a.out + O_MVP + (size_t)l * 1048576};
                    pg8::gemm_phase<EpiMem, pg8::StaticOrder, true, true>((PG8_LAS unsigned char*)lds, g, S, E);
                }
            } else if (k >= 1 && k <= 3) {
                const float* sinks = a.in[10] + l * 32;
                const float* wg = a.in[11] + l * 16 * 512; const float* bg = a.in[12] + l * 512; const float* gng = a.in[13] + l * 1024;
                const bf16_t* MKV = (const bf16_t*)(ws + WS_MKV + l * SZ_MKV);
                f32x4* Ug = (f32x4*)(ws + WS_U); u32x4* SF = (u32x4*)(ws + WS_SF); unsigned char* IMG = ws + WS_IMG; float* EBLg = (float*)(ws + WS_EBL);
                unsigned* qctr = (unsigned*)(ws + WS_CTL) + 8192 + (ph * 2 + rep) * 64;
#define QUEUE_LOOP_BEGIN(NTOT) { int u = bid; while (u < (NTOT)) { unsigned nxt_ = 0u; if (threadIdx.x == 0) nxt_ = atomicAdd(qctr, 1u) + (unsigned)G;
#define QUEUE_LOOP_END() __syncthreads(); if (threadIdx.x == 0) bst[2] = nxt_; __syncthreads(); u = (int)bst[2]; } }
                if (k == 1) {
                    EpiInS ES{Hb, rope, a.out + O_KS + (size_t)l * 1048576, a.out + O_VS + (size_t)l * 1048576, l == 0 ? nullptr : RSq};
                    QUEUE_LOOP_BEGIN(256 + 512 + NP / 32)
                        int tid = tidp; asm volatile("" : "+v"(tid));
                        if (u < 256) { if (PHM(4)) mem_unit(lds, Hb, MKV, Gt, u, tid); }
                        else if (u < 768) { if (PHM(3)) gla_prep_unit(lds, Hb, wg, bg, Ug, EBLg, IMG, u - 256, tid); }
                        else skinny_task<EpiInS>(lds, XN + (size_t)TP * DM, (const bf16_t*)(ws + WS_WIN + l * SZ_WIN), u - 768, tid, ES);
                    QUEUE_LOOP_END()
                } else if (k == 2) {
                    const bool dsel = (DUP_SEL != 0 && rep == 1 && ph == DUP_PH);
                    if (PHM(3) && (!dsel || DUP_SEL == 5)) { for (int tt = bid * 8 + wave; tt < 2048; tt += G * 8) gla_scan_task(Ug, EBLg, (u32x2*)SF, a.out + O_SP + (size_t)l * 524288, tt, lane); }
                    QUEUE_LOOP_BEGIN(256 + 384)
                        int tid = tidp; asm volatile("" : "+v"(tid));
                        const int utype = u < 256 ? 1 : (u < 384 ? 2 : (u < 512 ? 3 : 4));
                        if (dsel && utype != DUP_SEL) {}
                        else if (u < 256) { if (PHM(5)) swa_unit(lds, Hb, Gt, sinks, u, tid); }
                        else if (!PHM(6)) {}
                        else if (u < 384) s_mem_unit(lds, Hb, Gt, a.in[6] + (size_t)l * 8388608, a.in[7] + (size_t)l * 8388608, u - 256, tid);
                        else if (u < 512) s_gla_unit(lds, Hb, Gt, wg, bg, gng, a.in[5] + (size_t)l * 4194304, a.out + O_SS + (size_t)l * 4194304, u - 384, tid);
                        else s_swa_unit(lds, Hb, Gt, a.in[3] + (size_t)l * 1048576, a.in[4] + (size_t)l * 1048576, sinks, a.out + O_KS + (size_t)l * 1048576, a.out + O_VS + (size_t)l * 1048576, u - 512, tid);
                    QUEUE_LOOP_END()
                } else {
                    EpiResS ES{l == 0 ? x_sample : X1 + (size_t)TP * DM, (l == 0 ? X1 : a.out) + (size_t)TP * DM, l == 0 ? a.in[8] + DM : a.in[17], XN, RSq + l * MR, l};
                    QUEUE_LOOP_BEGIN(512 + DM / 32)
                        int tid = tidp; asm volatile("" : "+v"(tid));
                        if (u < 512) { if (PHM(3)) gla_out_unit(lds, Hb, Gt, gng, SF, IMG, u, tid); }
                        else skinny_task<EpiResS>(lds, Gt + (size_t)TP * DM, (const bf16_t*)(ws + WS_WOUT + l * SZ_WOUT), u - 512, tid, ES);
                    QUEUE_LOOP_END()
                }
                __syncthreads();
            } else if (k == 4) { if (PHM(7)) {
                pg8::Gemm g{Gt, (const bf16_t*)(ws + WS_WOUT + l * SZ_WOUT), TP, DM, DM};
                PanelOrder S; S.init(G, bid);
                if (l == 0) {
                    EpiRes E{x_prompt, X1, a.in[8] + DM, XN, RSq, 0};
                    pg8::gemm_phase<EpiRes, PanelOrder, true, true>((PG8_LAS unsigned char*)lds, g, S, E);
                } else {
                    if (bid < TS) {
                        const int row = TP + bid;
                        const float rs = __builtin_amdgcn_rsqf(RSq[MR + row] * (1.f / DM) + EPS);
                        f32x4* yr = (f32x4*)(a.out + (size_t)row * DM);
                        const f32x4 y0 = yr[tid], y1 = yr[tid + 512];
                        yr[tid] = y0 * rs; yr[tid + 512] = y1 * rs;
                    }
                    EpiFin E{X1, a.out, a.in[17], RSq + MR, (unsigned*)(ws + WS_CTL) + 4096};
                    pg8::gemm_phase<EpiFin, PanelOrder, true, true>((PG8_LAS unsigned char*)lds, g, S, E);
                }
            } } else if (PHM(8)) {
                const int gw = bid * 8 + wave, NGW = G * 8;
                for (int m = gw; m < MREAL; m += NGW) {
                    if (l == 0) norm_row(X1 + (size_t)m * DM, a.in[8] + DM, XN + (size_t)m * DM, nullptr, lane);
                    else {
                        const float rs = __builtin_amdgcn_rsqf(RSq[MR + m] * (1.f / DM) + EPS);
                        f32x4* yr = (f32x4*)(a.out + (size_t)m * DM) + lane;
                        f32x4 yv[16];
#pragma unroll
                        for (int j = 0; j < 16; ++j) yv[j] = yr[64 * j];
#pragma unroll
                        for (int j = 0; j < 16; ++j) yr[64 * j] = yv[j] * rs;
                    }
                }
            }
        }
        if (ph + 1 < a.ph_hi) { GRID_SYNC(); if (DUP_SYNC) { GRID_SYNC(); } }
        if (DUP_PH != 0 && ph == DUP_PH && rep == 0) rep = 1; else ++ph;
    }
}

extern "C" void kernel_launch(void* const* d_in, const int* in_sizes, int n_in, void* d_out, int out_size, void* d_ws, size_t ws_size, hipStream_t stream) {
    static int grid = 0;
    if (grid == 0) {
        if (n_in != 18 || (size_t)out_size != O_END || ws_size < WS_END) { fprintf(stderr, "kernel_launch: unexpected shapes (n_in %d, out %d, ws %zu); nothing launched\n", n_in, out_size, ws_size); grid = -1; return; }
        int dev = 0, cus = 0, per_cu = 0;
        if (hipGetDevice(&dev) != hipSuccess || hipDeviceGetAttribute(&cus, hipDeviceAttributeMultiprocessorCount, dev) != hipSuccess) { grid = -1; return; }
        if (hipFuncSetAttribute((const void*)mk_fwd, hipFuncAttributeMaxDynamicSharedMemorySize, LDS_BYTES) != hipSuccess) { fprintf(stderr, "kernel_launch: hipFuncSetAttribute failed\n"); grid = -1; return; }
        if (hipOccupancyMaxActiveBlocksPerMultiprocessor(&per_cu, (const void*)mk_fwd, 512, LDS_BYTES) != hipSuccess || per_cu < 1) { fprintf(stderr, "kernel_launch: occupancy query says %d\n", per_cu); per_cu = 1; }
        (void)hipGetLastError();
        grid = cus * per_cu;
    }
    if (grid < 0) return;
    if (hipMemsetAsync((char*)d_ws + WS_CTL, 0, CTL_BYTES, stream) != hipSuccess) { fprintf(stderr, "kernel_launch: memset failed\n"); return; }
    Args a{};
    for (int i = 0; i < 18; ++i) a.in[i] = (const float*)d_in[i];
    a.out = (float*)d_out; a.ws = (unsigned char*)d_ws;
#if MK_ONE_LAUNCH
    a.ph_lo = 0; a.ph_hi = N_PHASES;
    void* args[] = {&a};
    hipError_t e = hipLaunchCooperativeKernel((const void*)mk_fwd, dim3(grid), dim3(512), args, LDS_BYTES, stream);
    if (e != hipSuccess) fprintf(stderr, "kernel_launch: cooperative launch failed: %s (grid %d)\n", hipGetErrorString(e), grid);
#else
    for (int ph = 0; ph < N_PHASES; ++ph) {
        a.ph_lo = ph; a.ph_hi = ph + 1;
        hipLaunchKernelGGL(mk_fwd, dim3(grid), dim3(512), LDS_BYTES, stream, a);
    }
#endif
}
```

```cpp
#include <hip/hip_runtime.h>
#include <hip/hip_cooperative_groups.h>
#include <cstdio>
#include <cstdint>
namespace cg = cooperative_groups;
#define MK_ONE_LAUNCH 1
namespace pg8 {
#define PG8_LAS __attribute__((address_space(3)))
typedef unsigned short bf16_t;
typedef short bf16x8 __attribute__((ext_vector_type(8)));
typedef float f32x4 __attribute__((ext_vector_type(4)));
typedef unsigned u32x4 __attribute__((ext_vector_type(4)));
constexpr int BM = 256, BK = 64, HALF = 128, HTB = HALF * BK * 2  , STAGE_BYTES = 8 * HTB, NXCD = 8, WGM = 8;

__host__ __device__ __forceinline__ int lds_byte(int r, int c) { const int st = (r >> 4) * 2 + (c >> 5), rr = r & 15, cc = c & 31, ob = rr * 64 + cc * 2; return st * 1024 + (ob ^ (((ob >> 9) & 1) << 5)); }
__host__ __device__ __forceinline__ void stage_rc(int b, int& R, int& C) { const int st = b / 1024, sb = b % 1024, swz = sb ^ (((sb >> 9) & 1) << 5); R = (st >> 1) * 16 + swz / 64; C = (st & 1) * 32 + (swz % 64) / 2; }
__host__ __device__ __forceinline__ int perm32(int rho) { const int n = rho >> 4, i = rho & 15; return 8 * (i >> 2) + 4 * n + (i & 3); }

struct Unit { int pm, pn; };
struct Gemm { const bf16_t* A; const bf16_t* Bt; int M, N, K; };

struct StaticOrder {
    int nM, nN, nwg, G, c;
    __host__ __device__ void init(int M, int N, int G_, int c_) { nM = M / BM; nN = N / BM; nwg = nM * nN; G = G_; c = c_; }
    __host__ __device__ bool next(int i, Unit& u) const {
        const long L = (long)i * G + c; if (L >= nwg) return false;
        int wgid = (int)L; { const int q = nwg / NXCD, r = nwg % NXCD, xcd = wgid % NXCD, off = wgid / NXCD; wgid = (xcd < r ? xcd * (q + 1) : r * (q + 1) + (xcd - r) * q) + off; }
        const int nig = WGM * nN, gid = wgid / nig, fm = gid * WGM, gsz = (nM - fm) < WGM ? (nM - fm) : WGM;
        u.pm = fm + ((wgid % nig) % gsz); u.pn = (wgid % nig) / gsz; return true;
    }
    __device__ __forceinline__ void a_ready(const Unit&) const {}
    __device__ __forceinline__ void done(const Unit&) const {}
};

__device__ __forceinline__ unsigned cvt_pk_bf16(float lo, float hi) { unsigned r; asm volatile("v_cvt_pk_bf16_f32 %0, %1, %2" : "=v"(r) : "v"(lo), "v"(hi)); return r; }
typedef float f32x2 __attribute__((ext_vector_type(2)));
template <class Epi, class Sched, bool ALIGN_EPI = false, bool SP2 = false>
__device__ __forceinline__ void gemm_phase(PG8_LAS unsigned char* lds, const Gemm g, const Sched& S, const Epi& E) {
    int tid_ = threadIdx.x; asm volatile("" : "+v"(tid_));
    const int tid = tid_, wid = __builtin_amdgcn_readfirstlane(tid >> 6), lane = tid & 63, wr = wid >> 2, wc = wid & 3, fr = lane & 15, fq = lane >> 4;
    const int K = g.K, nt = K / BK;
    unsigned voffA[2], voffB[2];
#pragma unroll
    for (int i = 0; i < 2; ++i) { int R, C; stage_rc(tid * 16 + i * 8192, R, C); const int Rb = Epi::PERM ? ((R & ~31) + perm32(R & 31)) : R;
        voffA[i] = (unsigned)(R * K + C) * 2u; voffB[i] = (unsigned)(Rb * K + C) * 2u; }
    const size_t kstep = (size_t)(BK * 2);
    const size_t hstep = (size_t)HALF * K * 2;
    const size_t tstep = 2 * hstep;
    const unsigned ldsw = (unsigned)wid * 1024u;
    const int aoff = lds_byte(wr * 64 + fr, fq * 8), boff = lds_byte(wc * 32 + fr, fq * 8);
#define PG8_SA(b, h) (((b) * 2 + (h)) * HTB)
#define PG8_SB(b, h) ((4 + (b) * 2 + (h)) * HTB)
#define PG8_STAGE(bufoff, gbase, voff) do { _Pragma("unroll") for (int _i = 0; _i < 2; ++_i) \
        __builtin_amdgcn_global_load_lds((const unsigned*)((const char*)(gbase) + (voff)[_i]), (PG8_LAS unsigned*)(lds + (bufoff) + ldsw + _i * 8192), 16, 0, 0); } while (0)
#define PG8_LDA(dst, b, h) do { _Pragma("unroll") for (int m = 0; m < 4; ++m) _Pragma("unroll") for (int k = 0; k < 2; ++k) dst[m][k] = *(const PG8_LAS bf16x8*)(lds + PG8_SA(b, h) + aoff + m * 2048 + k * 1024); } while (0)
#define PG8_LDB(dst, b, h) do { _Pragma("unroll") for (int n = 0; n < 2; ++n) _Pragma("unroll") for (int k = 0; k < 2; ++k) dst[n][k] = *(const PG8_LAS bf16x8*)(lds + PG8_SB(b, h) + boff + n * 2048 + k * 1024); } while (0)
#define PG8_MMA(ai, bj, At, Bt) do { __builtin_amdgcn_s_setprio(1); _Pragma("unroll") for (int m = 0; m < 4; ++m) _Pragma("unroll") for (int n = 0; n < 2; ++n) _Pragma("unroll") for (int k = 0; k < 2; ++k) \
        acc[ai][bj][m][n] = __builtin_amdgcn_mfma_f32_16x16x32_bf16(Bt[n][k], At[m][k], acc[ai][bj][m][n], 0, 0, 0); __builtin_amdgcn_s_setprio(0); } while (0)
#define PG8_WAIT_V(n) asm volatile("s_waitcnt vmcnt(" #n ")" ::: "memory")
#define PG8_WAIT_L(n) asm volatile("s_waitcnt lgkmcnt(" #n ")" ::: "memory")
#define PG8_BAR __builtin_amdgcn_s_barrier()
#define PG8_SCHED __builtin_amdgcn_sched_barrier(0)
    Unit cur, nxt; int ui = 0;
    if (!S.next(0, cur)) return;
    f32x4 acc[2][2][4][2];
#pragma unroll
    for (int a = 0; a < 2; ++a)
#pragma unroll
        for (int b = 0; b < 2; ++b)
#pragma unroll
            for (int m = 0; m < 4; ++m)
#pragma unroll
                for (int n = 0; n < 2; ++n) acc[a][b][m][n] = (f32x4){0.f, 0.f, 0.f, 0.f};
    bf16x8 At[4][2], B0[2][2], B1[2][2];
    const char* cA = (const char*)g.A + (size_t)cur.pm * tstep; const char* cB = (const char*)g.Bt + (size_t)cur.pn * tstep;
    S.a_ready(cur);
    if constexpr (SP2) {
        PG8_STAGE(PG8_SB(0, 0), cB, voffB); PG8_STAGE(PG8_SB(0, 1), cB + hstep, voffB); PG8_STAGE(PG8_SA(0, 0), cA, voffA); PG8_STAGE(PG8_SA(0, 1), cA + hstep, voffA);
        if (wr == 1) PG8_BAR;
        PG8_WAIT_V(2); PG8_BAR;
        PG8_STAGE(PG8_SB(1, 0), cB + kstep, voffB); PG8_STAGE(PG8_SA(1, 0), cA + kstep, voffA); PG8_STAGE(PG8_SB(1, 1), cB + hstep + kstep, voffB);
        PG8_WAIT_V(6); PG8_BAR;
    } else {
        PG8_STAGE(PG8_SB(0, 0), cB, voffB); PG8_STAGE(PG8_SA(0, 0), cA, voffA); PG8_STAGE(PG8_SB(0, 1), cB + hstep, voffB); PG8_STAGE(PG8_SA(0, 1), cA + hstep, voffA);
        if (wr == 1) PG8_BAR;
        PG8_WAIT_V(4); PG8_BAR;
        PG8_STAGE(PG8_SB(1, 0), cB + kstep, voffB); PG8_STAGE(PG8_SA(1, 0), cA + kstep, voffA); PG8_STAGE(PG8_SB(1, 1), cB + hstep + kstep, voffB);
        PG8_WAIT_V(6); PG8_BAR;
    }
    for (;;) {
        const bool has_next = S.next(ui + 1, nxt);
        const char* nA = has_next ? (const char*)g.A + (size_t)nxt.pm * tstep : cA; const char* nB = has_next ? (const char*)g.Bt + (size_t)nxt.pn * tstep : cB;
        for (int t = 0; t < nt; t += 2) {
            const bool last = (t == nt - 2);
            const char* a1 = cA + (size_t)(t + 1) * kstep;
            const char* a2 = last ? nA : cA + (size_t)(t + 2) * kstep; const char* b2 = last ? nB : cB + (size_t)(t + 2) * kstep;
            const char* a3 = a2 + kstep; const char* b3 = b2 + kstep;
            if (last && has_next) S.a_ready(nxt);
            if constexpr (SP2) {
            PG8_LDB(B0, 0, 0); PG8_LDB(B1, 0, 1); PG8_SCHED; PG8_LDA(At, 0, 0); PG8_STAGE(PG8_SA(1, 1), a1 + hstep, voffA);
            PG8_WAIT_V(8); PG8_WAIT_L(0); PG8_BAR; PG8_MMA(0, 0, At, B0); PG8_MMA(0, 1, At, B1); PG8_BAR; PG8_SCHED;
            PG8_LDA(At, 0, 1); PG8_STAGE(PG8_SB(0, 0), b2, voffB); PG8_STAGE(PG8_SB(0, 1), b2 + hstep, voffB); PG8_STAGE(PG8_SA(0, 0), a2, voffA);
            PG8_WAIT_V(8); PG8_WAIT_L(0); PG8_BAR; PG8_MMA(1, 0, At, B0); PG8_MMA(1, 1, At, B1); PG8_BAR; PG8_SCHED;
            PG8_LDB(B0, 1, 0); PG8_LDB(B1, 1, 1); PG8_SCHED; PG8_LDA(At, 1, 0); PG8_STAGE(PG8_SA(0, 1), a2 + hstep, voffA);
            PG8_WAIT_V(8); PG8_WAIT_L(0); PG8_BAR; PG8_MMA(0, 0, At, B0); PG8_MMA(0, 1, At, B1); PG8_BAR; PG8_SCHED;
            PG8_LDA(At, 1, 1); PG8_STAGE(PG8_SB(1, 0), b3, voffB); PG8_STAGE(PG8_SB(1, 1), b3 + hstep, voffB); PG8_STAGE(PG8_SA(1, 0), a3, voffA);
            PG8_WAIT_V(8); PG8_WAIT_L(0); PG8_BAR; PG8_MMA(1, 0, At, B0); PG8_MMA(1, 1, At, B1); PG8_BAR; PG8_SCHED;
            } else {
            PG8_LDB(B0, 0, 0); PG8_SCHED; PG8_LDA(At, 0, 0); PG8_STAGE(PG8_SA(1, 1), a1 + hstep, voffA);
            PG8_WAIT_L(8); PG8_BAR; PG8_WAIT_L(0); PG8_MMA(0, 0, At, B0); PG8_BAR; PG8_SCHED;
            PG8_LDB(B1, 0, 1); PG8_STAGE(PG8_SB(0, 0), b2, voffB);
            PG8_BAR; PG8_WAIT_L(0); PG8_MMA(0, 1, At, B1); PG8_BAR;
            PG8_LDA(At, 0, 1); PG8_STAGE(PG8_SA(0, 0), a2, voffA);
            PG8_BAR; PG8_WAIT_L(0); PG8_MMA(1, 0, At, B0); PG8_BAR; PG8_SCHED;
            PG8_STAGE(PG8_SB(0, 1), b2 + hstep, voffB);
            PG8_WAIT_V(6); PG8_BAR; PG8_MMA(1, 1, At, B1); PG8_BAR;
            PG8_LDB(B0, 1, 0); PG8_SCHED; PG8_LDA(At, 1, 0); PG8_STAGE(PG8_SA(0, 1), a2 + hstep, voffA);
            PG8_WAIT_L(8); PG8_BAR; PG8_WAIT_L(0); PG8_MMA(0, 0, At, B0); PG8_BAR; PG8_SCHED;
            PG8_LDB(B1, 1, 1); PG8_STAGE(PG8_SB(1, 0), b3, voffB);
            PG8_BAR; PG8_WAIT_L(0); PG8_MMA(0, 1, At, B1); PG8_BAR;
            PG8_LDA(At, 1, 1); PG8_STAGE(PG8_SA(1, 0), a3, voffA);
            PG8_BAR; PG8_WAIT_L(0); PG8_MMA(1, 0, At, B0); PG8_BAR; PG8_SCHED;
            PG8_STAGE(PG8_SB(1, 1), b3 + hstep, voffB);
            PG8_WAIT_V(6); PG8_BAR; PG8_MMA(1, 1, At, B1); PG8_BAR;
            }
        }
        if constexpr (ALIGN_EPI) { if (wr == 0) PG8_BAR; }
        if constexpr (!Epi::AFTER_DRAIN) { E(acc, cur, wr, wc, fr, fq); S.done(cur); }
        if (!has_next) break;
#pragma unroll
        for (int a = 0; a < 2; ++a)
#pragma unroll
            for (int b = 0; b < 2; ++b)
#pragma unroll
                for (int m = 0; m < 4; ++m)
#pragma unroll
                    for (int n = 0; n < 2; ++n) acc[a][b][m][n] = (f32x4){0.f, 0.f, 0.f, 0.f};
        cur = nxt; cA = nA; cB = nB; ++ui;
        if constexpr (ALIGN_EPI) { if (wr == 1) PG8_BAR; }
    }
    PG8_WAIT_V(0);
    if constexpr (!ALIGN_EPI) { if (wr == 0) PG8_BAR; }
    PG8_BAR;
    if constexpr (Epi::AFTER_DRAIN) { E.fused(acc, cur, wr, wc, fr, fq, lds, wid, lane); S.done(cur); }
#undef PG8_SA
#undef PG8_SB
#undef PG8_STAGE
#undef PG8_LDA
#undef PG8_LDB
#undef PG8_MMA
#undef PG8_WAIT_V
#undef PG8_WAIT_L
#undef PG8_BAR
#undef PG8_SCHED
}
}
#define LAS __attribute__((address_space(3)))
#define XB_TMO      128
#define XB_XCNT(j)  (256  + 64 * (j))
#define XB_XSUB(j)  (1280 + 64 * (j))
#define XB_XGEN(j)  (2304 + 64 * (j))
#define XB_TOP      3328
#define XB_TOPGEN   3392
#define XCD_BAR_WORDS 3456
#define XB_SPIN_CAP (1u << 18)

__device__ __forceinline__ unsigned xb_ld(unsigned* p)              { return __hip_atomic_load(p, __ATOMIC_RELAXED, __HIP_MEMORY_SCOPE_AGENT); }
__device__ __forceinline__ unsigned xb_add(unsigned* p, unsigned v) { return __hip_atomic_fetch_add(p, v, __ATOMIC_RELAXED, __HIP_MEMORY_SCOPE_AGENT); }
__device__ __forceinline__ unsigned xb_xcc_id() { return (unsigned)__builtin_amdgcn_s_getreg((3 << 11) | 20) & 0xFu; }
#define XB_SPIN(cond, bar) do { unsigned _sp = 0; while (cond) { __builtin_amdgcn_s_sleep(1); \
    if ((++_sp & 255u) == 0u) { if (xb_ld(&(bar)[XB_TMO])) break; if (_sp > XB_SPIN_CAP) { atomicAdd(&(bar)[XB_TMO], 1u); break; } } } } while (0)

struct XcdBarrier {
    unsigned* bar; unsigned x;
    volatile LAS unsigned* st;
};

__device__ __forceinline__ XcdBarrier xcd_barrier_post(unsigned* bar, volatile LAS unsigned* st) {
    XcdBarrier b; b.bar = bar; b.x = xb_xcc_id(); b.st = st;
    if (threadIdx.x == 0) (void)xb_add(&bar[XB_XCNT(b.x)], 1u);
    return b;
}
__device__ __forceinline__ void xcd_barrier_complete(unsigned* bar, unsigned x, unsigned& nloc, unsigned& nx) {
    const unsigned G = gridDim.x * gridDim.y * gridDim.z;
    unsigned sum, cnt, mine, sp = 0u;
    for (;;) {
        sum = 0u; cnt = 0u; mine = 0u;
#pragma unroll
        for (unsigned j = 0; j < 16; ++j) { const unsigned c = xb_ld(&bar[XB_XCNT(j)]); sum += c; cnt += (c > 0u) ? 1u : 0u; mine = (j == x) ? c : mine; }
        if (sum == G) break;
        __builtin_amdgcn_s_sleep(1);
        if ((++sp & 255u) == 0u) { if (xb_ld(&bar[XB_TMO])) break; if (sp > XB_SPIN_CAP) { atomicAdd(&bar[XB_TMO], 1u); break; } }
    }
    nloc = mine > 0u ? mine : 1u; nx = cnt > 0u ? cnt : 1u;
}

__device__ __forceinline__ void xcd_barrier(const XcdBarrier& b) {
    asm volatile("s_waitcnt vmcnt(0)" ::: "memory");
    __syncthreads();
    if (threadIdx.x == 0) {
        unsigned* bar = b.bar;
        __builtin_amdgcn_s_waitcnt(0);
        unsigned nloc = b.st[0], nx = b.st[1];
        if (nloc == 0u) { xcd_barrier_complete(bar, b.x, nloc, nx); b.st[0] = nloc; b.st[1] = nx; }
        const unsigned old = xb_add(&bar[XB_XSUB(b.x)], 1u);
        const unsigned gen = old / nloc;
        if (old + 1u == (gen + 1u) * nloc) {
            __builtin_amdgcn_fence(__ATOMIC_RELEASE, "agent");
            asm volatile("s_waitcnt vmcnt(0)" ::: "memory");
            const unsigned og = xb_add(&bar[XB_TOP], 1u);
            const unsigned tg = og / nx;
            if (og + 1u == (tg + 1u) * nx) xb_add(&bar[XB_TOPGEN], 1u);
            else XB_SPIN(xb_ld(&bar[XB_TOPGEN]) == tg, bar);
            __builtin_amdgcn_fence(__ATOMIC_ACQUIRE, "agent");
            xb_add(&bar[XB_XGEN(b.x)], 1u);
            asm volatile("s_waitcnt vmcnt(0)" ::: "memory");
        } else {
            XB_SPIN(xb_ld(&bar[XB_XGEN(b.x)]) == gen, bar);
            __builtin_amdgcn_fence(__ATOMIC_ACQUIRE, "agent");
            asm volatile("s_waitcnt vmcnt(0)" ::: "memory");
        }
    }
    __syncthreads();
}

#define DI __device__ __forceinline__
typedef unsigned short bf16_t;
typedef short bf16x8 __attribute__((ext_vector_type(8)));
typedef short s16x4 __attribute__((ext_vector_type(4)));
typedef float f32x4 __attribute__((ext_vector_type(4)));
typedef unsigned u32x4 __attribute__((ext_vector_type(4)));
typedef unsigned u32x2 __attribute__((ext_vector_type(2)));
typedef float f32x2_t __attribute__((ext_vector_type(2)));
typedef __bf16 bf16x2_t __attribute__((ext_vector_type(2)));

constexpr int DM = 4096, TP = 8192, SEQ = 2048, NBATCH = 4, TS = 32, MR = 8448, MREAL = 8224, NP = 9984, NIN = 9744;
constexpr int C_SQ = 0, C_SK = 2048, C_SV = 2304, C_SG = 2560, C_GQ = 4608, C_GK = 5120, C_GV = 5632, C_GG = 6656, C_MQ = 7680, C_MG = 8704, C_LR = 9728;
constexpr float EPS = 1e-6f;
constexpr size_t O_YP = 0, O_YS = 33554432, O_KP = 33685504, O_VP = 33947648, O_SP = 34209792, O_MKP = 35258368, O_MVP = 37355520, O_KS = 39452672, O_VS = 41549824, O_SS = 43646976, O_END = 52035584;
constexpr size_t MiB = 1u << 20;
constexpr size_t WS_WIN = 0;
constexpr size_t SZ_WIN = (size_t)NP * DM * 2;
constexpr size_t WS_WOUT = 160 * MiB;
constexpr size_t SZ_WOUT = (size_t)DM * DM * 2;
constexpr size_t WS_WMEM = 224 * MiB;
constexpr size_t SZ_WMEM = (size_t)2048 * DM * 2;
constexpr size_t WS_XN = 256 * MiB;
constexpr size_t WS_MN = 324 * MiB;
constexpr size_t SZ_MN = (size_t)1024 * DM * 2;
constexpr size_t WS_H = 340 * MiB;
constexpr size_t WS_MKV = 502 * MiB;
constexpr size_t SZ_MKV = (size_t)1024 * 2048 * 2;
constexpr size_t WS_G = 510 * MiB;
constexpr size_t WS_X1 = 576 * MiB;
constexpr size_t WS_ROPE = 708 * MiB;
constexpr size_t WS_U = 710 * MiB;
constexpr size_t WS_SF = 774 * MiB;
constexpr size_t WS_IMG = 806 * MiB;
constexpr size_t WS_EBL = 838 * MiB;
constexpr size_t WS_RS = 838 * MiB + 524288;
constexpr size_t WS_CTL = 839 * MiB;
constexpr size_t CTL_BYTES = 65536;
constexpr size_t WS_END = 840 * MiB;
static_assert(WS_WIN + 2 * SZ_WIN <= WS_WOUT && WS_XN + (size_t)MR * DM * 2 <= WS_MN && WS_H + (size_t)MR * NP * 2 <= WS_MKV && WS_G + (size_t)MR * DM * 2 <= WS_X1 && WS_X1 + (size_t)MR * DM * 4 <= WS_ROPE, "ws map");

constexpr int LDS_BYTES = 147456;

DI float bf2f(unsigned short u) { return __uint_as_float((unsigned)u << 16); }
DI float bflo(unsigned w) { return __uint_as_float(w << 16); }
DI float bfhi(unsigned w) { return __uint_as_float(w & 0xffff0000u); }
DI unsigned pk2(float lo, float hi) { f32x2_t v = {lo, hi}; bf16x2_t b = __builtin_convertvector(v, bf16x2_t); return __builtin_bit_cast(unsigned, b); }
DI unsigned short f2bf(float f) { return (unsigned short)(pk2(f, 0.f) & 0xffffu); }
DI float silu(float x) { return x * __builtin_amdgcn_rcpf(1.f + __expf(-x)); }
DI float wave_sum(float v) {
#pragma unroll
    for (int o = 1; o < 64; o <<= 1) v += __shfl_xor(v, o);
    return v;
}
DI float wave_max(float v) {
#pragma unroll
    for (int o = 1; o < 64; o <<= 1) v = fmaxf(v, __shfl_xor(v, o));
    return v;
}
DI f32x4 mfma16(bf16x8 a, bf16x8 b, f32x4 c) { return __builtin_amdgcn_mfma_f32_16x16x32_bf16(a, b, c, 0, 0, 0); }
DI bf16x8 pack8(f32x4 a, f32x4 b) { u32x4 p; p.x = pk2(a[0], a[1]); p.y = pk2(a[2], a[3]); p.z = pk2(b[0], b[1]); p.w = pk2(b[2], b[3]); return __builtin_bit_cast(bf16x8, p); }
DI bf16x8 cat4(s16x4 lo, s16x4 hi) { return __builtin_shufflevector(lo, hi, 0, 1, 2, 3, 4, 5, 6, 7); }

struct Args {
    const float* in[18]; float* out; unsigned char* ws; int ph_lo, ph_hi;
};

struct EpiIn {
    static constexpr bool PERM = true, AFTER_DRAIN = false;
    bf16_t* H; const float* rope; float* kp; float* vp; const float* RSin;
    DI void operator()(const f32x4 (&acc)[2][2][4][2], const pg8::Unit& u, int wr, int wc, int fr, int fq) const {
        const int pn = u.pn;
        const bool do_rope = pn < 9;
        float sc = 1.f;
        if (pn < 8) sc = 0.125f; else if (pn == 18 || pn == 19) sc = 0.08838834764831845f; else if (pn >= 30 && pn < 34) sc = 0.0625f;
        const int row0 = u.pm * 256 + wr * 64 + fr;
        const int colt = wc * 32 + 8 * fq;
#pragma unroll
        for (int ai = 0; ai < 2; ++ai) {
            f32x4 tr[4][2];
#pragma unroll
            for (int m = 0; m < 4; ++m) {
                tr[m][0] = (f32x4){1.f, 0.f, 1.f, 0.f}; tr[m][1] = (f32x4){1.f, 0.f, 1.f, 0.f};
                if (do_rope) {
                    const f32x4* rp = (const f32x4*)(rope + ((size_t)((row0 + ai * 128 + m * 16) & (SEQ - 1)) * 32 + 16 * (wc & 1) + 4 * fq) * 2);
                    tr[m][0] = rp[0]; tr[m][1] = rp[1];
                }
            }
            float rsv[4];
#pragma unroll
            for (int m = 0; m < 4; ++m) { rsv[m] = sc; if (RSin) rsv[m] = sc * __builtin_amdgcn_rsqf(RSin[row0 + ai * 128 + m * 16] * (1.f / DM) + EPS); }
#pragma unroll
            for (int m = 0; m < 4; ++m) {
                const int row = row0 + ai * 128 + m * 16;
                const f32x4 t0 = tr[m][0], t1 = tr[m][1];
#pragma unroll
                for (int bj = 0; bj < 2; ++bj) {
                    f32x4 v0 = acc[ai][bj][m][0], v1 = acc[ai][bj][m][1];
                    if (do_rope) {
                        float a, b;
                        a = v0[0]; b = v0[1]; v0[0] = a * t0[0] - b * t0[1]; v0[1] = b * t0[0] + a * t0[1];
                        a = v0[2]; b = v0[3]; v0[2] = a * t0[2] - b * t0[3]; v0[3] = b * t0[2] + a * t0[3];
                        a = v1[0]; b = v1[1]; v1[0] = a * t1[0] - b * t1[1]; v1[1] = b * t1[0] + a * t1[1];
                        a = v1[2]; b = v1[3]; v1[2] = a * t1[2] - b * t1[3]; v1[3] = b * t1[2] + a * t1[3];
                    }
                    v0 = v0 * rsv[m]; v1 = v1 * rsv[m];
                    u32x4 w4; w4.x = pk2(v0[0], v0[1]); w4.y = pk2(v0[2], v0[3]); w4.z = pk2(v1[0], v1[1]); w4.w = pk2(v1[2], v1[3]);
                    *(u32x4*)(H + (size_t)row * NP + pn * 256 + bj * 128 + colt) = w4;
                    if (pn == 8 || pn == 9) {
                        const int t = row & (SEQ - 1);
                        if (t >= SEQ - 128) {
                            const int kvh = bj * 2 + (wc >> 1);
                            float* dst = (pn == 8 ? kp : vp) + ((size_t)((row >> 11) * 128 + (t - (SEQ - 128))) * 4 + kvh) * 64;
                            if (pn == 8) {
                                const int d0 = 16 * (wc & 1) + 4 * fq;
                                *(f32x4*)(dst + d0) = (f32x4){v0[0], v0[2], v1[0], v1[2]};
                                *(f32x4*)(dst + d0 + 32) = (f32x4){v0[1], v0[3], v1[1], v1[3]};
                            } else {
                                const int p0 = 32 * (wc & 1) + 8 * fq;
                                *(f32x4*)(dst + p0) = v0; *(f32x4*)(dst + p0 + 4) = v1;
                            }
                        }
                    }
                }
            }
        }
    }
};
struct EpiInS {
    bf16_t* H; const float* rope; float* ks; float* vs; const float* RSin;
    DI void operator()(f32x4 v, int m, int n) const {
        const int pn = n >> 8;
        if (pn < 9) {
            const f32x4 t = *(const f32x4*)(rope + ((size_t)SEQ * 32 + ((n & 63) >> 1)) * 2);
            float a, b;
            a = v[0]; b = v[1]; v[0] = a * t[0] - b * t[1]; v[1] = b * t[0] + a * t[1];
            a = v[2]; b = v[3]; v[2] = a * t[2] - b * t[3]; v[3] = b * t[2] + a * t[3];
        }
        float sc = 1.f;
        if (pn < 8) sc = 0.125f; else if (pn == 18 || pn == 19) sc = 0.08838834764831845f; else if (pn >= 30 && pn < 34) sc = 0.0625f;
        if (RSin) sc *= __builtin_amdgcn_rsqf(RSin[TP + m] * (1.f / DM) + EPS);
        v = v * sc;
        u32x2 w2; w2.x = pk2(v[0], v[1]); w2.y = pk2(v[2], v[3]);
        *(u32x2*)(H + (size_t)(TP + m) * NP + n) = w2;
        if (pn == 8) {
            float* dst = ks + ((size_t)(m * 128 + 127) * 4 + ((n - C_SK) >> 6)) * 64; const int d0 = (n & 63) >> 1;
            dst[d0] = v[0]; dst[d0 + 32] = v[1]; dst[d0 + 1] = v[2]; dst[d0 + 33] = v[3];
        } else if (pn == 9) {
            float* dst = vs + ((size_t)(m * 128 + 127) * 4 + ((n - C_SV) >> 6)) * 64 + (n & 63);
            *(f32x4*)dst = v;
        }
    }
};
struct EpiResS {
    const float* base; float* X; const float* gnext; bf16_t* XNo; float* RS; int fin;
    DI void operator()(f32x4 v, int m, int n) const {
        const f32x4 x = *(const f32x4*)(base + (size_t)m * DM + n) + v;
        if (!fin) *(f32x4*)(X + (size_t)m * DM + n) = x;
        if (gnext) {
            const f32x4 y = x * *(const f32x4*)(gnext + n);
            if (fin) *(f32x4*)(X + (size_t)m * DM + n) = y;
            else { u32x2 w2; w2.x = pk2(y[0], y[1]); w2.y = pk2(y[2], y[3]); *(u32x2*)(XNo + (size_t)(TP + m) * DM + n) = w2; }
            float q = (x[0] * x[0] + x[1] * x[1]) + (x[2] * x[2] + x[3] * x[3]);
            q += __shfl_xor(q, 16); q += __shfl_xor(q, 32);
            if (((n >> 2) & 3) == 0) atomicAdd(RS + TP + m, q);
        }
    }
};
template <class EpiS>
DI void skinny_task(unsigned char* lds, const bf16_t* X, const bf16_t* Wt, int task, int tid, const EpiS& E) {
    const int lane = tid & 63, w = tid >> 6, c16 = lane & 15, quad = lane >> 4;
    const int ntl = w & 1, ksp = w >> 1;
    const int n0 = task * 32 + ntl * 16;
    f32x4 acc0 = {0.f, 0.f, 0.f, 0.f}, acc1 = {0.f, 0.f, 0.f, 0.f};
    const bf16_t* wp = Wt + (size_t)(n0 + c16) * DM + ksp * 1024 + quad * 8;
    const bf16_t* xp0 = X + (size_t)c16 * DM + ksp * 1024 + quad * 8;
    const bf16_t* xp1 = xp0 + 16 * DM;
    for (int k0 = 0; k0 < 32; k0 += 16) {
        bf16x8 av[16], b0v[16], b1v[16];
#pragma unroll
        for (int j = 0; j < 16; ++j) { av[j] = *(const bf16x8*)(wp + (k0 + j) * 32); b0v[j] = *(const bf16x8*)(xp0 + (k0 + j) * 32); b1v[j] = *(const bf16x8*)(xp1 + (k0 + j) * 32); }
#pragma unroll
        for (int j = 0; j < 16; ++j) { acc0 = mfma16(av[j], b0v[j], acc0); acc1 = mfma16(av[j], b1v[j], acc1); }
    }
    f32x4* red = (f32x4*)lds;
    __syncthreads();
    red[(w * 2 + 0) * 64 + lane] = acc0; red[(w * 2 + 1) * 64 + lane] = acc1;
    __syncthreads();
    if (w < 2) {
#pragma unroll
        for (int mt = 0; mt < 2; ++mt) {
            f32x4 v = red[((0 * 2 + w) * 2 + mt) * 64 + lane];
#pragma unroll
            for (int kp = 1; kp < 4; ++kp) v += red[((kp * 2 + w) * 2 + mt) * 64 + lane];
            E(v, mt * 16 + c16, n0 + quad * 4);
        }
    }
}
struct EpiMem {
    static constexpr bool PERM = true, AFTER_DRAIN = false;
    bf16_t* MKV; float* outk; float* outv;
    DI void operator()(const f32x4 (&acc)[2][2][4][2], const pg8::Unit& u, int wr, int wc, int fr, int fq) const {
        const int row0 = u.pm * 256 + wr * 64 + fr;
#pragma unroll
        for (int ai = 0; ai < 2; ++ai)
#pragma unroll
            for (int m = 0; m < 4; ++m) {
                const int row = row0 + ai * 128 + m * 16;
#pragma unroll
                for (int bj = 0; bj < 2; ++bj) {
                    const int col = u.pn * 256 + bj * 128 + wc * 32 + 8 * fq;
                    const f32x4 v0 = acc[ai][bj][m][0], v1 = acc[ai][bj][m][1];
                    u32x4 w4; w4.x = pk2(v0[0], v0[1]); w4.y = pk2(v0[2], v0[3]); w4.z = pk2(v1[0], v1[1]); w4.w = pk2(v1[2], v1[3]);
                    *(u32x4*)(MKV + (size_t)row * 2048 + col) = w4;
                    float* dst = (col < 1024) ? (outk + (size_t)row * 1024 + col) : (outv + (size_t)row * 1024 + (col - 1024));
                    *(f32x4*)dst = v0; *(f32x4*)(dst + 4) = v1;
                }
            }
    }
};
struct EpiRes {
    static constexpr bool PERM = true, AFTER_DRAIN = false;
    const float* baseP; float* X; const float* gnext; bf16_t* XNo; float* RS; int fin;
    DI void operator()(const f32x4 (&acc)[2][2][4][2], const pg8::Unit& u, int wr, int wc, int fr, int fq) const {
        const int row0 = u.pm * 256 + wr * 64 + fr;
        const int col0 = u.pn * 256 + wc * 32 + 8 * fq;
        f32x4 gv[2][2];
#pragma unroll
        for (int bj = 0; bj < 2; ++bj) { gv[bj][0] = (f32x4){0.f, 0.f, 0.f, 0.f}; gv[bj][1] = gv[bj][0];
            if (gnext) { gv[bj][0] = *(const f32x4*)(gnext + col0 + bj * 128); gv[bj][1] = *(const f32x4*)(gnext + col0 + bj * 128 + 4); } }
#pragma unroll
        for (int am = 0; am < 4; ++am) {
            const int ai = am >> 1, mb = (am & 1) * 2;
            f32x4 bv[2][2][2];
#pragma unroll
            for (int mm = 0; mm < 2; ++mm)
#pragma unroll
                for (int bj = 0; bj < 2; ++bj) {
                    const float* bp = baseP + (size_t)(row0 + ai * 128 + (mb + mm) * 16) * DM + col0 + bj * 128;
                    bv[mm][bj][0] = *(const f32x4*)bp; bv[mm][bj][1] = *(const f32x4*)(bp + 4);
                }
#pragma unroll
            for (int mm = 0; mm < 2; ++mm) {
                const int m = mb + mm;
                const int row = row0 + ai * 128 + m * 16;
                float q = 0.f;
#pragma unroll
                for (int bj = 0; bj < 2; ++bj) {
                    float* xp = X + (size_t)row * DM + col0 + bj * 128;
                    const f32x4 x0 = bv[mm][bj][0] + acc[ai][bj][m][0], x1 = bv[mm][bj][1] + acc[ai][bj][m][1];
                    if (!fin) { *(f32x4*)xp = x0; *(f32x4*)(xp + 4) = x1; }
                    if (gnext) {
                        const f32x4 y0 = x0 * gv[bj][0], y1 = x1 * gv[bj][1];
                        if (fin) { *(f32x4*)xp = y0; *(f32x4*)(xp + 4) = y1; }
                        else { u32x4 w4; w4.x = pk2(y0[0], y0[1]); w4.y = pk2(y0[2], y0[3]); w4.z = pk2(y1[0], y1[1]); w4.w = pk2(y1[2], y1[3]);
                               *(u32x4*)(XNo + (size_t)row * DM + col0 + bj * 128) = w4; }
                        q += ((x0[0] * x0[0] + x0[1] * x0[1]) + (x0[2] * x0[2] + x0[3] * x0[3])) + ((x1[0] * x1[0] + x1[1] * x1[1]) + (x1[2] * x1[2] + x1[3] * x1[3]));
                    }
                }
                if (gnext) { q += __shfl_xor(q, 16); q += __shfl_xor(q, 32); if (fq == 0) atomicAdd(RS + row, q); }
            }
        }
    }
};

struct EpiFin {
    static constexpr bool PERM = true, AFTER_DRAIN = false;
    const float* baseP; float* Y; const float* g; float* RS; unsigned* pcnt;
    DI void operator()(const f32x4 (&acc_)[2][2][4][2], const pg8::Unit& u, int wr, int wc, int fr, int fq) const {
        f32x4 (&acc)[2][2][4][2] = const_cast<f32x4 (&)[2][2][4][2]>(acc_);
        const int row0 = u.pm * 256 + wr * 64 + fr;
        const int col0 = u.pn * 256 + wc * 32 + 8 * fq;
        f32x4 gv[2][2];
#pragma unroll
        for (int bj = 0; bj < 2; ++bj) { gv[bj][0] = *(const f32x4*)(g + col0 + bj * 128); gv[bj][1] = *(const f32x4*)(g + col0 + bj * 128 + 4); }
#pragma unroll
        for (int am = 0; am < 4; ++am) {
            const int ai = am >> 1, mb = (am & 1) * 2;
            f32x4 bv[2][2][2];
#pragma unroll
            for (int mm = 0; mm < 2; ++mm)
#pragma unroll
                for (int bj = 0; bj < 2; ++bj) {
                    const float* bp = baseP + (size_t)(row0 + ai * 128 + (mb + mm) * 16) * DM + col0 + bj * 128;
                    bv[mm][bj][0] = *(const f32x4*)bp; bv[mm][bj][1] = *(const f32x4*)(bp + 4);
                }
#pragma unroll
            for (int mm = 0; mm < 2; ++mm) {
                const int m = mb + mm;
                float q = 0.f;
#pragma unroll
                for (int bj = 0; bj < 2; ++bj) {
                    const f32x4 x0 = bv[mm][bj][0] + acc[ai][bj][m][0], x1 = bv[mm][bj][1] + acc[ai][bj][m][1];
                    q += ((x0[0] * x0[0] + x0[1] * x0[1]) + (x0[2] * x0[2] + x0[3] * x0[3])) + ((x1[0] * x1[0] + x1[1] * x1[1]) + (x1[2] * x1[2] + x1[3] * x1[3]));
                    acc[ai][bj][m][0] = x0 * gv[bj][0]; acc[ai][bj][m][1] = x1 * gv[bj][1];
                }
                q += __shfl_xor(q, 16); q += __shfl_xor(q, 32);
                if (fq == 0) atomicAdd(RS + row0 + ai * 128 + m * 16, q);
            }
        }
        asm volatile("s_waitcnt vmcnt(0)" ::: "memory");
        unsigned* pc = pcnt + 64 * u.pm;
        if (fr == 0 && fq == 0) __hip_atomic_fetch_add(pc, 1u, __ATOMIC_RELAXED, __HIP_MEMORY_SCOPE_AGENT);
        { unsigned sp = 0; while (__hip_atomic_load(pc, __ATOMIC_RELAXED, __HIP_MEMORY_SCOPE_AGENT) < 128u) { __builtin_amdgcn_s_sleep(2); if (++sp > (1u << 21)) break; } }
        asm volatile("" ::: "memory");
#pragma unroll
        for (int ai = 0; ai < 2; ++ai)
#pragma unroll
            for (int m = 0; m < 4; ++m) {
                const int row = row0 + ai * 128 + m * 16;
                const float rs = __builtin_amdgcn_rsqf(__hip_atomic_load(RS + row, __ATOMIC_RELAXED, __HIP_MEMORY_SCOPE_AGENT) * (1.f / DM) + EPS);
#pragma unroll
                for (int bj = 0; bj < 2; ++bj) {
                    float* yp = Y + (size_t)row * DM + col0 + bj * 128;
                    *(f32x4*)yp = acc[ai][bj][m][0] * rs; *(f32x4*)(yp + 4) = acc[ai][bj][m][1] * rs;
                }
            }
    }
};
struct PanelOrder {
    int G, c;
    DI void init(int G_, int c_) { G = G_; c = c_; }
    DI bool next(int i, pg8::Unit& u) const {
        if (G == 256) { if (i >= 2) return false; const int xcd = c & 7, r = c >> 3, j = xcd >> 1, hx = xcd & 1; u.pm = 16 * i + 4 * j + (r & 3); u.pn = 8 * hx + (r >> 2); return true; }
        const long L = (long)i * G + c; if (L >= 512) return false; u.pm = (int)(L >> 4); u.pn = (int)(L & 15); return true;
    }
    DI void a_ready(const pg8::Unit&) const {}
    DI void done(const pg8::Unit&) const {}
};

DI int dst_row_in(int s) {
    if (s < 2304) { const int d = s & 63; return (s & ~63) + 2 * (d & 31) + (d >> 5); }
    if (s < 6656) return s;
    if (s < 6672) return 9728 + (s - 6656);
    return s - 16;
}
struct TrItem { const float* W; bf16_t* WT; int N, item, inmap; };
DI void tr_load(const TrItem& t, f32x4 (&tv)[16], int lane) {
    const int nblk = (t.N + 63) >> 6, kb = t.item / nblk, nb = t.item - kb * nblk, k0 = 64 * kb, n0 = 64 * nb;
    const int cl = (lane & 15) * 4, rl = lane >> 4;
    const bool okc = (n0 + cl) < t.N;
#pragma unroll
    for (int i = 0; i < 16; ++i) { tv[i] = (f32x4){0.f, 0.f, 0.f, 0.f}; if (okc) tv[i] = *(const f32x4*)(t.W + (size_t)(k0 + 4 * i + rl) * t.N + n0 + cl); }
}
DI void tr_store(const TrItem& t, const f32x4 (&tv)[16], float* scr, int lane) {
    const int nblk = (t.N + 63) >> 6, kb = t.item / nblk, nb = t.item - kb * nblk, k0 = 64 * kb, n0 = 64 * nb;
    const int cl = (lane & 15) * 4, rl = lane >> 4;
#pragma unroll
    for (int i = 0; i < 16; ++i) { float* s = scr + (4 * i + rl) * 65 + cl; s[0] = tv[i][0]; s[1] = tv[i][1]; s[2] = tv[i][2]; s[3] = tv[i][3]; }
    asm volatile("s_waitcnt lgkmcnt(0)" ::: "memory");
    const int c = lane & 7;
#pragma unroll
    for (int j = 0; j < 8; ++j) {
        const int n = (lane >> 3) + 8 * j;
        if (n0 + n < t.N) {
            const float* s = scr + (8 * c) * 65 + n;
            u32x4 o; o.x = pk2(s[0], s[65]); o.y = pk2(s[2 * 65], s[3 * 65]); o.z = pk2(s[4 * 65], s[5 * 65]); o.w = pk2(s[6 * 65], s[7 * 65]);
            const int row = t.inmap ? dst_row_in(n0 + n) : (n0 + n);
            *(u32x4*)(t.WT + (size_t)row * DM + k0 + 8 * c) = o;
        }
    }
    asm volatile("s_waitcnt lgkmcnt(0)" ::: "memory");
}
DI void norm_row(const float* src, const float* g, bf16_t* dstb, float* dstf, int lane) {
    const f32x4* xr = (const f32x4*)src + lane;
    f32x4 v[16]; float s = 0.f;
#pragma unroll
    for (int j = 0; j < 16; ++j) { v[j] = xr[64 * j]; s += (v[j][0] * v[j][0] + v[j][1] * v[j][1]) + (v[j][2] * v[j][2] + v[j][3] * v[j][3]); }
    const f32x4* gr = (const f32x4*)g + lane;
    f32x4 gv[16];
#pragma unroll
    for (int j = 0; j < 16; ++j) gv[j] = gr[64 * j];
    const float rs = __builtin_amdgcn_rsqf(wave_sum(s) * (1.f / DM) + EPS);
#pragma unroll
    for (int j = 0; j < 16; ++j) {
        const f32x4 o = v[j] * rs * gv[j];
        if (dstb) { u32x2 w2; w2.x = pk2(o[0], o[1]); w2.y = pk2(o[2], o[3]); *((u32x2*)dstb + lane + 64 * j) = w2; }
        else *((f32x4*)dstf + lane + 64 * j) = o;
    }
}
DI void rope_entry(float* tab, int idx) {
    const int pi = idx >> 5, i = idx & 31;
    const double pos = pi < SEQ ? (double)pi : 16384.0;
    double inv = 1.0; for (int k = 0; k < i; ++k) inv *= 0.7498942093324559;
    const double a = pos * inv;
    const double q = __builtin_rint(a * 0.6366197723675814);
    const double r = (a - q * 1.5707963267948966) - q * 6.123233995736766e-17;
    const int qi = ((int)q) & 3;
    const double r2 = r * r;
    const double sn = r * (1.0 + r2 * (-1.0 / 6 + r2 * (1.0 / 120 + r2 * (-1.0 / 5040 + r2 * (1.0 / 362880 + r2 * (-1.0 / 39916800 + r2 * (1.0 / 6227020800.0)))))));
    const double cs = 1.0 + r2 * (-0.5 + r2 * (1.0 / 24 + r2 * (-1.0 / 720 + r2 * (1.0 / 40320 + r2 * (-1.0 / 3628800 + r2 * (1.0 / 479001600 + r2 * (-1.0 / 87178291200.0)))))));
    double c, s;
    if (qi == 0) { c = cs; s = sn; } else if (qi == 1) { c = -sn; s = cs; } else if (qi == 2) { c = -cs; s = -sn; } else { c = sn; s = -cs; }
    tab[2 * idx] = (float)c; tab[2 * idx + 1] = (float)s;
}

DI void swa_unit(unsigned char* lds, const bf16_t* H, bf16_t* Gt, const float* sinks, int u, int tid) {
    const int kvh = u & 3, blk = (u >> 2) & 15, b = u >> 6;
    bf16_t* Ks = (bf16_t*)lds;
    bf16_t* Vt = (bf16_t*)(lds + 39168);
    const int lane = tid & 63, w = tid >> 6, c16 = lane & 15, quad = lane >> 4;
    const int qi = w * 16 + c16;
    const size_t qrow = (size_t)(b * SEQ + blk * 128 + qi);
    bf16x8 qc0 = *(const bf16x8*)(H + qrow * NP + C_SQ + kvh * 512 + quad * 8), qc1 = *(const bf16x8*)(H + qrow * NP + C_SQ + kvh * 512 + 32 + quad * 8);
    __syncthreads();
    {
        const int r = tid >> 1, half = tid & 1;
        const int tok = blk * 128 - 128 + r;
        u32x4 kv[4], vv[4];
#pragma unroll
        for (int i = 0; i < 4; ++i) { kv[i] = (u32x4){0u, 0u, 0u, 0u}; vv[i] = (u32x4){0u, 0u, 0u, 0u}; }
        if (tok >= 0) {
            const bf16_t* src = H + (size_t)(b * SEQ + tok) * NP + kvh * 64 + half * 32;
#pragma unroll
            for (int i = 0; i < 4; ++i) { kv[i] = *(const u32x4*)(src + C_SK + i * 8); vv[i] = *(const u32x4*)(src + C_SV + i * 8); }
        }
#pragma unroll
        for (int i = 0; i < 4; ++i) *(u32x4*)(Ks + r * 72 + half * 32 + i * 8) = kv[i];
#pragma unroll
        for (int i = 0; i < 4; ++i)
#pragma unroll
            for (int e = 0; e < 4; ++e) {
                const unsigned wv = vv[i][e];
                Vt[(half * 32 + i * 8 + 2 * e) * 280 + r] = (bf16_t)(wv & 0xffffu);
                Vt[(half * 32 + i * 8 + 2 * e + 1) * 280 + r] = (bf16_t)(wv >> 16);
            }
        for (int i = tid; i < 576; i += 512) ((unsigned*)(Ks + 256 * 72))[i] = 0u;
        { const int d = tid >> 3, cc = 256 + (tid & 7) * 2; *(unsigned*)(Vt + d * 280 + cc) = 0u; }
    }
    __syncthreads();
    for (int g = 0; g < 8; ++g) {
        const int head = kvh * 8 + g;
        bf16x8 qf[2]; qf[0] = qc0; qf[1] = qc1;
        { const int hn = kvh * 8 + (g < 7 ? g + 1 : g);
          qc0 = *(const bf16x8*)(H + qrow * NP + C_SQ + hn * 64 + quad * 8); qc1 = *(const bf16x8*)(H + qrow * NP + C_SQ + hn * 64 + 32 + quad * 8); }
        u32x2 gwv[4];
#pragma unroll
        for (int mt = 0; mt < 4; ++mt) gwv[mt] = *(const u32x2*)(H + qrow * NP + C_SG + head * 64 + mt * 16 + quad * 4);
        f32x4 s[10];
#pragma unroll
        for (int i = 0; i < 10; ++i) {
            s[i] = (f32x4){0.f, 0.f, 0.f, 0.f};
            const bf16_t* kp = Ks + ((w + i) * 16 + c16) * 72 + quad * 8;
#pragma unroll
            for (int ks = 0; ks < 2; ++ks) s[i] = mfma16(*(const bf16x8*)(kp + ks * 32), qf[ks], s[i]);
        }
        const float sink = sinks[head];
        float mx = sink;
        int qiv = qi + 128 - (w * 16 + quad * 4); asm volatile("" : "+v"(qiv));
        const int lowlim = blk > 0 ? 0 : 128;
#pragma unroll
        for (int i = 0; i < 10; ++i)
#pragma unroll
            for (int j = 0; j < 4; ++j) {
                const int sj = (w + i) * 16 + quad * 4 + j, diff = qiv - (i * 16 + j);
                const bool valid = (unsigned)diff < 128u && sj >= lowlim;
                s[i][j] = valid ? s[i][j] : -INFINITY;
                mx = fmaxf(mx, s[i][j]);
            }
        mx = fmaxf(mx, __shfl_xor(mx, 16)); mx = fmaxf(mx, __shfl_xor(mx, 32));
        float sum = 0.f;
#pragma unroll
        for (int i = 0; i < 10; ++i)
#pragma unroll
            for (int j = 0; j < 4; ++j) { const float p = __expf(s[i][j] - mx); s[i][j] = p; sum += p; }
        sum += __shfl_xor(sum, 16); sum += __shfl_xor(sum, 32);
        sum += __expf(sink - mx);
        const float inv = __builtin_amdgcn_rcpf(sum);
        f32x4 o[4];
#pragma unroll
        for (int mt = 0; mt < 4; ++mt) o[mt] = (f32x4){0.f, 0.f, 0.f, 0.f};
#pragma unroll
        for (int st = 0; st < 5; ++st) {
            const bf16x8 pb = pack8(s[2 * st], s[2 * st + 1]);
#pragma unroll
            for (int mt = 0; mt < 4; ++mt) {
                const bf16_t* vp = Vt + (mt * 16 + c16) * 280 + (w + 2 * st) * 16 + quad * 4;
                o[mt] = mfma16(cat4(*(const s16x4*)vp, *(const s16x4*)(vp + 16)), pb, o[mt]);
            }
        }
#pragma unroll
        for (int mt = 0; mt < 4; ++mt) {
            const int d = mt * 16 + quad * 4;
            const u32x2 gw = gwv[mt];
            u32x2 ow;
            ow.x = pk2(o[mt][0] * inv * silu(bflo(gw.x)), o[mt][1] * inv * silu(bfhi(gw.x)));
            ow.y = pk2(o[mt][2] * inv * silu(bflo(gw.y)), o[mt][3] * inv * silu(bfhi(gw.y)));
            *(u32x2*)(Gt + qrow * DM + head * 64 + d) = ow;
        }
    }
}

DI void mem_unit(unsigned char* lds, const bf16_t* H, const bf16_t* MKV, bf16_t* Gt, int u, int tid) {
    const int qt = u & 15, h = (u >> 4) & 3, b = u >> 6;
    bf16_t* Kc = (bf16_t*)lds;
    bf16_t* Vc = (bf16_t*)(lds + 33792);
    const int lane = tid & 63, w = tid >> 6, c16 = lane & 15, quad = lane >> 4;
    const size_t qrow = (size_t)(b * SEQ + qt * 128 + w * 16 + c16);
    const int srow = tid >> 3, seg = tid & 7;
    const bf16_t* ksrc = MKV + (size_t)(b * 256 + srow) * 2048 + h * 256 + seg * 32;
    const bf16_t* vsrc = MKV + (size_t)(b * 256 + lane) * 2048 + 1024 + h * 256 + w * 32;
    u32x4 pre[4];
#pragma unroll
    for (int i = 0; i < 4; ++i) pre[i] = *(const u32x4*)(ksrc + i * 8);
    bf16x8 qf[8];
#pragma unroll
    for (int ks = 0; ks < 8; ++ks) qf[ks] = *(const bf16x8*)(H + qrow * NP + C_MQ + h * 256 + ks * 32 + quad * 8);
    f32x4 s[16];
#pragma unroll
    for (int c = 0; c < 4; ++c) {
        __syncthreads();
#pragma unroll
        for (int i = 0; i < 4; ++i) *(u32x4*)(Kc + srow * 264 + seg * 32 + i * 8) = pre[i];
        if (c < 3) {
#pragma unroll
            for (int i = 0; i < 4; ++i) pre[i] = *(const u32x4*)(ksrc + (size_t)(c + 1) * 64 * 2048 + i * 8);
        } else {
#pragma unroll
            for (int i = 0; i < 4; ++i) pre[i] = *(const u32x4*)(vsrc + i * 8);
        }
        __syncthreads();
#pragma unroll
        for (int kt = 0; kt < 4; ++kt) {
            f32x4 a = {0.f, 0.f, 0.f, 0.f};
            const bf16_t* kp = Kc + (kt * 16 + c16) * 264 + quad * 8;
#pragma unroll
            for (int ks = 0; ks < 8; ++ks) a = mfma16(*(const bf16x8*)(kp + ks * 32), qf[ks], a);
            s[c * 4 + kt] = a;
        }
    }
    u32x2 gwv[16];
#pragma unroll
    for (int mt = 0; mt < 16; ++mt) gwv[mt] = *(const u32x2*)(H + qrow * NP + C_MG + h * 256 + mt * 16 + quad * 4);
    float mx = -INFINITY;
#pragma unroll
    for (int i = 0; i < 16; ++i)
#pragma unroll
        for (int j = 0; j < 4; ++j) mx = fmaxf(mx, s[i][j]);
    mx = fmaxf(mx, __shfl_xor(mx, 16)); mx = fmaxf(mx, __shfl_xor(mx, 32));
    float sum = 0.f;
#pragma unroll
    for (int i = 0; i < 16; ++i)
#pragma unroll
        for (int j = 0; j < 4; ++j) { const float p = __expf(s[i][j] - mx); s[i][j] = p; sum += p; }
    sum += __shfl_xor(sum, 16); sum += __shfl_xor(sum, 32);
    const float inv = __builtin_amdgcn_rcpf(sum);
    bf16x8 pbv[8];
#pragma unroll
    for (int i = 0; i < 8; ++i) pbv[i] = pack8(s[2 * i], s[2 * i + 1]);
    f32x4 o[16];
#pragma unroll
    for (int mt = 0; mt < 16; ++mt) o[mt] = (f32x4){0.f, 0.f, 0.f, 0.f};
#pragma unroll
    for (int c = 0; c < 4; ++c) {
        __syncthreads();
#pragma unroll
        for (int i = 0; i < 4; ++i)
#pragma unroll
            for (int e = 0; e < 4; ++e) {
                Vc[(w * 32 + i * 8 + 2 * e) * 72 + lane] = (bf16_t)(pre[i][e] & 0xffffu);
                Vc[(w * 32 + i * 8 + 2 * e + 1) * 72 + lane] = (bf16_t)(pre[i][e] >> 16);
            }
        if (c < 3) {
#pragma unroll
            for (int i = 0; i < 4; ++i) pre[i] = *(const u32x4*)(vsrc + (size_t)(c + 1) * 64 * 2048 + i * 8);
        }
        __syncthreads();
#pragma unroll
        for (int st = 0; st < 2; ++st) {
            const bf16x8 pb = pbv[c * 2 + st];
#pragma unroll
            for (int mt = 0; mt < 16; ++mt) {
                const bf16_t* vp = Vc + (mt * 16 + c16) * 72 + (2 * st) * 16 + quad * 4;
                o[mt] = mfma16(cat4(*(const s16x4*)vp, *(const s16x4*)(vp + 16)), pb, o[mt]);
            }
        }
    }
#pragma unroll
    for (int mt = 0; mt < 16; ++mt) {
        const int d = mt * 16 + quad * 4;
        const u32x2 gw = gwv[mt];
        u32x2 ow;
        ow.x = pk2(o[mt][0] * inv * silu(bflo(gw.x)), o[mt][1] * inv * silu(bfhi(gw.x)));
        ow.y = pk2(o[mt][2] * inv * silu(bflo(gw.y)), o[mt][3] * inv * silu(bfhi(gw.y)));
        *(u32x2*)(Gt + qrow * DM + 3072 + h * 256 + d) = ow;
    }
}

DI float logsig16(float z) { return (fminf(z, 0.f) - __logf(1.f + __expf(-fabsf(z)))) * 0.0625f; }

constexpr int GI_QS = 0, GI_AS = 17408, GI_VT = 26624, GI_BYTES = 63488, GI_IMG = 26624;
DI void gla_prep_unit(unsigned char* lds, const bf16_t* H, const float* wg, const float* bg, u32x2* Ug, float* EBLg, unsigned char* IMG, int u, int tid) {
    const int ch = u & 31, h = (u >> 5) & 3, b = u >> 7;
    bf16_t* Qs = (bf16_t*)(lds + GI_QS);
    bf16_t* As = (bf16_t*)(lds + GI_AS);
    bf16_t* Vt = (bf16_t*)(lds + GI_VT);
    bf16_t* Ks = (bf16_t*)(lds + 63488);
    bf16_t* Kt = (bf16_t*)(lds + 80896);
    float* LR = (float*)(lds + 99328);
    float* WgL = (float*)(lds + 103424);
    float* GT = (float*)(lds + 111616);
    const int lane = tid & 63, w = tid >> 6, c16 = lane & 15, quad = lane >> 4;
    const size_t row0 = (size_t)(b * SEQ + ch * 64);
    __syncthreads();
    { const int i = tid >> 3, r2 = (tid & 7) * 2; const unsigned wv = *(const unsigned*)(H + (row0 + i) * NP + C_LR + r2); LR[i * 16 + r2] = bflo(wv); LR[i * 16 + r2 + 1] = bfhi(wv); }
#pragma unroll
    for (int r = 0; r < 4; ++r) { const int idx = tid + 512 * r; WgL[idx] = wg[(idx >> 7) * 512 + h * 128 + (idx & 127)]; }
    const int dk = tid & 127, ig = tid >> 7;
    const float bgc = bg[h * 128 + dk];
    unsigned short qr[16], kr[16];
#pragma unroll
    for (int ii = 0; ii < 16; ++ii) { const bf16_t* src = H + (row0 + ig * 16 + ii) * NP + h * 128 + dk; qr[ii] = src[C_GQ]; kr[ii] = src[C_GK]; }
    u32x4 vpre[4];
#pragma unroll
    for (int i = 0; i < 4; ++i) vpre[i] = *(const u32x4*)(H + (row0 + lane) * NP + C_GV + h * 256 + w * 32 + i * 8);
    __syncthreads();
    float bb[16];
    {
        float wgc[16];
#pragma unroll
        for (int r = 0; r < 16; ++r) wgc[r] = WgL[r * 128 + dk];
        float run = 0.f;
#pragma unroll
        for (int ii = 0; ii < 16; ++ii) {
            const int i = ig * 16 + ii;
            float z = bgc;
#pragma unroll
            for (int r = 0; r < 16; ++r) z += LR[i * 16 + r] * wgc[r];
            run += logsig16(z); bb[ii] = run;
        }
        GT[ig * 128 + dk] = run;
    }
#pragma unroll
    for (int i = 0; i < 4; ++i)
#pragma unroll
        for (int e = 0; e < 4; ++e) {
            Vt[(w * 32 + i * 8 + 2 * e) * 72 + lane] = (bf16_t)(vpre[i][e] & 0xffffu);
            Vt[(w * 32 + i * 8 + 2 * e + 1) * 72 + lane] = (bf16_t)(vpre[i][e] >> 16);
        }
    __syncthreads();
    {
        const float t0 = GT[dk], t1 = GT[128 + dk], t2 = GT[256 + dk], t3 = GT[384 + dk];
        const float bl = (t0 + t1) + (t2 + t3);
        const float off = (ig > 0 ? t0 : 0.f) + (ig > 1 ? t1 : 0.f) + (ig > 2 ? t2 : 0.f);
#pragma unroll
        for (int ii = 0; ii < 16; ++ii) {
            const int i = ig * 16 + ii;
            const float bv = off + bb[ii], q = bf2f(qr[ii]), k = bf2f(kr[ii]);
            Qs[i * 136 + dk] = f2bf(q * __expf(bv));
            Ks[i * 136 + dk] = f2bf(k * __expf(-bv));
            Kt[dk * 72 + i] = f2bf(k * __expf(bl - bv));
        }
        if (ig == 0) EBLg[(size_t)u * 128 + dk] = __expf(bl);
    }
    __syncthreads();
#pragma unroll
    for (int tt = 0; tt < 2; ++tt) {
        const int t = 2 * w + tt, mt = t >> 2, nt = t & 3;
        f32x4 a = {0.f, 0.f, 0.f, 0.f};
        if (nt <= mt) {
#pragma unroll
            for (int ks = 0; ks < 4; ++ks)
                a = mfma16(*(const bf16x8*)(Qs + (mt * 16 + c16) * 136 + ks * 32 + quad * 8), *(const bf16x8*)(Ks + (nt * 16 + c16) * 136 + ks * 32 + quad * 8), a);
        }
#pragma unroll
        for (int jj = 0; jj < 4; ++jj) { const int i = mt * 16 + quad * 4 + jj, j = nt * 16 + c16; As[i * 72 + j] = f2bf(j <= i ? a[jj] : 0.f); }
    }
#pragma unroll
    for (int kt = 0; kt < 8; ++kt) {
        f32x4 s0 = {0.f, 0.f, 0.f, 0.f}, s1 = {0.f, 0.f, 0.f, 0.f};
#pragma unroll
        for (int ks = 0; ks < 2; ++ks) {
            const bf16x8 a = *(const bf16x8*)(Kt + (kt * 16 + c16) * 72 + ks * 32 + quad * 8);
            s0 = mfma16(a, *(const bf16x8*)(Vt + ((2 * w) * 16 + c16) * 72 + ks * 32 + quad * 8), s0);
            s1 = mfma16(a, *(const bf16x8*)(Vt + ((2 * w + 1) * 16 + c16) * 72 + ks * 32 + quad * 8), s1);
        }
        { u32x2 p0, p1; p0.x = pk2(s0[0], s0[1]); p0.y = pk2(s0[2], s0[3]); p1.x = pk2(s1[0], s1[1]); p1.y = pk2(s1[2], s1[3]);
          Ug[((size_t)(u * 8 + kt) * 16 + 2 * w) * 64 + lane] = p0; Ug[((size_t)(u * 8 + kt) * 16 + 2 * w + 1) * 64 + lane] = p1; }
    }
    __syncthreads();
    { u32x4* dst = (u32x4*)(IMG + (size_t)u * GI_IMG); const u32x4* srcl = (const u32x4*)lds;
      for (int i = tid; i < GI_IMG / 16; i += 512) dst[i] = srcl[i]; }
}
DI void gla_scan_task(const u32x2* Ug, const float* EBLg, u32x2* SF2, float* state_out, int t, int lane) {
    const int nt = t & 15, kt = (t >> 4) & 7, bh = t >> 7;
    const int c16 = lane & 15, quad = lane >> 4;
    f32x4 s0 = {0.f, 0.f, 0.f, 0.f};
    for (int n0 = 0; n0 < 32; n0 += 16) {
        f32x4 ev[16], uv[16];
#pragma unroll
        for (int j = 0; j < 16; ++j) {
            const size_t u = (size_t)bh * 32 + n0 + j;
            ev[j] = *(const f32x4*)(EBLg + u * 128 + kt * 16 + quad * 4);
            { const u32x2 p = Ug[((u * 8 + kt) * 16 + nt) * 64 + lane]; uv[j] = (f32x4){bflo(p.x), bfhi(p.x), bflo(p.y), bfhi(p.y)}; }
        }
#pragma unroll
        for (int j = 0; j < 16; ++j) {
            const size_t u = (size_t)bh * 32 + n0 + j;
            u32x2 pk; pk.x = pk2(s0[0], s0[1]); pk.y = pk2(s0[2], s0[3]);
            SF2[(((u * 4 + (kt >> 1)) * 16 + nt) * 64 + lane) * 2 + (kt & 1)] = pk;
            s0 = s0 * ev[j] + uv[j];
        }
    }
#pragma unroll
    for (int jj = 0; jj < 4; ++jj) state_out[((size_t)bh * 128 + kt * 16 + quad * 4 + jj) * 256 + nt * 16 + c16] = s0[jj];
}
DI void gla_out_unit(unsigned char* lds, const bf16_t* H, bf16_t* Gt, const float* gng, const u32x4* SF, const unsigned char* IMG, int u, int tid) {
    const int ch = u & 31, h = (u >> 5) & 3, b = u >> 7;
    const bf16_t* Qs = (const bf16_t*)(lds + GI_QS);
    const bf16_t* As = (const bf16_t*)(lds + GI_AS);
    const bf16_t* Vt = (const bf16_t*)(lds + GI_VT);
    float* SSw = (float*)(lds + GI_BYTES);
    const int lane = tid & 63, w = tid >> 6, c16 = lane & 15, quad = lane >> 4;
    const size_t row0 = (size_t)(b * SEQ + ch * 64);
    unsigned short gtv[4][4][2];
#pragma unroll
    for (int mt = 0; mt < 4; ++mt)
#pragma unroll
        for (int jj = 0; jj < 4; ++jj)
#pragma unroll
            for (int n = 0; n < 2; ++n) gtv[mt][jj][n] = H[(row0 + mt * 16 + quad * 4 + jj) * NP + C_GG + h * 256 + (2 * w + n) * 16 + c16];
    u32x4 vpre[4];
#pragma unroll
    for (int i = 0; i < 4; ++i) vpre[i] = *(const u32x4*)(H + (row0 + lane) * NP + C_GV + h * 256 + w * 32 + i * 8);
    __syncthreads();
    { const u32x4* src = (const u32x4*)(IMG + (size_t)u * GI_IMG); u32x4* dstl = (u32x4*)lds;
      for (int i = tid; i < GI_IMG / 16; i += 512) dstl[i] = src[i]; }
    { bf16_t* Vw = (bf16_t*)(lds + GI_VT);
#pragma unroll
      for (int i = 0; i < 4; ++i)
#pragma unroll
          for (int e = 0; e < 4; ++e) {
              Vw[(w * 32 + i * 8 + 2 * e) * 72 + lane] = (bf16_t)(vpre[i][e] & 0xffffu);
              Vw[(w * 32 + i * 8 + 2 * e + 1) * 72 + lane] = (bf16_t)(vpre[i][e] >> 16);
          } }
    bf16x8 sb[4][2];
#pragma unroll
    for (int ks = 0; ks < 4; ++ks)
#pragma unroll
        for (int n = 0; n < 2; ++n) sb[ks][n] = __builtin_bit_cast(bf16x8, SF[(((size_t)u * 4 + ks) * 16 + 2 * w + n) * 64 + lane]);
    __syncthreads();
    f32x4 o[4][2];
#pragma unroll
    for (int mt = 0; mt < 4; ++mt) {
        o[mt][0] = (f32x4){0.f, 0.f, 0.f, 0.f}; o[mt][1] = (f32x4){0.f, 0.f, 0.f, 0.f};
#pragma unroll
        for (int ks = 0; ks < 4; ++ks) {
            const bf16_t* qp = Qs + (mt * 16 + c16) * 136 + (2 * ks) * 16 + quad * 4;
            const bf16x8 a = cat4(*(const s16x4*)qp, *(const s16x4*)(qp + 16));
            o[mt][0] = mfma16(a, sb[ks][0], o[mt][0]); o[mt][1] = mfma16(a, sb[ks][1], o[mt][1]);
        }
#pragma unroll
        for (int ks = 0; ks < 2; ++ks) {
            const bf16x8 a = *(const bf16x8*)(As + (mt * 16 + c16) * 72 + ks * 32 + quad * 8);
#pragma unroll
            for (int n = 0; n < 2; ++n) o[mt][n] = mfma16(a, *(const bf16x8*)(Vt + ((2 * w + n) * 16 + c16) * 72 + ks * 32 + quad * 8), o[mt][n]);
        }
    }
#pragma unroll
    for (int mt = 0; mt < 4; ++mt)
#pragma unroll
        for (int jj = 0; jj < 4; ++jj) {
            float q = o[mt][0][jj] * o[mt][0][jj] + o[mt][1][jj] * o[mt][1][jj];
            q += __shfl_xor(q, 1); q += __shfl_xor(q, 2); q += __shfl_xor(q, 4); q += __shfl_xor(q, 8);
            if (c16 == 0) SSw[w * 64 + mt * 16 + quad * 4 + jj] = q;
        }
    __syncthreads();
    const float gn0 = gng[h * 256 + (2 * w) * 16 + c16], gn1 = gng[h * 256 + (2 * w + 1) * 16 + c16];
#pragma unroll
    for (int mt = 0; mt < 4; ++mt)
#pragma unroll
        for (int jj = 0; jj < 4; ++jj) {
            const int i = mt * 16 + quad * 4 + jj;
            float tot = 0.f;
#pragma unroll
            for (int ww = 0; ww < 8; ++ww) tot += SSw[ww * 64 + i];
            const float rs = __builtin_amdgcn_rsqf(tot * (1.f / 256.f) + EPS);
#pragma unroll
            for (int n = 0; n < 2; ++n) {
                const int dv = (2 * w + n) * 16 + c16;
                const float gate = bf2f(gtv[mt][jj][n]);
                Gt[(row0 + i) * DM + 2048 + h * 256 + dv] = f2bf(o[mt][n][jj] * rs * (n ? gn1 : gn0) * silu(gate));
            }
        }
}

DI void s_swa_unit(unsigned char* lds, const bf16_t* H, bf16_t* Gt, const float* ck, const float* cv, const float* sinks, float* kout, float* vout, int u, int tid) {
    const int kvh = u & 3, b = u >> 2;
    float* Kl = (float*)lds;
    float* Vl = Kl + 128 * 65;
    float* Ql = Vl + 128 * 64;
    float* Pl = Ql + 512;
    const int lane = tid & 63, w = tid >> 6;
    const bf16_t* hrow = H + (size_t)(TP + b) * NP;
    __syncthreads();
    {
        float kr[16], vr[16];
#pragma unroll
        for (int i = 0; i < 16; ++i) {
            const int kk = w + 8 * i;
            if (kk < 127) { const size_t o = ((size_t)(b * 128 + kk + 1) * 4 + kvh) * 64 + lane; kr[i] = ck[o]; vr[i] = cv[o]; }
            else { const int p = 2 * (lane & 31) + (lane >> 5); kr[i] = bf2f(hrow[C_SK + kvh * 64 + p]); vr[i] = bf2f(hrow[C_SV + kvh * 64 + lane]); }
        }
#pragma unroll
        for (int i = 0; i < 16; ++i) {
            const int kk = w + 8 * i;
            if (kk < 127) { const size_t oo = ((size_t)(b * 128 + kk) * 4 + kvh) * 64 + lane; kout[oo] = kr[i]; vout[oo] = vr[i]; }
            Kl[kk * 65 + lane] = kr[i]; Vl[kk * 64 + lane] = vr[i];
        }
    }
    { const int p = 2 * (lane & 31) + (lane >> 5); Ql[w * 64 + lane] = bf2f(hrow[C_SQ + (kvh * 8 + w) * 64 + p]); }
    __syncthreads();
    float s0 = 0.f, s1 = 0.f;
    for (int d = 0; d < 64; ++d) { const float qd = Ql[w * 64 + d]; s0 += qd * Kl[lane * 65 + d]; s1 += qd * Kl[(lane + 64) * 65 + d]; }
    const float sink = sinks[kvh * 8 + w];
    const float mx = fmaxf(wave_max(fmaxf(s0, s1)), sink);
    const float p0 = __expf(s0 - mx), p1 = __expf(s1 - mx);
    const float inv = __builtin_amdgcn_rcpf(wave_sum(p0 + p1) + __expf(sink - mx));
    Pl[w * 128 + lane] = p0 * inv; Pl[w * 128 + lane + 64] = p1 * inv;
    __syncthreads();
    float o = 0.f;
    for (int kk = 0; kk < 128; ++kk) o += Pl[w * 128 + kk] * Vl[kk * 64 + lane];
    const float gate = bf2f(hrow[C_SG + (kvh * 8 + w) * 64 + lane]);
    Gt[(size_t)(TP + b) * DM + (kvh * 8 + w) * 64 + lane] = f2bf(o * silu(gate));
}
DI void s_gla_unit(unsigned char* lds, const bf16_t* H, bf16_t* Gt, const float* wg, const float* bg, const float* gng, const float* sin_, float* sout, int u, int tid) {
    const int h = u & 3, b = u >> 2;
    float* gE = (float*)lds; float* qv = gE + 128; float* kv = qv + 128; float* vv = kv + 128; float* Osum = vv + 256; float* red = Osum + 2048;
    const int lane = tid & 63, w = tid >> 6;
    const bf16_t* hrow = H + (size_t)(TP + b) * NP;
    __syncthreads();
    if (tid < 128) {
        float z = bg[h * 128 + tid];
#pragma unroll
        for (int r = 0; r < 16; ++r) z += bf2f(hrow[C_LR + r]) * wg[r * 512 + h * 128 + tid];
        gE[tid] = __expf(logsig16(z)); qv[tid] = bf2f(hrow[C_GQ + h * 128 + tid]); kv[tid] = bf2f(hrow[C_GK + h * 128 + tid]);
    }
    if (tid < 256) vv[tid] = bf2f(hrow[C_GV + h * 256 + tid]);
    __syncthreads();
    const float* S0 = sin_ + (size_t)(b * 4 + h) * 128 * 256;
    float* S1 = sout + (size_t)(b * 4 + h) * 128 * 256;
    const f32x4 v4 = *(const f32x4*)(vv + lane * 4);
    f32x4 oacc = {0.f, 0.f, 0.f, 0.f};
    f32x4 srow[16];
#pragma unroll
    for (int r = 0; r < 16; ++r) srow[r] = *(const f32x4*)(S0 + (16 * w + r) * 256 + lane * 4);
#pragma unroll
    for (int r = 0; r < 16; ++r) {
        const int dk = 16 * w + r;
        const f32x4 sv = srow[r] * gE[dk] + v4 * kv[dk];
        *(f32x4*)(S1 + dk * 256 + lane * 4) = sv;
        oacc += sv * qv[dk];
    }
    *(f32x4*)(Osum + w * 256 + lane * 4) = oacc;
    __syncthreads();
    float o = 0.f;
    if (tid < 256) {
#pragma unroll
        for (int ww = 0; ww < 8; ++ww) o += Osum[ww * 256 + tid];
        const float q = wave_sum(o * o);
        if (lane == 0) red[w] = q;
    }
    __syncthreads();
    if (tid < 256) {
        const float rs = __builtin_amdgcn_rsqf((red[0] + red[1] + red[2] + red[3]) * (1.f / 256.f) + EPS);
        const float gate = bf2f(hrow[C_GG + h * 256 + tid]);
        Gt[(size_t)(TP + b) * DM + 2048 + h * 256 + tid] = f2bf(o * rs * gng[h * 256 + tid] * silu(gate));
    }
}
DI void s_mem_unit(unsigned char* lds, const bf16_t* H, bf16_t* Gt, const float* mk, const float* mv, int u, int tid) {
    const int h = u & 3, b = u >> 2;
    float* Sc = (float*)lds; float* Osum = Sc + 256;
    const int lane = tid & 63, w = tid >> 6;
    const bf16_t* hrow = H + (size_t)(TP + b) * NP;
    __syncthreads();
    const u32x2 qw = *(const u32x2*)(hrow + C_MQ + h * 256 + lane * 4);
    const f32x4 q4 = {bflo(qw.x), bfhi(qw.x), bflo(qw.y), bfhi(qw.y)};
    const float* kbase = mk + ((size_t)(b * 256 + w * 32) * 4 + h) * 256 + lane * 4;
    const float* vbase = mv + ((size_t)(b * 256 + w * 32) * 4 + h) * 256 + lane * 4;
    float vals[32];
    {
        f32x4 kr[32];
#pragma unroll
        for (int r = 0; r < 32; ++r) kr[r] = *(const f32x4*)(kbase + (size_t)r * 1024);
#pragma unroll
        for (int r = 0; r < 32; ++r) vals[r] = (q4[0] * kr[r][0] + q4[1] * kr[r][1]) + (q4[2] * kr[r][2] + q4[3] * kr[r][3]);
    }
#pragma unroll
    for (int i = 0; i < 16; ++i) { const bool hi = lane & 32; const float send = hi ? vals[i] : vals[i + 16], keep = hi ? vals[i + 16] : vals[i]; vals[i] = keep + __shfl_xor(send, 32); }
#pragma unroll
    for (int i = 0; i < 8; ++i) { const bool hi = lane & 16; const float send = hi ? vals[i] : vals[i + 8], keep = hi ? vals[i + 8] : vals[i]; vals[i] = keep + __shfl_xor(send, 16); }
#pragma unroll
    for (int i = 0; i < 4; ++i) { const bool hi = lane & 8; const float send = hi ? vals[i] : vals[i + 4], keep = hi ? vals[i + 4] : vals[i]; vals[i] = keep + __shfl_xor(send, 8); }
#pragma unroll
    for (int i = 0; i < 2; ++i) { const bool hi = lane & 4; const float send = hi ? vals[i] : vals[i + 2], keep = hi ? vals[i + 2] : vals[i]; vals[i] = keep + __shfl_xor(send, 4); }
    { const bool hi = lane & 2; const float send = hi ? vals[0] : vals[1], keep = hi ? vals[1] : vals[0]; vals[0] = keep + __shfl_xor(send, 2); }
    vals[0] += __shfl_xor(vals[0], 1);
    if ((lane & 1) == 0) Sc[w * 32 + (lane >> 1)] = vals[0];
    f32x4 vr[32];
#pragma unroll
    for (int r = 0; r < 32; ++r) vr[r] = *(const f32x4*)(vbase + (size_t)r * 1024);
    __syncthreads();
    const f32x4 sv = *(const f32x4*)(Sc + lane * 4);
    const float mx = wave_max(fmaxf(fmaxf(sv[0], sv[1]), fmaxf(sv[2], sv[3])));
    const float inv = __builtin_amdgcn_rcpf(wave_sum((__expf(sv[0] - mx) + __expf(sv[1] - mx)) + (__expf(sv[2] - mx) + __expf(sv[3] - mx))));
    f32x4 oacc = {0.f, 0.f, 0.f, 0.f};
#pragma unroll
    for (int r = 0; r < 32; ++r) oacc += vr[r] * (__expf(Sc[w * 32 + r] - mx) * inv);
    *(f32x4*)(Osum + w * 256 + lane * 4) = oacc;
    __syncthreads();
    if (tid < 256) {
        float o = 0.f;
#pragma unroll
        for (int ww = 0; ww < 8; ++ww) o += Osum[ww * 256 + tid];
        const float gate = bf2f(hrow[C_MG + h * 256 + tid]);
        Gt[(size_t)(TP + b) * DM + 3072 + h * 256 + tid] = f2bf(o * silu(gate));
    }
}

#ifndef MK_ONE_LAUNCH
#define MK_ONE_LAUNCH 1
#endif
constexpr int N_PHASES = 12;
#ifndef PH_MASK
#define PH_MASK 0xFFFF
#endif
#define PHM(b) ((PH_MASK >> (b)) & 1)
#ifndef DUP_PH
#define DUP_PH 0
#endif
#ifndef DUP_SEL
#define DUP_SEL 0
#endif
#ifndef DUP_SYNC
#define DUP_SYNC 0
#endif
#ifndef DUP_P0
#define DUP_P0 0
#endif

__global__ void __launch_bounds__(512, 2) mk_fwd(Args a) {
    extern __shared__ __attribute__((aligned(16))) unsigned char lds[];
    const int G = gridDim.x, bid = blockIdx.x;
    unsigned char* ws = a.ws;
    bf16_t* XN = (bf16_t*)(ws + WS_XN);
    bf16_t* Hb = (bf16_t*)(ws + WS_H);
    bf16_t* Gt = (bf16_t*)(ws + WS_G);
    float* X1 = (float*)(ws + WS_X1);
    float* rope = (float*)(ws + WS_ROPE);
    float* RSq = (float*)(ws + WS_RS);
    const float* x_prompt = a.in[0]; const float* mem_prompt = a.in[1]; const float* x_sample = a.in[2];
    volatile LAS unsigned* bst = (volatile LAS unsigned*)((LAS unsigned char*)lds + (LDS_BYTES - 16));
    if (threadIdx.x < 4) bst[threadIdx.x] = 0u;
    __syncthreads();
    XcdBarrier xbar = xcd_barrier_post((unsigned*)(ws + WS_CTL), bst);
#define GRID_SYNC() xcd_barrier(xbar)

    if (a.ph_lo == 0) {
        int tidp = threadIdx.x; asm volatile("" : "+v"(tidp));
        const int tid = tidp, lane = tid & 63, wave = __builtin_amdgcn_readfirstlane(tid >> 6);
        for (int rep0 = 0; rep0 <= DUP_P0; ++rep0) if (PHM(0)) {
            float* scr = (float*)(lds + wave * 16640);
            const int gw = bid * 8 + wave, NGW = G * 8;
            constexpr int I_IN = 64 * 153, I_OUT = 64 * 64, I_MEM = 64 * 32, I_L = I_IN + I_OUT + I_MEM;
            auto mk_item = [&](int it) {
                TrItem t; const int l = it / I_L; int r = it - l * I_L;
                if (r < I_IN) { t.W = a.in[9] + (size_t)l * DM * NIN; t.WT = (bf16_t*)(ws + WS_WIN + l * SZ_WIN); t.N = NIN; t.item = r; t.inmap = 1; return t; }
                r -= I_IN;
                if (r < I_OUT) { t.W = a.in[16] + (size_t)l * DM * DM; t.WT = (bf16_t*)(ws + WS_WOUT + l * SZ_WOUT); t.N = DM; t.item = r; t.inmap = 0; return t; }
                r -= I_OUT;
                t.W = a.in[15] + (size_t)l * DM * 2048; t.WT = (bf16_t*)(ws + WS_WMEM + l * SZ_WMEM); t.N = 2048; t.item = r; t.inmap = 0; return t;
            };
            {
                int it = gw;
                f32x4 tv[16];
                TrItem cur = mk_item(it < 2 * I_L ? it : 0);
                if (it < 2 * I_L) tr_load(cur, tv, lane);
                while (it < 2 * I_L) {
                    const int nx = it + NGW;
                    f32x4 tn[16]; TrItem nxt = cur;
                    if (nx < 2 * I_L) { nxt = mk_item(nx); tr_load(nxt, tn, lane); }
                    tr_store(cur, tv, scr, lane);
#pragma unroll
                    for (int i = 0; i < 16; ++i) tv[i] = tn[i];
                    cur = nxt; it = nx;
                }
            }
            for (int i = bid * 512 + tid; i < 2 * 240 * 512; i += G * 512) {
                const int l = i / (240 * 512), r = i - l * 240 * 512;
                ((u32x4*)(ws + WS_WIN + l * SZ_WIN + (size_t)NIN * DM * 2))[r] = (u32x4){0u, 0u, 0u, 0u};
            }
            for (int i = bid * 512 + tid; i < 2049 * 32; i += G * 512) rope_entry(rope, i);
            for (int i = bid * 512 + tid; i < 2 * MR; i += G * 512) RSq[i] = 0.f;
            for (int m = gw; m < MREAL + 2048; m += NGW) {
                if (m < TP) norm_row(x_prompt + (size_t)m * DM, a.in[8], XN + (size_t)m * DM, nullptr, lane);
                else if (m < MREAL) norm_row(x_sample + (size_t)(m - TP) * DM, a.in[8], XN + (size_t)m * DM, nullptr, lane);
                else { const int mm = m - MREAL, l = mm >> 10, r = mm & 1023;
                       norm_row(mem_prompt + (size_t)r * DM, a.in[14] + l * DM, (bf16_t*)(ws + WS_MN + l * SZ_MN) + (size_t)r * DM, nullptr, lane); }
            }
        }
        if (a.ph_hi > 1) GRID_SYNC();
        if (a.ph_hi > 1000) cg::this_grid().sync();
    }
    for (int ph = a.ph_lo < 1 ? 1 : a.ph_lo, rep = 0; ph < a.ph_hi; ) {
        int tidp = threadIdx.x; asm volatile("" : "+v"(tidp));
        const int tid = tidp, lane = tid & 63, wave = __builtin_amdgcn_readfirstlane(tid >> 6);
        {
            const int l = (ph - 1) / 6, k = (ph - 1) % 6;
            if (k == 5 && l == 0) { ++ph; continue; }
            if (k == 0) {
                if (PHM(1)) {
                    pg8::Gemm g{XN, (const bf16_t*)(ws + WS_WIN + l * SZ_WIN), TP, NP, DM};
                    pg8::StaticOrder S; S.init(TP, NP, G, bid);
                    EpiIn E{Hb, rope, a.out + O_KP + (size_t)l * 131072, a.out + O_VP + (size_t)l * 131072, l == 0 ? nullptr : RSq};
                    pg8::gemm_phase<EpiIn, pg8::StaticOrder, true, true>((PG8_LAS unsigned char*)lds, g, S, E);
                }
                if (PHM(2)) {
                    pg8::Gemm g{(const bf16_t*)(ws + WS_MN + l * SZ_MN), (const bf16_t*)(ws + WS_WMEM + l * SZ_WMEM), 1024, 2048, DM};
                    const int nwg1 = (TP / 256) * (NP / 256);
                    pg8::StaticOrder S; S.init(1024, 2048, G, (bid + G - (nwg1 % G)) % G);
                    EpiMem E{(bf16_t*)(ws + WS_MKV + l * SZ_MKV), a.out + O_MKP + (size_t)l * 1048576, a.out + O_MVP + (size_t)l * 1048576};
                    pg8::gemm_phase<EpiMem, pg8::StaticOrder, true, true>((PG8_LAS unsigned char*)lds, g, S, E);
                }
            } else if (k >= 1 && k <= 3) {
                const float* sinks = a.in[10] + l * 32;
                const float* wg = a.in[11] + l * 16 * 512; const float* bg = a.in[12] + l * 512; const float* gng = a.in[13] + l * 1024;
                const bf16_t* MKV = (const bf16_t*)(ws + WS_MKV + l * SZ_MKV);
                u32x2* Ug = (u32x2*)(ws + WS_U); u32x4* SF = (u32x4*)(ws + WS_SF); unsigned char* IMG = ws + WS_IMG; float* EBLg = (float*)(ws + WS_EBL);
                unsigned* qctr = (unsigned*)(ws + WS_CTL) + 8192 + (ph * 2 + rep) * 64;
#define QUEUE_LOOP_BEGIN(NTOT) { int u = bid; while (u < (NTOT)) { unsigned nxt_ = 0u; if (threadIdx.x == 0) nxt_ = atomicAdd(qctr, 1u) + (unsigned)G;
#define QUEUE_LOOP_END() __syncthreads(); if (threadIdx.x == 0) bst[2] = nxt_; __syncthreads(); u = (int)bst[2]; } }
                if (k == 1) {
                    EpiInS ES{Hb, rope, a.out + O_KS + (size_t)l * 1048576, a.out + O_VS + (size_t)l * 1048576, l == 0 ? nullptr : RSq};
                    QUEUE_LOOP_BEGIN(256 + 512 + NP / 32)
                        int tid = tidp; asm volatile("" : "+v"(tid));
                        if (u < 256) { if (PHM(4)) mem_unit(lds, Hb, MKV, Gt, u, tid); }
                        else if (u < 768) { if (PHM(3)) gla_prep_unit(lds, Hb, wg, bg, Ug, EBLg, IMG, u - 256, tid); }
                        else skinny_task<EpiInS>(lds, XN + (size_t)TP * DM, (const bf16_t*)(ws + WS_WIN + l * SZ_WIN), u - 768, tid, ES);
                    QUEUE_LOOP_END()
                } else if (k == 2) {
                    const bool dsel = (DUP_SEL != 0 && rep == 1 && ph == DUP_PH);
                    if (PHM(3) && (!dsel || DUP_SEL == 5)) { for (int tt = bid * 8 + wave; tt < 2048; tt += G * 8) gla_scan_task(Ug, EBLg, (u32x2*)SF, a.out + O_SP + (size_t)l * 524288, tt, lane); }
                    QUEUE_LOOP_BEGIN(256 + 384)
                        int tid = tidp; asm volatile("" : "+v"(tid));
                        const int utype = u < 256 ? 1 : (u < 384 ? 2 : (u < 512 ? 3 : 4));
                        if (dsel && utype != DUP_SEL) {}
                        else if (u < 256) { if (PHM(5)) swa_unit(lds, Hb, Gt, sinks, u, tid); }
                        else if (!PHM(6)) {}
                        else if (u < 384) s_mem_unit(lds, Hb, Gt, a.in[6] + (size_t)l * 8388608, a.in[7] + (size_t)l * 8388608, u - 256, tid);
                        else if (u < 512) s_gla_unit(lds, Hb, Gt, wg, bg, gng, a.in[5] + (size_t)l * 4194304, a.out + O_SS + (size_t)l * 4194304, u - 384, tid);
                        else s_swa_unit(lds, Hb, Gt, a.in[3] + (size_t)l * 1048576, a.in[4] + (size_t)l * 1048576, sinks, a.out + O_KS + (size_t)l * 1048576, a.out + O_VS + (size_t)l * 1048576, u - 512, tid);
                    QUEUE_LOOP_END()
                } else {
                    EpiResS ES{l == 0 ? x_sample : X1 + (size_t)TP * DM, (l == 0 ? X1 : a.out) + (size_t)TP * DM, l == 0 ? a.in[8] + DM : a.in[17], XN, RSq + l * MR, l};
                    QUEUE_LOOP_BEGIN(512 + DM / 32)
                        int tid = tidp; asm volatile("" : "+v"(tid));
                        if (u < 512) { if (PHM(3)) gla_out_unit(lds, Hb, Gt, gng, SF, IMG, u, tid); }
                        else skinny_task<EpiResS>(lds, Gt + (size_t)TP * DM, (const bf16_t*)(ws + WS_WOUT + l * SZ_WOUT), u - 512, tid, ES);
                    QUEUE_LOOP_END()
                }
                __syncthreads();
            } else if (k == 4) { if (PHM(7)) {
                pg8::Gemm g{Gt, (const bf16_t*)(ws + WS_WOUT + l * SZ_WOUT), TP, DM, DM};
                PanelOrder S; S.init(G, bid);
                if (l == 0) {
                    EpiRes E{x_prompt, X1, a.in[8] + DM, XN, RSq, 0};
                    pg8::gemm_phase<EpiRes, PanelOrder, true, true>((PG8_LAS unsigned char*)lds, g, S, E);
                } else {
                    if (bid < TS) {
                        const int row = TP + bid;
                        const float rs = __builtin_amdgcn_rsqf(RSq[MR + row] * (1.f / DM) + EPS);
                        f32x4* yr = (f32x4*)(a.out + (size_t)row * DM);
                        const f32x4 y0 = yr[tid], y1 = yr[tid + 512];
                        yr[tid] = y0 * rs; yr[tid + 512] = y1 * rs;
                    }
                    EpiFin E{X1, a.out, a.in[17], RSq + MR, (unsigned*)(ws + WS_CTL) + 4096};
                    pg8::gemm_phase<EpiFin, PanelOrder, true, true>((PG8_LAS unsigned char*)lds, g, S, E);
                }
            } } else if (PHM(8)) {
                const int gw = bid * 8 + wave, NGW = G * 8;
                for (int m = gw; m < MREAL; m += NGW) {
                    if (l == 0) norm_row(X1 + (size_t)m * DM, a.in[8] + DM, XN + (size_t)m * DM, nullptr, lane);
                    else {
                        const float rs = __builtin_amdgcn_rsqf(RSq[MR + m] * (1.f / DM) + EPS);
                        f32x4* yr = (f32x4*)(a.out + (size_t)m * DM) + lane;
                        f32x4 yv[16];
#pragma unroll
                        for (int j = 0; j < 16; ++j) yv[j] = yr[64 * j];
#pragma unroll
                        for (int j = 0; j < 16; ++j) yr[64 * j] = yv[j] * rs;
                    }
                }
            }
        }
        if (ph + 1 < a.ph_hi) { GRID_SYNC(); if (DUP_SYNC) { GRID_SYNC(); } }
        if (DUP_PH != 0 && ph == DUP_PH && rep == 0) rep = 1; else ++ph;
    }
}

extern "C" void kernel_launch(void* const* d_in, const int* in_sizes, int n_in, void* d_out, int out_size, void* d_ws, size_t ws_size, hipStream_t stream) {
    static int grid = 0;
    if (grid == 0) {
        if (n_in != 18 || (size_t)out_size != O_END || ws_size < WS_END) { fprintf(stderr, "kernel_launch: unexpected shapes (n_in %d, out %d, ws %zu); nothing launched\n", n_in, out_size, ws_size); grid = -1; return; }
        int dev = 0, cus = 0, per_cu = 0;
        if (hipGetDevice(&dev) != hipSuccess || hipDeviceGetAttribute(&cus, hipDeviceAttributeMultiprocessorCount, dev) != hipSuccess) { grid = -1; return; }
        if (hipFuncSetAttribute((const void*)mk_fwd, hipFuncAttributeMaxDynamicSharedMemorySize, LDS_BYTES) != hipSuccess) { fprintf(stderr, "kernel_launch: hipFuncSetAttribute failed\n"); grid = -1; return; }
        if (hipOccupancyMaxActiveBlocksPerMultiprocessor(&per_cu, (const void*)mk_fwd, 512, LDS_BYTES) != hipSuccess || per_cu < 1) { fprintf(stderr, "kernel_launch: occupancy query says %d\n", per_cu); per_cu = 1; }
        (void)hipGetLastError();
        grid = cus * per_cu;
    }
    if (grid < 0) return;
    if (hipMemsetAsync((char*)d_ws + WS_CTL, 0, CTL_BYTES, stream) != hipSuccess) { fprintf(stderr, "kernel_launch: memset failed\n"); return; }
    Args a{};
    for (int i = 0; i < 18; ++i) a.in[i] = (const float*)d_in[i];
    a.out = (float*)d_out; a.ws = (unsigned char*)d_ws;
#if MK_ONE_LAUNCH
    a.ph_lo = 0; a.ph_hi = N_PHASES;
    void* args[] = {&a};
    hipError_t e = hipLaunchCooperativeKernel((const void*)mk_fwd, dim3(grid), dim3(512), args, LDS_BYTES, stream);
    if (e != hipSuccess) fprintf(stderr, "kernel_launch: cooperative launch failed: %s (grid %d)\n", hipGetErrorString(e), grid);
#else
    for (int ph = 0; ph < N_PHASES; ++ph) {
        a.ph_lo = ph; a.ph_hi = ph + 1;
        hipLaunchKernelGGL(mk_fwd, dim3(grid), dim3(512), LDS_BYTES, stream, a);
    }
#endif
}
```

```cpp
#include <hip/hip_runtime.h>
#include <hip/hip_cooperative_groups.h>
#include <cstdio>
#include <cstdint>
namespace cg = cooperative_groups;
#define MK_ONE_LAUNCH 1
namespace pg8 {
#define PG8_LAS __attribute__((address_space(3)))
typedef unsigned short bf16_t;
typedef short bf16x8 __attribute__((ext_vector_type(8)));
typedef float f32x4 __attribute__((ext_vector_type(4)));
typedef unsigned u32x4 __attribute__((ext_vector_type(4)));
constexpr int BM = 256, BK = 64, HALF = 128, HTB = HALF * BK * 2  , STAGE_BYTES = 8 * HTB, NXCD = 8, WGM = 8;

__host__ __device__ __forceinline__ int lds_byte(int r, int c) { const int st = (r >> 4) * 2 + (c >> 5), rr = r & 15, cc = c & 31, ob = rr * 64 + cc * 2; return st * 1024 + (ob ^ (((ob >> 9) & 1) << 5)); }
__host__ __device__ __forceinline__ void stage_rc(int b, int& R, int& C) { const int st = b / 1024, sb = b % 1024, swz = sb ^ (((sb >> 9) & 1) << 5); R = (st >> 1) * 16 + swz / 64; C = (st & 1) * 32 + (swz % 64) / 2; }
__host__ __device__ __forceinline__ int perm32(int rho) { const int n = rho >> 4, i = rho & 15; return 8 * (i >> 2) + 4 * n + (i & 3); }

struct Unit { int pm, pn; };
struct Gemm { const bf16_t* A; const bf16_t* Bt; int M, N, K; };

struct StaticOrder {
    int nM, nN, nwg, G, c;
    __host__ __device__ void init(int M, int N, int G_, int c_) { nM = M / BM; nN = N / BM; nwg = nM * nN; G = G_; c = c_; }
    __host__ __device__ bool next(int i, Unit& u) const {
        const long L = (long)i * G + c; if (L >= nwg) return false;
        int wgid = (int)L; { const int q = nwg / NXCD, r = nwg % NXCD, xcd = wgid % NXCD, off = wgid / NXCD; wgid = (xcd < r ? xcd * (q + 1) : r * (q + 1) + (xcd - r) * q) + off; }
        const int nig = WGM * nN, gid = wgid / nig, fm = gid * WGM, gsz = (nM - fm) < WGM ? (nM - fm) : WGM;
        u.pm = fm + ((wgid % nig) % gsz); u.pn = (wgid % nig) / gsz; return true;
    }
    __device__ __forceinline__ void a_ready(const Unit&) const {}
    __device__ __forceinline__ void done(const Unit&) const {}
};

__device__ __forceinline__ unsigned cvt_pk_bf16(float lo, float hi) { unsigned r; asm volatile("v_cvt_pk_bf16_f32 %0, %1, %2" : "=v"(r) : "v"(lo), "v"(hi)); return r; }
typedef float f32x2 __attribute__((ext_vector_type(2)));
template <class Epi, class Sched, bool ALIGN_EPI = false, bool SP2 = false>
__device__ __forceinline__ void gemm_phase(PG8_LAS unsigned char* lds, const Gemm g, const Sched& S, const Epi& E) {
    int tid_ = threadIdx.x; asm volatile("" : "+v"(tid_));
    const int tid = tid_, wid = __builtin_amdgcn_readfirstlane(tid >> 6), lane = tid & 63, wr = wid >> 2, wc = wid & 3, fr = lane & 15, fq = lane >> 4;
    const int K = g.K, nt = K / BK;
    unsigned voffA[2], voffB[2];
#pragma unroll
    for (int i = 0; i < 2; ++i) { int R, C; stage_rc(tid * 16 + i * 8192, R, C); const int Rb = Epi::PERM ? ((R & ~31) + perm32(R & 31)) : R;
        voffA[i] = (unsigned)(R * K + C) * 2u; voffB[i] = (unsigned)(Rb * K + C) * 2u; }
    const size_t kstep = (size_t)(BK * 2);
    const size_t hstep = (size_t)HALF * K * 2;
    const size_t tstep = 2 * hstep;
    const unsigned ldsw = (unsigned)wid * 1024u;
    const int aoff = lds_byte(wr * 64 + fr, fq * 8), boff = lds_byte(wc * 32 + fr, fq * 8);
#define PG8_SA(b, h) (((b) * 2 + (h)) * HTB)
#define PG8_SB(b, h) ((4 + (b) * 2 + (h)) * HTB)
#define PG8_STAGE(bufoff, gbase, voff) do { _Pragma("unroll") for (int _i = 0; _i < 2; ++_i) \
        __builtin_amdgcn_global_load_lds((const unsigned*)((const char*)(gbase) + (voff)[_i]), (PG8_LAS unsigned*)(lds + (bufoff) + ldsw + _i * 8192), 16, 0, 0); } while (0)
#define PG8_LDA(dst, b, h) do { _Pragma("unroll") for (int m = 0; m < 4; ++m) _Pragma("unroll") for (int k = 0; k < 2; ++k) dst[m][k] = *(const PG8_LAS bf16x8*)(lds + PG8_SA(b, h) + aoff + m * 2048 + k * 1024); } while (0)
#define PG8_LDB(dst, b, h) do { _Pragma("unroll") for (int n = 0; n < 2; ++n) _Pragma("unroll") for (int k = 0; k < 2; ++k) dst[n][k] = *(const PG8_LAS bf16x8*)(lds + PG8_SB(b, h) + boff + n * 2048 + k * 1024); } while (0)
#define PG8_MMA(ai, bj, At, Bt) do { __builtin_amdgcn_s_setprio(1); _Pragma("unroll") for (int m = 0; m < 4; ++m) _Pragma("unroll") for (int n = 0; n < 2; ++n) _Pragma("unroll") for (int k = 0; k < 2; ++k) \
        acc[ai][bj][m][n] = __builtin_amdgcn_mfma_f32_16x16x32_bf16(Bt[n][k], At[m][k], acc[ai][bj][m][n], 0, 0, 0); __builtin_amdgcn_s_setprio(0); } while (0)
#define PG8_WAIT_V(n) asm volatile("s_waitcnt vmcnt(" #n ")" ::: "memory")
#define PG8_WAIT_L(n) asm volatile("s_waitcnt lgkmcnt(" #n ")" ::: "memory")
#define PG8_BAR __builtin_amdgcn_s_barrier()
#define PG8_SCHED __builtin_amdgcn_sched_barrier(0)
    Unit cur, nxt; int ui = 0;
    if (!S.next(0, cur)) return;
    f32x4 acc[2][2][4][2];
#pragma unroll
    for (int a = 0; a < 2; ++a)
#pragma unroll
        for (int b = 0; b < 2; ++b)
#pragma unroll
            for (int m = 0; m < 4; ++m)
#pragma unroll
                for (int n = 0; n < 2; ++n) acc[a][b][m][n] = (f32x4){0.f, 0.f, 0.f, 0.f};
    bf16x8 At[4][2], B0[2][2], B1[2][2];
    const char* cA = (const char*)g.A + (size_t)cur.pm * tstep; const char* cB = (const char*)g.Bt + (size_t)cur.pn * tstep;
    S.a_ready(cur);
    if constexpr (SP2) {
        PG8_STAGE(PG8_SB(0, 0), cB, voffB); PG8_STAGE(PG8_SB(0, 1), cB + hstep, voffB); PG8_STAGE(PG8_SA(0, 0), cA, voffA); PG8_STAGE(PG8_SA(0, 1), cA + hstep, voffA);
        if (wr == 1) PG8_BAR;
        PG8_WAIT_V(2); PG8_BAR;
        PG8_STAGE(PG8_SB(1, 0), cB + kstep, voffB); PG8_STAGE(PG8_SA(1, 0), cA + kstep, voffA); PG8_STAGE(PG8_SB(1, 1), cB + hstep + kstep, voffB);
        PG8_WAIT_V(6); PG8_BAR;
    } else {
        PG8_STAGE(PG8_SB(0, 0), cB, voffB); PG8_STAGE(PG8_SA(0, 0), cA, voffA); PG8_STAGE(PG8_SB(0, 1), cB + hstep, voffB); PG8_STAGE(PG8_SA(0, 1), cA + hstep, voffA);
        if (wr == 1) PG8_BAR;
        PG8_WAIT_V(4); PG8_BAR;
        PG8_STAGE(PG8_SB(1, 0), cB + kstep, voffB); PG8_STAGE(PG8_SA(1, 0), cA + kstep, voffA); PG8_STAGE(PG8_SB(1, 1), cB + hstep + kstep, voffB);
        PG8_WAIT_V(6); PG8_BAR;
    }
    for (;;) {
        const bool has_next = S.next(ui + 1, nxt);
        const char* nA = has_next ? (const char*)g.A + (size_t)nxt.pm * tstep : cA; const char* nB = has_next ? (const char*)g.Bt + (size_t)nxt.pn * tstep : cB;
        for (int t = 0; t < nt; t += 2) {
            const bool last = (t == nt - 2);
            const char* a1 = cA + (size_t)(t + 1) * kstep;
            const char* a2 = last ? nA : cA + (size_t)(t + 2) * kstep; const char* b2 = last ? nB : cB + (size_t)(t + 2) * kstep;
            const char* a3 = a2 + kstep; const char* b3 = b2 + kstep;
            if (last && has_next) S.a_ready(nxt);
            if constexpr (SP2) {
            PG8_LDB(B0, 0, 0); PG8_LDB(B1, 0, 1); PG8_SCHED; PG8_LDA(At, 0, 0); PG8_STAGE(PG8_SA(1, 1), a1 + hstep, voffA);
            PG8_WAIT_V(8); PG8_WAIT_L(0); PG8_BAR; PG8_MMA(0, 0, At, B0); PG8_MMA(0, 1, At, B1); PG8_BAR; PG8_SCHED;
            PG8_LDA(At, 0, 1); PG8_STAGE(PG8_SB(0, 0), b2, voffB); PG8_STAGE(PG8_SB(0, 1), b2 + hstep, voffB); PG8_STAGE(PG8_SA(0, 0), a2, voffA);
            PG8_WAIT_V(8); PG8_WAIT_L(0); PG8_BAR; PG8_MMA(1, 0, At, B0); PG8_MMA(1, 1, At, B1); PG8_BAR; PG8_SCHED;
            PG8_LDB(B0, 1, 0); PG8_LDB(B1, 1, 1); PG8_SCHED; PG8_LDA(At, 1, 0); PG8_STAGE(PG8_SA(0, 1), a2 + hstep, voffA);
            PG8_WAIT_V(8); PG8_WAIT_L(0); PG8_BAR; PG8_MMA(0, 0, At, B0); PG8_MMA(0, 1, At, B1); PG8_BAR; PG8_SCHED;
            PG8_LDA(At, 1, 1); PG8_STAGE(PG8_SB(1, 0), b3, voffB); PG8_STAGE(PG8_SB(1, 1), b3 + hstep, voffB); PG8_STAGE(PG8_SA(1, 0), a3, voffA);
            PG8_WAIT_V(8); PG8_WAIT_L(0); PG8_BAR; PG8_MMA(1, 0, At, B0); PG8_MMA(1, 1, At, B1); PG8_BAR; PG8_SCHED;
            } else {
            PG8_LDB(B0, 0, 0); PG8_SCHED; PG8_LDA(At, 0, 0); PG8_STAGE(PG8_SA(1, 1), a1 + hstep, voffA);
            PG8_WAIT_L(8); PG8_BAR; PG8_WAIT_L(0); PG8_MMA(0, 0, At, B0); PG8_BAR; PG8_SCHED;
            PG8_LDB(B1, 0, 1); PG8_STAGE(PG8_SB(0, 0), b2, voffB);
            PG8_BAR; PG8_WAIT_L(0); PG8_MMA(0, 1, At, B1); PG8_BAR;
            PG8_LDA(At, 0, 1); PG8_STAGE(PG8_SA(0, 0), a2, voffA);
            PG8_BAR; PG8_WAIT_L(0); PG8_MMA(1, 0, At, B0); PG8_BAR; PG8_SCHED;
            PG8_STAGE(PG8_SB(0, 1), b2 + hstep, voffB);
            PG8_WAIT_V(6); PG8_BAR; PG8_MMA(1, 1, At, B1); PG8_BAR;
            PG8_LDB(B0, 1, 0); PG8_SCHED; PG8_LDA(At, 1, 0); PG8_STAGE(PG8_SA(0, 1), a2 + hstep, voffA);
            PG8_WAIT_L(8); PG8_BAR; PG8_WAIT_L(0); PG8_MMA(0, 0, At, B0); PG8_BAR; PG8_SCHED;
            PG8_LDB(B1, 1, 1); PG8_STAGE(PG8_SB(1, 0), b3, voffB);
            PG8_BAR; PG8_WAIT_L(0); PG8_MMA(0, 1, At, B1); PG8_BAR;
            PG8_LDA(At, 1, 1); PG8_STAGE(PG8_SA(1, 0), a3, voffA);
            PG8_BAR; PG8_WAIT_L(0); PG8_MMA(1, 0, At, B0); PG8_BAR; PG8_SCHED;
            PG8_STAGE(PG8_SB(1, 1), b3 + hstep, voffB);
            PG8_WAIT_V(6); PG8_BAR; PG8_MMA(1, 1, At, B1); PG8_BAR;
            }
        }
        if constexpr (ALIGN_EPI) { if (wr == 0) PG8_BAR; }
        if constexpr (!Epi::AFTER_DRAIN) { E(acc, cur, wr, wc, fr, fq); S.done(cur); }
        if (!has_next) break;
#pragma unroll
        for (int a = 0; a < 2; ++a)
#pragma unroll
            for (int b = 0; b < 2; ++b)
#pragma unroll
                for (int m = 0; m < 4; ++m)
#pragma unroll
                    for (int n = 0; n < 2; ++n) acc[a][b][m][n] = (f32x4){0.f, 0.f, 0.f, 0.f};
        cur = nxt; cA = nA; cB = nB; ++ui;
        if constexpr (ALIGN_EPI) { if (wr == 1) PG8_BAR; }
    }
    PG8_WAIT_V(0);
    if constexpr (!ALIGN_EPI) { if (wr == 0) PG8_BAR; }
    PG8_BAR;
    if constexpr (Epi::AFTER_DRAIN) { E.fused(acc, cur, wr, wc, fr, fq, lds, wid, lane); S.done(cur); }
#undef PG8_SA
#undef PG8_SB
#undef PG8_STAGE
#undef PG8_LDA
#undef PG8_LDB
#undef PG8_MMA
#undef PG8_WAIT_V
#undef PG8_WAIT_L
#undef PG8_BAR
#undef PG8_SCHED
}
}
#define LAS __attribute__((address_space(3)))
#define XB_TMO      128
#define XB_XCNT(j)  (256  + 64 * (j))
#define XB_XSUB(j)  (1280 + 64 * (j))
#define XB_XGEN(j)  (2304 + 64 * (j))
#define XB_TOP      3328
#define XB_TOPGEN   3392
#define XCD_BAR_WORDS 3456
#define XB_SPIN_CAP (1u << 18)

__device__ __forceinline__ unsigned xb_ld(unsigned* p)              { return __hip_atomic_load(p, __ATOMIC_RELAXED, __HIP_MEMORY_SCOPE_AGENT); }
__device__ __forceinline__ unsigned xb_add(unsigned* p, unsigned v) { return __hip_atomic_fetch_add(p, v, __ATOMIC_RELAXED, __HIP_MEMORY_SCOPE_AGENT); }
__device__ __forceinline__ unsigned xb_xcc_id() { return (unsigned)__builtin_amdgcn_s_getreg((3 << 11) | 20) & 0xFu; }
#define XB_SPIN(cond, bar) do { unsigned _sp = 0; while (cond) { __builtin_amdgcn_s_sleep(1); \
    if ((++_sp & 255u) == 0u) { if (xb_ld(&(bar)[XB_TMO])) break; if (_sp > XB_SPIN_CAP) { atomicAdd(&(bar)[XB_TMO], 1u); break; } } } } while (0)

struct XcdBarrier {
    unsigned* bar; unsigned x;
    volatile LAS unsigned* st;
};

__device__ __forceinline__ XcdBarrier xcd_barrier_post(unsigned* bar, volatile LAS unsigned* st) {
    XcdBarrier b; b.bar = bar; b.x = xb_xcc_id(); b.st = st;
    if (threadIdx.x == 0) (void)xb_add(&bar[XB_XCNT(b.x)], 1u);
    return b;
}
__device__ __forceinline__ void xcd_barrier_complete(unsigned* bar, unsigned x, unsigned& nloc, unsigned& nx) {
    const unsigned G = gridDim.x * gridDim.y * gridDim.z;
    unsigned sum, cnt, mine, sp = 0u;
    for (;;) {
        sum = 0u; cnt = 0u; mine = 0u;
#pragma unroll
        for (unsigned j = 0; j < 16; ++j) { const unsigned c = xb_ld(&bar[XB_XCNT(j)]); sum += c; cnt += (c > 0u) ? 1u : 0u; mine = (j == x) ? c : mine; }
        if (sum == G) break;
        __builtin_amdgcn_s_sleep(1);
        if ((++sp & 255u) == 0u) { if (xb_ld(&bar[XB_TMO])) break; if (sp > XB_SPIN_CAP) { atomicAdd(&bar[XB_TMO], 1u); break; } }
    }
    nloc = mine > 0u ? mine : 1u; nx = cnt > 0u ? cnt : 1u;
}

__device__ __forceinline__ void xcd_barrier(const XcdBarrier& b) {
    asm volatile("s_waitcnt vmcnt(0)" ::: "memory");
    __syncthreads();
    if (threadIdx.x == 0) {
        unsigned* bar = b.bar;
        __builtin_amdgcn_s_waitcnt(0);
        unsigned nloc = b.st[0], nx = b.st[1];
        if (nloc == 0u) { xcd_barrier_complete(bar, b.x, nloc, nx); b.st[0] = nloc; b.st[1] = nx; }
        const unsigned old = xb_add(&bar[XB_XSUB(b.x)], 1u);
        const unsigned gen = old / nloc;
        if (old + 1u == (gen + 1u) * nloc) {
            __builtin_amdgcn_fence(__ATOMIC_RELEASE, "agent");
            asm volatile("s_waitcnt vmcnt(0)" ::: "memory");
            const unsigned og = xb_add(&bar[XB_TOP], 1u);
            const unsigned tg = og / nx;
            if (og + 1u == (tg + 1u) * nx) xb_add(&bar[XB_TOPGEN], 1u);
            else XB_SPIN(xb_ld(&bar[XB_TOPGEN]) == tg, bar);
            __builtin_amdgcn_fence(__ATOMIC_ACQUIRE, "agent");
            xb_add(&bar[XB_XGEN(b.x)], 1u);
            asm volatile("s_waitcnt vmcnt(0)" ::: "memory");
        } else {
            XB_SPIN(xb_ld(&bar[XB_XGEN(b.x)]) == gen, bar);
            __builtin_amdgcn_fence(__ATOMIC_ACQUIRE, "agent");
            asm volatile("s_waitcnt vmcnt(0)" ::: "memory");
        }
    }
    __syncthreads();
}

#define DI __device__ __forceinline__
typedef unsigned short bf16_t;
typedef short bf16x8 __attribute__((ext_vector_type(8)));
typedef short s16x4 __attribute__((ext_vector_type(4)));
typedef float f32x4 __attribute__((ext_vector_type(4)));
typedef unsigned u32x4 __attribute__((ext_vector_type(4)));
typedef unsigned u32x2 __attribute__((ext_vector_type(2)));
typedef float f32x2_t __attribute__((ext_vector_type(2)));
typedef __bf16 bf16x2_t __attribute__((ext_vector_type(2)));

constexpr int DM = 4096, TP = 8192, SEQ = 2048, NBATCH = 4, TS = 32, MR = 8448, MREAL = 8224, NP = 9984, NIN = 9744;
constexpr int C_SQ = 0, C_SK = 2048, C_SV = 2304, C_SG = 2560, C_GQ = 4608, C_GK = 5120, C_GV = 5632, C_GG = 6656, C_MQ = 7680, C_MG = 8704, C_LR = 9728;
constexpr float EPS = 1e-6f;
constexpr size_t O_YP = 0, O_YS = 33554432, O_KP = 33685504, O_VP = 33947648, O_SP = 34209792, O_MKP = 35258368, O_MVP = 37355520, O_KS = 39452672, O_VS = 41549824, O_SS = 43646976, O_END = 52035584;
constexpr size_t MiB = 1u << 20;
constexpr size_t WS_WIN = 0;
constexpr size_t SZ_WIN = (size_t)NP * DM * 2;
constexpr size_t WS_WOUT = 160 * MiB;
constexpr size_t SZ_WOUT = (size_t)DM * DM * 2;
constexpr size_t WS_WMEM = 224 * MiB;
constexpr size_t SZ_WMEM = (size_t)2048 * DM * 2;
constexpr size_t WS_XN = 256 * MiB;
constexpr size_t WS_MN = 324 * MiB;
constexpr size_t SZ_MN = (size_t)1024 * DM * 2;
constexpr size_t WS_H = 340 * MiB;
constexpr size_t WS_MKV = 502 * MiB;
constexpr size_t SZ_MKV = (size_t)1024 * 2048 * 2;
constexpr size_t WS_G = 510 * MiB;
constexpr size_t WS_X1 = 576 * MiB;
constexpr size_t WS_ROPE = 708 * MiB;
constexpr size_t WS_U = 710 * MiB;
constexpr size_t WS_SF = 774 * MiB;
constexpr size_t WS_IMG = 806 * MiB;
constexpr size_t WS_EBL = 838 * MiB;
constexpr size_t WS_RS = 838 * MiB + 524288;
constexpr size_t WS_CTL = 839 * MiB;
constexpr size_t CTL_BYTES = 65536;
constexpr size_t WS_END = 840 * MiB;
static_assert(WS_WIN + 2 * SZ_WIN <= WS_WOUT && WS_XN + (size_t)MR * DM * 2 <= WS_MN && WS_H + (size_t)MR * NP * 2 <= WS_MKV && WS_G + (size_t)MR * DM * 2 <= WS_X1 && WS_X1 + (size_t)MR * DM * 4 <= WS_ROPE, "ws map");

constexpr int LDS_BYTES = 147456;

DI float bf2f(unsigned short u) { return __uint_as_float((unsigned)u << 16); }
DI float bflo(unsigned w) { return __uint_as_float(w << 16); }
DI float bfhi(unsigned w) { return __uint_as_float(w & 0xffff0000u); }
DI unsigned pk2(float lo, float hi) { f32x2_t v = {lo, hi}; bf16x2_t b = __builtin_convertvector(v, bf16x2_t); return __builtin_bit_cast(unsigned, b); }
DI unsigned short f2bf(float f) { return (unsigned short)(pk2(f, 0.f) & 0xffffu); }
DI float silu(float x) { return x * __builtin_amdgcn_rcpf(1.f + __expf(-x)); }
DI float wave_sum(float v) {
#pragma unroll
    for (int o = 1; o < 64; o <<= 1) v += __shfl_xor(v, o);
    return v;
}
DI float wave_max(float v) {
#pragma unroll
    for (int o = 1; o < 64; o <<= 1) v = fmaxf(v, __shfl_xor(v, o));
    return v;
}
DI f32x4 mfma16(bf16x8 a, bf16x8 b, f32x4 c) { return __builtin_amdgcn_mfma_f32_16x16x32_bf16(a, b, c, 0, 0, 0); }
DI bf16x8 pack8(f32x4 a, f32x4 b) { u32x4 p; p.x = pk2(a[0], a[1]); p.y = pk2(a[2], a[3]); p.z = pk2(b[0], b[1]); p.w = pk2(b[2], b[3]); return __builtin_bit_cast(bf16x8, p); }
DI bf16x8 cat4(s16x4 lo, s16x4 hi) { return __builtin_shufflevector(lo, hi, 0, 1, 2, 3, 4, 5, 6, 7); }

struct Args {
    const float* in[18]; float* out; unsigned char* ws; int ph_lo, ph_hi;
};

struct EpiIn {
    static constexpr bool PERM = true, AFTER_DRAIN = false;
    bf16_t* H; const float* rope; float* kp; float* vp; const float* RSin;
    DI void operator()(const f32x4 (&acc)[2][2][4][2], const pg8::Unit& u, int wr, int wc, int fr, int fq) const {
        const int pn = u.pn;
        const bool do_rope = pn < 9;
        float sc = 1.f;
        if (pn < 8) sc = 0.125f; else if (pn == 18 || pn == 19) sc = 0.08838834764831845f; else if (pn >= 30 && pn < 34) sc = 0.0625f;
        const int row0 = u.pm * 256 + wr * 64 + fr;
        const int colt = wc * 32 + 8 * fq;
#pragma unroll
        for (int ai = 0; ai < 2; ++ai) {
            f32x4 tr[4][2];
#pragma unroll
            for (int m = 0; m < 4; ++m) {
                tr[m][0] = (f32x4){1.f, 0.f, 1.f, 0.f}; tr[m][1] = (f32x4){1.f, 0.f, 1.f, 0.f};
                if (do_rope) {
                    const f32x4* rp = (const f32x4*)(rope + ((size_t)((row0 + ai * 128 + m * 16) & (SEQ - 1)) * 32 + 16 * (wc & 1) + 4 * fq) * 2);
                    tr[m][0] = rp[0]; tr[m][1] = rp[1];
                }
            }
            float rsv[4];
#pragma unroll
            for (int m = 0; m < 4; ++m) { rsv[m] = sc; if (RSin) rsv[m] = sc * __builtin_amdgcn_rsqf(RSin[row0 + ai * 128 + m * 16] * (1.f / DM) + EPS); }
#pragma unroll
            for (int m = 0; m < 4; ++m) {
                const int row = row0 + ai * 128 + m * 16;
                const f32x4 t0 = tr[m][0], t1 = tr[m][1];
#pragma unroll
                for (int bj = 0; bj < 2; ++bj) {
                    f32x4 v0 = acc[ai][bj][m][0], v1 = acc[ai][bj][m][1];
                    if (do_rope) {
                        float a, b;
                        a = v0[0]; b = v0[1]; v0[0] = a * t0[0] - b * t0[1]; v0[1] = b * t0[0] + a * t0[1];
                        a = v0[2]; b = v0[3]; v0[2] = a * t0[2] - b * t0[3]; v0[3] = b * t0[2] + a * t0[3];
                        a = v1[0]; b = v1[1]; v1[0] = a * t1[0] - b * t1[1]; v1[1] = b * t1[0] + a * t1[1];
                        a = v1[2]; b = v1[3]; v1[2] = a * t1[2] - b * t1[3]; v1[3] = b * t1[2] + a * t1[3];
                    }
                    v0 = v0 * rsv[m]; v1 = v1 * rsv[m];
                    u32x4 w4; w4.x = pk2(v0[0], v0[1]); w4.y = pk2(v0[2], v0[3]); w4.z = pk2(v1[0], v1[1]); w4.w = pk2(v1[2], v1[3]);
                    *(u32x4*)(H + (size_t)row * NP + pn * 256 + bj * 128 + colt) = w4;
                    if (pn == 8 || pn == 9) {
                        const int t = row & (SEQ - 1);
                        if (t >= SEQ - 128) {
                            const int kvh = bj * 2 + (wc >> 1);
                            float* dst = (pn == 8 ? kp : vp) + ((size_t)((row >> 11) * 128 + (t - (SEQ - 128))) * 4 + kvh) * 64;
                            if (pn == 8) {
                                const int d0 = 16 * (wc & 1) + 4 * fq;
                                *(f32x4*)(dst + d0) = (f32x4){v0[0], v0[2], v1[0], v1[2]};
                                *(f32x4*)(dst + d0 + 32) = (f32x4){v0[1], v0[3], v1[1], v1[3]};
                            } else {
                                const int p0 = 32 * (wc & 1) + 8 * fq;
                                *(f32x4*)(dst + p0) = v0; *(f32x4*)(dst + p0 + 4) = v1;
                            }
                        }
                    }
                }
            }
        }
    }
};
struct EpiInS {
    bf16_t* H; const float* rope; float* ks; float* vs; const float* RSin;
    DI void operator()(f32x4 v, int m, int n) const {
        const int pn = n >> 8;
        if (pn < 9) {
            const f32x4 t = *(const f32x4*)(rope + ((size_t)SEQ * 32 + ((n & 63) >> 1)) * 2);
            float a, b;
            a = v[0]; b = v[1]; v[0] = a * t[0] - b * t[1]; v[1] = b * t[0] + a * t[1];
            a = v[2]; b = v[3]; v[2] = a * t[2] - b * t[3]; v[3] = b * t[2] + a * t[3];
        }
        float sc = 1.f;
        if (pn < 8) sc = 0.125f; else if (pn == 18 || pn == 19) sc = 0.08838834764831845f; else if (pn >= 30 && pn < 34) sc = 0.0625f;
        if (RSin) sc *= __builtin_amdgcn_rsqf(RSin[TP + m] * (1.f / DM) + EPS);
        v = v * sc;
        u32x2 w2; w2.x = pk2(v[0], v[1]); w2.y = pk2(v[2], v[3]);
        *(u32x2*)(H + (size_t)(TP + m) * NP + n) = w2;
        if (pn == 8) {
            float* dst = ks + ((size_t)(m * 128 + 127) * 4 + ((n - C_SK) >> 6)) * 64; const int d0 = (n & 63) >> 1;
            dst[d0] = v[0]; dst[d0 + 32] = v[1]; dst[d0 + 1] = v[2]; dst[d0 + 33] = v[3];
        } else if (pn == 9) {
            float* dst = vs + ((size_t)(m * 128 + 127) * 4 + ((n - C_SV) >> 6)) * 64 + (n & 63);
            *(f32x4*)dst = v;
        }
    }
};
struct EpiResS {
    const float* base; float* X; const float* gnext; bf16_t* XNo; float* RS; int fin;
    DI void operator()(f32x4 v, int m, int n) const {
        const f32x4 x = *(const f32x4*)(base + (size_t)m * DM + n) + v;
        if (!fin) *(f32x4*)(X + (size_t)m * DM + n) = x;
        if (gnext) {
            const f32x4 y = x * *(const f32x4*)(gnext + n);
            if (fin) *(f32x4*)(X + (size_t)m * DM + n) = y;
            else { u32x2 w2; w2.x = pk2(y[0], y[1]); w2.y = pk2(y[2], y[3]); *(u32x2*)(XNo + (size_t)(TP + m) * DM + n) = w2; }
            float q = (x[0] * x[0] + x[1] * x[1]) + (x[2] * x[2] + x[3] * x[3]);
            q += __shfl_xor(q, 16); q += __shfl_xor(q, 32);
            if (((n >> 2) & 3) == 0) atomicAdd(RS + TP + m, q);
        }
    }
};
template <class EpiS>
DI void skinny_task(unsigned char* lds, const bf16_t* X, const bf16_t* Wt, int task, int tid, const EpiS& E) {
    const int lane = tid & 63, w = tid >> 6, c16 = lane & 15, quad = lane >> 4;
    const int ntl = w & 1, ksp = w >> 1;
    const int n0 = task * 32 + ntl * 16;
    f32x4 acc0 = {0.f, 0.f, 0.f, 0.f}, acc1 = {0.f, 0.f, 0.f, 0.f};
    const bf16_t* wp = Wt + (size_t)(n0 + c16) * DM + ksp * 1024 + quad * 8;
    const bf16_t* xp0 = X + (size_t)c16 * DM + ksp * 1024 + quad * 8;
    const bf16_t* xp1 = xp0 + 16 * DM;
    for (int k0 = 0; k0 < 32; k0 += 16) {
        bf16x8 av[16], b0v[16], b1v[16];
#pragma unroll
        for (int j = 0; j < 16; ++j) { av[j] = *(const bf16x8*)(wp + (k0 + j) * 32); b0v[j] = *(const bf16x8*)(xp0 + (k0 + j) * 32); b1v[j] = *(const bf16x8*)(xp1 + (k0 + j) * 32); }
#pragma unroll
        for (int j = 0; j < 16; ++j) { acc0 = mfma16(av[j], b0v[j], acc0); acc1 = mfma16(av[j], b1v[j], acc1); }
    }
    f32x4* red = (f32x4*)lds;
    __syncthreads();
    red[(w * 2 + 0) * 64 + lane] = acc0; red[(w * 2 + 1) * 64 + lane] = acc1;
    __syncthreads();
    if (w < 2) {
#pragma unroll
        for (int mt = 0; mt < 2; ++mt) {
            f32x4 v = red[((0 * 2 + w) * 2 + mt) * 64 + lane];
#pragma unroll
            for (int kp = 1; kp < 4; ++kp) v += red[((kp * 2 + w) * 2 + mt) * 64 + lane];
            E(v, mt * 16 + c16, n0 + quad * 4);
        }
    }
}
struct EpiMem {
    static constexpr bool PERM = true, AFTER_DRAIN = false;
    bf16_t* MKV; float* outk; float* outv;
    DI void operator()(const f32x4 (&acc)[2][2][4][2], const pg8::Unit& u, int wr, int wc, int fr, int fq) const {
        const int row0 = u.pm * 256 + wr * 64 + fr;
#pragma unroll
        for (int ai = 0; ai < 2; ++ai)
#pragma unroll
            for (int m = 0; m < 4; ++m) {
                const int row = row0 + ai * 128 + m * 16;
#pragma unroll
                for (int bj = 0; bj < 2; ++bj) {
                    const int col = u.pn * 256 + bj * 128 + wc * 32 + 8 * fq;
                    const f32x4 v0 = acc[ai][bj][m][0], v1 = acc[ai][bj][m][1];
                    u32x4 w4; w4.x = pk2(v0[0], v0[1]); w4.y = pk2(v0[2], v0[3]); w4.z = pk2(v1[0], v1[1]); w4.w = pk2(v1[2], v1[3]);
                    *(u32x4*)(MKV + (size_t)row * 2048 + col) = w4;
                    float* dst = (col < 1024) ? (outk + (size_t)row * 1024 + col) : (outv + (size_t)row * 1024 + (col - 1024));
                    *(f32x4*)dst = v0; *(f32x4*)(dst + 4) = v1;
                }
            }
    }
};
struct EpiRes {
    static constexpr bool PERM = true, AFTER_DRAIN = false;
    const float* baseP; float* X; const float* gnext; bf16_t* XNo; float* RS; int fin;
    DI void operator()(const f32x4 (&acc)[2][2][4][2], const pg8::Unit& u, int wr, int wc, int fr, int fq) const {
        const int row0 = u.pm * 256 + wr * 64 + fr;
        const int col0 = u.pn * 256 + wc * 32 + 8 * fq;
        f32x4 gv[2][2];
#pragma unroll
        for (int bj = 0; bj < 2; ++bj) { gv[bj][0] = (f32x4){0.f, 0.f, 0.f, 0.f}; gv[bj][1] = gv[bj][0];
            if (gnext) { gv[bj][0] = *(const f32x4*)(gnext + col0 + bj * 128); gv[bj][1] = *(const f32x4*)(gnext + col0 + bj * 128 + 4); } }
#pragma unroll
        for (int am = 0; am < 4; ++am) {
            const int ai = am >> 1, mb = (am & 1) * 2;
            f32x4 bv[2][2][2];
#pragma unroll
            for (int mm = 0; mm < 2; ++mm)
#pragma unroll
                for (int bj = 0; bj < 2; ++bj) {
                    const float* bp = baseP + (size_t)(row0 + ai * 128 + (mb + mm) * 16) * DM + col0 + bj * 128;
                    bv[mm][bj][0] = *(const f32x4*)bp; bv[mm][bj][1] = *(const f32x4*)(bp + 4);
                }
#pragma unroll
            for (int mm = 0; mm < 2; ++mm) {
                const int m = mb + mm;
                const int row = row0 + ai * 128 + m * 16;
                float q = 0.f;
#pragma unroll
                for (int bj = 0; bj < 2; ++bj) {
                    float* xp = X + (size_t)row * DM + col0 + bj * 128;
                    const f32x4 x0 = bv[mm][bj][0] + acc[ai][bj][m][0], x1 = bv[mm][bj][1] + acc[ai][bj][m][1];
                    if (!fin && X) { *(f32x4*)xp = x0; *(f32x4*)(xp + 4) = x1; }
                    if (gnext) {
                        const f32x4 y0 = x0 * gv[bj][0], y1 = x1 * gv[bj][1];
                        if (fin) { *(f32x4*)xp = y0; *(f32x4*)(xp + 4) = y1; }
                        else { u32x4 w4; w4.x = pk2(y0[0], y0[1]); w4.y = pk2(y0[2], y0[3]); w4.z = pk2(y1[0], y1[1]); w4.w = pk2(y1[2], y1[3]);
                               *(u32x4*)(XNo + (size_t)row * DM + col0 + bj * 128) = w4; }
                        q += ((x0[0] * x0[0] + x0[1] * x0[1]) + (x0[2] * x0[2] + x0[3] * x0[3])) + ((x1[0] * x1[0] + x1[1] * x1[1]) + (x1[2] * x1[2] + x1[3] * x1[3]));
                    }
                }
                if (gnext) { q += __shfl_xor(q, 16); q += __shfl_xor(q, 32); if (fq == 0) atomicAdd(RS + row, q); }
            }
        }
    }
};

struct EpiFin {
    static constexpr bool PERM = true, AFTER_DRAIN = false;
    const bf16_t* XNb; const float* g1; float* Y; const float* g; float* RS; unsigned* pcnt;
    DI void operator()(const f32x4 (&acc_)[2][2][4][2], const pg8::Unit& u, int wr, int wc, int fr, int fq) const {
        f32x4 (&acc)[2][2][4][2] = const_cast<f32x4 (&)[2][2][4][2]>(acc_);
        const int row0 = u.pm * 256 + wr * 64 + fr;
        const int col0 = u.pn * 256 + wc * 32 + 8 * fq;
        f32x4 gv[2][2];
#pragma unroll
        for (int bj = 0; bj < 2; ++bj) { gv[bj][0] = *(const f32x4*)(g + col0 + bj * 128); gv[bj][1] = *(const f32x4*)(g + col0 + bj * 128 + 4); }
        f32x4 rg[2][2];
#pragma unroll
        for (int bj = 0; bj < 2; ++bj)
#pragma unroll
            for (int hh = 0; hh < 2; ++hh) { const f32x4 t = *(const f32x4*)(g1 + col0 + bj * 128 + 4 * hh);
                rg[bj][hh] = (f32x4){__builtin_amdgcn_rcpf(t[0]), __builtin_amdgcn_rcpf(t[1]), __builtin_amdgcn_rcpf(t[2]), __builtin_amdgcn_rcpf(t[3])}; }
#pragma unroll
        for (int am = 0; am < 4; ++am) {
            const int ai = am >> 1, mb = (am & 1) * 2;
            u32x4 bw[2][2];
#pragma unroll
            for (int mm = 0; mm < 2; ++mm)
#pragma unroll
                for (int bj = 0; bj < 2; ++bj) bw[mm][bj] = *(const u32x4*)(XNb + (size_t)(row0 + ai * 128 + (mb + mm) * 16) * DM + col0 + bj * 128);
#pragma unroll
            for (int mm = 0; mm < 2; ++mm) {
                const int m = mb + mm;
                float q = 0.f;
#pragma unroll
                for (int bj = 0; bj < 2; ++bj) {
                    const u32x4 wv = bw[mm][bj];
                    const f32x4 x0 = (f32x4){bflo(wv.x), bfhi(wv.x), bflo(wv.y), bfhi(wv.y)} * rg[bj][0] + acc[ai][bj][m][0];
                    const f32x4 x1 = (f32x4){bflo(wv.z), bfhi(wv.z), bflo(wv.w), bfhi(wv.w)} * rg[bj][1] + acc[ai][bj][m][1];
                    q += ((x0[0] * x0[0] + x0[1] * x0[1]) + (x0[2] * x0[2] + x0[3] * x0[3])) + ((x1[0] * x1[0] + x1[1] * x1[1]) + (x1[2] * x1[2] + x1[3] * x1[3]));
                    acc[ai][bj][m][0] = x0 * gv[bj][0]; acc[ai][bj][m][1] = x1 * gv[bj][1];
                }
                q += __shfl_xor(q, 16); q += __shfl_xor(q, 32);
                if (fq == 0) atomicAdd(RS + row0 + ai * 128 + m * 16, q);
            }
        }
        asm volatile("s_waitcnt vmcnt(0)" ::: "memory");
        unsigned* pc = pcnt + 64 * u.pm;
        if (fr == 0 && fq == 0) __hip_atomic_fetch_add(pc, 1u, __ATOMIC_RELAXED, __HIP_MEMORY_SCOPE_AGENT);
        { unsigned sp = 0; while (__hip_atomic_load(pc, __ATOMIC_RELAXED, __HIP_MEMORY_SCOPE_AGENT) < 128u) { __builtin_amdgcn_s_sleep(2); if (++sp > (1u << 21)) break; } }
        asm volatile("" ::: "memory");
#pragma unroll
        for (int ai = 0; ai < 2; ++ai)
#pragma unroll
            for (int m = 0; m < 4; ++m) {
                const int row = row0 + ai * 128 + m * 16;
                const float rs = __builtin_amdgcn_rsqf(__hip_atomic_load(RS + row, __ATOMIC_RELAXED, __HIP_MEMORY_SCOPE_AGENT) * (1.f / DM) + EPS);
#pragma unroll
                for (int bj = 0; bj < 2; ++bj) {
                    float* yp = Y + (size_t)row * DM + col0 + bj * 128;
                    *(f32x4*)yp = acc[ai][bj][m][0] * rs; *(f32x4*)(yp + 4) = acc[ai][bj][m][1] * rs;
                }
            }
    }
};
struct PanelOrder {
    int G, c;
    DI void init(int G_, int c_) { G = G_; c = c_; }
    DI bool next(int i, pg8::Unit& u) const {
        if (G == 256) { if (i >= 2) return false; const int xcd = c & 7, r = c >> 3, j = xcd >> 1, hx = xcd & 1; u.pm = 16 * i + 4 * j + (r & 3); u.pn = 8 * hx + (r >> 2); return true; }
        const long L = (long)i * G + c; if (L >= 512) return false; u.pm = (int)(L >> 4); u.pn = (int)(L & 15); return true;
    }
    DI void a_ready(const pg8::Unit&) const {}
    DI void done(const pg8::Unit&) const {}
};

DI int dst_row_in(int s) {
    if (s < 2304) { const int d = s & 63; return (s & ~63) + 2 * (d & 31) + (d >> 5); }
    if (s < 6656) return s;
    if (s < 6672) return 9728 + (s - 6656);
    return s - 16;
}
struct TrItem { const float* W; bf16_t* WT; int N, item, inmap; };
DI void tr_load(const TrItem& t, f32x4 (&tv)[16], int lane) {
    const int nblk = (t.N + 63) >> 6, kb = t.item / nblk, nb = t.item - kb * nblk, k0 = 64 * kb, n0 = 64 * nb;
    const int cl = (lane & 15) * 4, rl = lane >> 4;
    const bool okc = (n0 + cl) < t.N;
#pragma unroll
    for (int i = 0; i < 16; ++i) { tv[i] = (f32x4){0.f, 0.f, 0.f, 0.f}; if (okc) tv[i] = *(const f32x4*)(t.W + (size_t)(k0 + 4 * i + rl) * t.N + n0 + cl); }
}
DI void tr_store(const TrItem& t, const f32x4 (&tv)[16], float* scr, int lane) {
    const int nblk = (t.N + 63) >> 6, kb = t.item / nblk, nb = t.item - kb * nblk, k0 = 64 * kb, n0 = 64 * nb;
    const int cl = (lane & 15) * 4, rl = lane >> 4;
#pragma unroll
    for (int i = 0; i < 16; ++i) { float* s = scr + (4 * i + rl) * 65 + cl; s[0] = tv[i][0]; s[1] = tv[i][1]; s[2] = tv[i][2]; s[3] = tv[i][3]; }
    asm volatile("s_waitcnt lgkmcnt(0)" ::: "memory");
    const int c = lane & 7;
#pragma unroll
    for (int j = 0; j < 8; ++j) {
        const int n = (lane >> 3) + 8 * j;
        if (n0 + n < t.N) {
            const float* s = scr + (8 * c) * 65 + n;
            u32x4 o; o.x = pk2(s[0], s[65]); o.y = pk2(s[2 * 65], s[3 * 65]); o.z = pk2(s[4 * 65], s[5 * 65]); o.w = pk2(s[6 * 65], s[7 * 65]);
            const int row = t.inmap ? dst_row_in(n0 + n) : (n0 + n);
            *(u32x4*)(t.WT + (size_t)row * DM + k0 + 8 * c) = o;
        }
    }
    asm volatile("s_waitcnt lgkmcnt(0)" ::: "memory");
}
DI void norm_row(const float* src, const float* g, bf16_t* dstb, float* dstf, int lane) {
    const f32x4* xr = (const f32x4*)src + lane;
    f32x4 v[16]; float s = 0.f;
#pragma unroll
    for (int j = 0; j < 16; ++j) { v[j] = xr[64 * j]; s += (v[j][0] * v[j][0] + v[j][1] * v[j][1]) + (v[j][2] * v[j][2] + v[j][3] * v[j][3]); }
    const f32x4* gr = (const f32x4*)g + lane;
    f32x4 gv[16];
#pragma unroll
    for (int j = 0; j < 16; ++j) gv[j] = gr[64 * j];
    const float rs = __builtin_amdgcn_rsqf(wave_sum(s) * (1.f / DM) + EPS);
#pragma unroll
    for (int j = 0; j < 16; ++j) {
        const f32x4 o = v[j] * rs * gv[j];
        if (dstb) { u32x2 w2; w2.x = pk2(o[0], o[1]); w2.y = pk2(o[2], o[3]); *((u32x2*)dstb + lane + 64 * j) = w2; }
        else *((f32x4*)dstf + lane + 64 * j) = o;
    }
}
DI void rope_entry(float* tab, int idx) {
    const int pi = idx >> 5, i = idx & 31;
    const double pos = pi < SEQ ? (double)pi : 16384.0;
    double inv = 1.0; for (int k = 0; k < i; ++k) inv *= 0.7498942093324559;
    const double a = pos * inv;
    const double q = __builtin_rint(a * 0.6366197723675814);
    const double r = (a - q * 1.5707963267948966) - q * 6.123233995736766e-17;
    const int qi = ((int)q) & 3;
    const double r2 = r * r;
    const double sn = r * (1.0 + r2 * (-1.0 / 6 + r2 * (1.0 / 120 + r2 * (-1.0 / 5040 + r2 * (1.0 / 362880 + r2 * (-1.0 / 39916800 + r2 * (1.0 / 6227020800.0)))))));
    const double cs = 1.0 + r2 * (-0.5 + r2 * (1.0 / 24 + r2 * (-1.0 / 720 + r2 * (1.0 / 40320 + r2 * (-1.0 / 3628800 + r2 * (1.0 / 479001600 + r2 * (-1.0 / 87178291200.0)))))));
    double c, s;
    if (qi == 0) { c = cs; s = sn; } else if (qi == 1) { c = -sn; s = cs; } else if (qi == 2) { c = -cs; s = -sn; } else { c = sn; s = -cs; }
    tab[2 * idx] = (float)c; tab[2 * idx + 1] = (float)s;
}

DI void swa_unit(unsigned char* lds, const bf16_t* H, bf16_t* Gt, const float* sinks, int u, int tid) {
    const int kvh = u & 3, blk = (u >> 2) & 15, b = u >> 6;
    bf16_t* Ks = (bf16_t*)lds;
    bf16_t* Vt = (bf16_t*)(lds + 39168);
    const int lane = tid & 63, w = tid >> 6, c16 = lane & 15, quad = lane >> 4;
    const int qi = w * 16 + c16;
    const size_t qrow = (size_t)(b * SEQ + blk * 128 + qi);
    bf16x8 qc0 = *(const bf16x8*)(H + qrow * NP + C_SQ + kvh * 512 + quad * 8), qc1 = *(const bf16x8*)(H + qrow * NP + C_SQ + kvh * 512 + 32 + quad * 8);
    __syncthreads();
    {
        const int r = tid >> 1, half = tid & 1;
        const int tok = blk * 128 - 128 + r;
        u32x4 kv[4], vv[4];
#pragma unroll
        for (int i = 0; i < 4; ++i) { kv[i] = (u32x4){0u, 0u, 0u, 0u}; vv[i] = (u32x4){0u, 0u, 0u, 0u}; }
        if (tok >= 0) {
            const bf16_t* src = H + (size_t)(b * SEQ + tok) * NP + kvh * 64 + half * 32;
#pragma unroll
            for (int i = 0; i < 4; ++i) { kv[i] = *(const u32x4*)(src + C_SK + i * 8); vv[i] = *(const u32x4*)(src + C_SV + i * 8); }
        }
#pragma unroll
        for (int i = 0; i < 4; ++i) *(u32x4*)(Ks + r * 72 + half * 32 + i * 8) = kv[i];
#pragma unroll
        for (int i = 0; i < 4; ++i)
#pragma unroll
            for (int e = 0; e < 4; ++e) {
                const unsigned wv = vv[i][e];
                Vt[(half * 32 + i * 8 + 2 * e) * 280 + r] = (bf16_t)(wv & 0xffffu);
                Vt[(half * 32 + i * 8 + 2 * e + 1) * 280 + r] = (bf16_t)(wv >> 16);
            }
        for (int i = tid; i < 576; i += 512) ((unsigned*)(Ks + 256 * 72))[i] = 0u;
        { const int d = tid >> 3, cc = 256 + (tid & 7) * 2; *(unsigned*)(Vt + d * 280 + cc) = 0u; }
    }
    __syncthreads();
    for (int g = 0; g < 8; ++g) {
        const int head = kvh * 8 + g;
        bf16x8 qf[2]; qf[0] = qc0; qf[1] = qc1;
        { const int hn = kvh * 8 + (g < 7 ? g + 1 : g);
          qc0 = *(const bf16x8*)(H + qrow * NP + C_SQ + hn * 64 + quad * 8); qc1 = *(const bf16x8*)(H + qrow * NP + C_SQ + hn * 64 + 32 + quad * 8); }
        u32x2 gwv[4];
#pragma unroll
        for (int mt = 0; mt < 4; ++mt) gwv[mt] = *(const u32x2*)(H + qrow * NP + C_SG + head * 64 + mt * 16 + quad * 4);
        f32x4 s[10];
#pragma unroll
        for (int i = 0; i < 10; ++i) {
            s[i] = (f32x4){0.f, 0.f, 0.f, 0.f};
            const bf16_t* kp = Ks + ((w + i) * 16 + c16) * 72 + quad * 8;
#pragma unroll
            for (int ks = 0; ks < 2; ++ks) s[i] = mfma16(*(const bf16x8*)(kp + ks * 32), qf[ks], s[i]);
        }
        const float sink = sinks[head];
        float mx = sink;
        int qiv = qi + 128 - (w * 16 + quad * 4); asm volatile("" : "+v"(qiv));
        const int lowlim = blk > 0 ? 0 : 128;
#pragma unroll
        for (int i = 0; i < 10; ++i)
#pragma unroll
            for (int j = 0; j < 4; ++j) {
                const int sj = (w + i) * 16 + quad * 4 + j, diff = qiv - (i * 16 + j);
                const bool valid = (unsigned)diff < 128u && sj >= lowlim;
                s[i][j] = valid ? s[i][j] : -INFINITY;
                mx = fmaxf(mx, s[i][j]);
            }
        mx = fmaxf(mx, __shfl_xor(mx, 16)); mx = fmaxf(mx, __shfl_xor(mx, 32));
        float sum = 0.f;
#pragma unroll
        for (int i = 0; i < 10; ++i)
#pragma unroll
            for (int j = 0; j < 4; ++j) { const float p = __expf(s[i][j] - mx); s[i][j] = p; sum += p; }
        sum += __shfl_xor(sum, 16); sum += __shfl_xor(sum, 32);
        sum += __expf(sink - mx);
        const float inv = __builtin_amdgcn_rcpf(sum);
        f32x4 o[4];
#pragma unroll
        for (int mt = 0; mt < 4; ++mt) o[mt] = (f32x4){0.f, 0.f, 0.f, 0.f};
#pragma unroll
        for (int st = 0; st < 5; ++st) {
            const bf16x8 pb = pack8(s[2 * st], s[2 * st + 1]);
#pragma unroll
            for (int mt = 0; mt < 4; ++mt) {
                const bf16_t* vp = Vt + (mt * 16 + c16) * 280 + (w + 2 * st) * 16 + quad * 4;
                o[mt] = mfma16(cat4(*(const s16x4*)vp, *(const s16x4*)(vp + 16)), pb, o[mt]);
            }
        }
#pragma unroll
        for (int mt = 0; mt < 4; ++mt) {
            const int d = mt * 16 + quad * 4;
            const u32x2 gw = gwv[mt];
            u32x2 ow;
            ow.x = pk2(o[mt][0] * inv * silu(bflo(gw.x)), o[mt][1] * inv * silu(bfhi(gw.x)));
            ow.y = pk2(o[mt][2] * inv * silu(bflo(gw.y)), o[mt][3] * inv * silu(bfhi(gw.y)));
            *(u32x2*)(Gt + qrow * DM + head * 64 + d) = ow;
        }
    }
}

DI void mem_unit(unsigned char* lds, const bf16_t* H, const bf16_t* MKV, bf16_t* Gt, int u, int tid) {
    const int qt = u & 15, h = (u >> 4) & 3, b = u >> 6;
    bf16_t* Kc = (bf16_t*)lds;
    bf16_t* Vc = (bf16_t*)(lds + 33792);
    const int lane = tid & 63, w = tid >> 6, c16 = lane & 15, quad = lane >> 4;
    const size_t qrow = (size_t)(b * SEQ + qt * 128 + w * 16 + c16);
    const int srow = tid >> 3, seg = tid & 7;
    const bf16_t* ksrc = MKV + (size_t)(b * 256 + srow) * 2048 + h * 256 + seg * 32;
    const bf16_t* vsrc = MKV + (size_t)(b * 256 + lane) * 2048 + 1024 + h * 256 + w * 32;
    u32x4 pre[4];
#pragma unroll
    for (int i = 0; i < 4; ++i) pre[i] = *(const u32x4*)(ksrc + i * 8);
    bf16x8 qf[8];
#pragma unroll
    for (int ks = 0; ks < 8; ++ks) qf[ks] = *(const bf16x8*)(H + qrow * NP + C_MQ + h * 256 + ks * 32 + quad * 8);
    f32x4 s[16];
#pragma unroll
    for (int c = 0; c < 4; ++c) {
        __syncthreads();
#pragma unroll
        for (int i = 0; i < 4; ++i) *(u32x4*)(Kc + srow * 264 + seg * 32 + i * 8) = pre[i];
        if (c < 3) {
#pragma unroll
            for (int i = 0; i < 4; ++i) pre[i] = *(const u32x4*)(ksrc + (size_t)(c + 1) * 64 * 2048 + i * 8);
        } else {
#pragma unroll
            for (int i = 0; i < 4; ++i) pre[i] = *(const u32x4*)(vsrc + i * 8);
        }
        __syncthreads();
#pragma unroll
        for (int kt = 0; kt < 4; ++kt) {
            f32x4 a = {0.f, 0.f, 0.f, 0.f};
            const bf16_t* kp = Kc + (kt * 16 + c16) * 264 + quad * 8;
#pragma unroll
            for (int ks = 0; ks < 8; ++ks) a = mfma16(*(const bf16x8*)(kp + ks * 32), qf[ks], a);
            s[c * 4 + kt] = a;
        }
    }
    u32x2 gwv[16];
#pragma unroll
    for (int mt = 0; mt < 16; ++mt) gwv[mt] = *(const u32x2*)(H + qrow * NP + C_MG + h * 256 + mt * 16 + quad * 4);
    float mx = -INFINITY;
#pragma unroll
    for (int i = 0; i < 16; ++i)
#pragma unroll
        for (int j = 0; j < 4; ++j) mx = fmaxf(mx, s[i][j]);
    mx = fmaxf(mx, __shfl_xor(mx, 16)); mx = fmaxf(mx, __shfl_xor(mx, 32));
    float sum = 0.f;
#pragma unroll
    for (int i = 0; i < 16; ++i)
#pragma unroll
        for (int j = 0; j < 4; ++j) { const float p = __expf(s[i][j] - mx); s[i][j] = p; sum += p; }
    sum += __shfl_xor(sum, 16); sum += __shfl_xor(sum, 32);
    const float inv = __builtin_amdgcn_rcpf(sum);
    bf16x8 pbv[8];
#pragma unroll
    for (int i = 0; i < 8; ++i) pbv[i] = pack8(s[2 * i], s[2 * i + 1]);
    f32x4 o[16];
#pragma unroll
    for (int mt = 0; mt < 16; ++mt) o[mt] = (f32x4){0.f, 0.f, 0.f, 0.f};
#pragma unroll
    for (int c = 0; c < 4; ++c) {
        __syncthreads();
#pragma unroll
        for (int i = 0; i < 4; ++i)
#pragma unroll
            for (int e = 0; e < 4; ++e) {
                Vc[(w * 32 + i * 8 + 2 * e) * 72 + lane] = (bf16_t)(pre[i][e] & 0xffffu);
                Vc[(w * 32 + i * 8 + 2 * e + 1) * 72 + lane] = (bf16_t)(pre[i][e] >> 16);
            }
        if (c < 3) {
#pragma unroll
            for (int i = 0; i < 4; ++i) pre[i] = *(const u32x4*)(vsrc + (size_t)(c + 1) * 64 * 2048 + i * 8);
        }
        __syncthreads();
#pragma unroll
        for (int st = 0; st < 2; ++st) {
            const bf16x8 pb = pbv[c * 2 + st];
#pragma unroll
            for (int mt = 0; mt < 16; ++mt) {
                const bf16_t* vp = Vc + (mt * 16 + c16) * 72 + (2 * st) * 16 + quad * 4;
                o[mt] = mfma16(cat4(*(const s16x4*)vp, *(const s16x4*)(vp + 16)), pb, o[mt]);
            }
        }
    }
#pragma unroll
    for (int mt = 0; mt < 16; ++mt) {
        const int d = mt * 16 + quad * 4;
        const u32x2 gw = gwv[mt];
        u32x2 ow;
        ow.x = pk2(o[mt][0] * inv * silu(bflo(gw.x)), o[mt][1] * inv * silu(bfhi(gw.x)));
        ow.y = pk2(o[mt][2] * inv * silu(bflo(gw.y)), o[mt][3] * inv * silu(bfhi(gw.y)));
        *(u32x2*)(Gt + qrow * DM + 3072 + h * 256 + d) = ow;
    }
}

DI float logsig16(float z) { return (fminf(z, 0.f) - __logf(1.f + __expf(-fabsf(z)))) * 0.0625f; }

constexpr int GI_QS = 0, GI_AS = 17408, GI_VT = 26624, GI_BYTES = 63488, GI_IMG = 26624;
DI void gla_prep_unit(unsigned char* lds, const bf16_t* H, const float* wg, const float* bg, u32x2* Ug, float* EBLg, unsigned char* IMG, int u, int tid) {
    const int ch = u & 31, h = (u >> 5) & 3, b = u >> 7;
    bf16_t* Qs = (bf16_t*)(lds + GI_QS);
    bf16_t* As = (bf16_t*)(lds + GI_AS);
    bf16_t* Vt = (bf16_t*)(lds + GI_VT);
    bf16_t* Ks = (bf16_t*)(lds + 63488);
    bf16_t* Kt = (bf16_t*)(lds + 80896);
    float* LR = (float*)(lds + 99328);
    float* WgL = (float*)(lds + 103424);
    float* GT = (float*)(lds + 111616);
    const int lane = tid & 63, w = tid >> 6, c16 = lane & 15, quad = lane >> 4;
    const size_t row0 = (size_t)(b * SEQ + ch * 64);
    __syncthreads();
    { const int i = tid >> 3, r2 = (tid & 7) * 2; const unsigned wv = *(const unsigned*)(H + (row0 + i) * NP + C_LR + r2); LR[i * 16 + r2] = bflo(wv); LR[i * 16 + r2 + 1] = bfhi(wv); }
#pragma unroll
    for (int r = 0; r < 4; ++r) { const int idx = tid + 512 * r; WgL[idx] = wg[(idx >> 7) * 512 + h * 128 + (idx & 127)]; }
    const int dk = tid & 127, ig = tid >> 7;
    const float bgc = bg[h * 128 + dk];
    unsigned short qr[16], kr[16];
#pragma unroll
    for (int ii = 0; ii < 16; ++ii) { const bf16_t* src = H + (row0 + ig * 16 + ii) * NP + h * 128 + dk; qr[ii] = src[C_GQ]; kr[ii] = src[C_GK]; }
    u32x4 vpre[4];
#pragma unroll
    for (int i = 0; i < 4; ++i) vpre[i] = *(const u32x4*)(H + (row0 + lane) * NP + C_GV + h * 256 + w * 32 + i * 8);
    __syncthreads();
    float bb[16];
    {
        float wgc[16];
#pragma unroll
        for (int r = 0; r < 16; ++r) wgc[r] = WgL[r * 128 + dk];
        float run = 0.f;
#pragma unroll
        for (int ii = 0; ii < 16; ++ii) {
            const int i = ig * 16 + ii;
            float z = bgc;
#pragma unroll
            for (int r = 0; r < 16; ++r) z += LR[i * 16 + r] * wgc[r];
            run += logsig16(z); bb[ii] = run;
        }
        GT[ig * 128 + dk] = run;
    }
#pragma unroll
    for (int i = 0; i < 4; ++i)
#pragma unroll
        for (int e = 0; e < 4; ++e) {
            Vt[(w * 32 + i * 8 + 2 * e) * 72 + lane] = (bf16_t)(vpre[i][e] & 0xffffu);
            Vt[(w * 32 + i * 8 + 2 * e + 1) * 72 + lane] = (bf16_t)(vpre[i][e] >> 16);
        }
    __syncthreads();
    {
        const float t0 = GT[dk], t1 = GT[128 + dk], t2 = GT[256 + dk], t3 = GT[384 + dk];
        const float bl = (t0 + t1) + (t2 + t3);
        const float off = (ig > 0 ? t0 : 0.f) + (ig > 1 ? t1 : 0.f) + (ig > 2 ? t2 : 0.f);
#pragma unroll
        for (int ii = 0; ii < 16; ++ii) {
            const int i = ig * 16 + ii;
            const float bv = off + bb[ii], q = bf2f(qr[ii]), k = bf2f(kr[ii]);
            Qs[i * 136 + dk] = f2bf(q * __expf(bv));
            Ks[i * 136 + dk] = f2bf(k * __expf(-bv));
            Kt[dk * 72 + i] = f2bf(k * __expf(bl - bv));
        }
        if (ig == 0) EBLg[(size_t)u * 128 + dk] = __expf(bl);
    }
    __syncthreads();
#pragma unroll
    for (int tt = 0; tt < 2; ++tt) {
        const int t = 2 * w + tt, mt = t >> 2, nt = t & 3;
        f32x4 a = {0.f, 0.f, 0.f, 0.f};
        if (nt <= mt) {
#pragma unroll
            for (int ks = 0; ks < 4; ++ks)
                a = mfma16(*(const bf16x8*)(Qs + (mt * 16 + c16) * 136 + ks * 32 + quad * 8), *(const bf16x8*)(Ks + (nt * 16 + c16) * 136 + ks * 32 + quad * 8), a);
        }
#pragma unroll
        for (int jj = 0; jj < 4; ++jj) { const int i = mt * 16 + quad * 4 + jj, j = nt * 16 + c16; As[i * 72 + j] = f2bf(j <= i ? a[jj] : 0.f); }
    }
#pragma unroll
    for (int kt = 0; kt < 8; ++kt) {
        f32x4 s0 = {0.f, 0.f, 0.f, 0.f}, s1 = {0.f, 0.f, 0.f, 0.f};
#pragma unroll
        for (int ks = 0; ks < 2; ++ks) {
            const bf16x8 a = *(const bf16x8*)(Kt + (kt * 16 + c16) * 72 + ks * 32 + quad * 8);
            s0 = mfma16(a, *(const bf16x8*)(Vt + ((2 * w) * 16 + c16) * 72 + ks * 32 + quad * 8), s0);
            s1 = mfma16(a, *(const bf16x8*)(Vt + ((2 * w + 1) * 16 + c16) * 72 + ks * 32 + quad * 8), s1);
        }
        { u32x2 p0, p1; p0.x = pk2(s0[0], s0[1]); p0.y = pk2(s0[2], s0[3]); p1.x = pk2(s1[0], s1[1]); p1.y = pk2(s1[2], s1[3]);
          Ug[((size_t)(u * 8 + kt) * 16 + 2 * w) * 64 + lane] = p0; Ug[((size_t)(u * 8 + kt) * 16 + 2 * w + 1) * 64 + lane] = p1; }
    }
    __syncthreads();
    { u32x4* dst = (u32x4*)(IMG + (size_t)u * GI_IMG); const u32x4* srcl = (const u32x4*)lds;
      for (int i = tid; i < GI_IMG / 16; i += 512) dst[i] = srcl[i]; }
}
DI void gla_scan_task(const u32x2* Ug, const float* EBLg, u32x2* SF2, float* state_out, int t, int lane) {
    const int nt = t & 15, kt = (t >> 4) & 7, bh = t >> 7;
    const int c16 = lane & 15, quad = lane >> 4;
    f32x4 s0 = {0.f, 0.f, 0.f, 0.f};
    for (int n0 = 0; n0 < 32; n0 += 16) {
        f32x4 ev[16], uv[16];
#pragma unroll
        for (int j = 0; j < 16; ++j) {
            const size_t u = (size_t)bh * 32 + n0 + j;
            ev[j] = *(const f32x4*)(EBLg + u * 128 + kt * 16 + quad * 4);
            { const u32x2 p = Ug[((u * 8 + kt) * 16 + nt) * 64 + lane]; uv[j] = (f32x4){bflo(p.x), bfhi(p.x), bflo(p.y), bfhi(p.y)}; }
        }
#pragma unroll
        for (int j = 0; j < 16; ++j) {
            const size_t u = (size_t)bh * 32 + n0 + j;
            u32x2 pk; pk.x = pk2(s0[0], s0[1]); pk.y = pk2(s0[2], s0[3]);
            SF2[(((u * 4 + (kt >> 1)) * 16 + nt) * 64 + lane) * 2 + (kt & 1)] = pk;
            s0 = s0 * ev[j] + uv[j];
        }
    }
#pragma unroll
    for (int jj = 0; jj < 4; ++jj) state_out[((size_t)bh * 128 + kt * 16 + quad * 4 + jj) * 256 + nt * 16 + c16] = s0[jj];
}
DI void gla_out_unit(unsigned char* lds, const bf16_t* H, bf16_t* Gt, const float* gng, const u32x4* SF, const unsigned char* IMG, int u, int tid) {
    const int ch = u & 31, h = (u >> 5) & 3, b = u >> 7;
    const bf16_t* Qs = (const bf16_t*)(lds + GI_QS);
    const bf16_t* As = (const bf16_t*)(lds + GI_AS);
    const bf16_t* Vt = (const bf16_t*)(lds + GI_VT);
    float* SSw = (float*)(lds + GI_BYTES);
    const int lane = tid & 63, w = tid >> 6, c16 = lane & 15, quad = lane >> 4;
    const size_t row0 = (size_t)(b * SEQ + ch * 64);
    unsigned short gtv[4][4][2];
#pragma unroll
    for (int mt = 0; mt < 4; ++mt)
#pragma unroll
        for (int jj = 0; jj < 4; ++jj)
#pragma unroll
            for (int n = 0; n < 2; ++n) gtv[mt][jj][n] = H[(row0 + mt * 16 + quad * 4 + jj) * NP + C_GG + h * 256 + (2 * w + n) * 16 + c16];
    u32x4 vpre[4];
#pragma unroll
    for (int i = 0; i < 4; ++i) vpre[i] = *(const u32x4*)(H + (row0 + lane) * NP + C_GV + h * 256 + w * 32 + i * 8);
    __syncthreads();
    { const u32x4* src = (const u32x4*)(IMG + (size_t)u * GI_IMG); u32x4* dstl = (u32x4*)lds;
      for (int i = tid; i < GI_IMG / 16; i += 512) dstl[i] = src[i]; }
    { bf16_t* Vw = (bf16_t*)(lds + GI_VT);
#pragma unroll
      for (int i = 0; i < 4; ++i)
#pragma unroll
          for (int e = 0; e < 4; ++e) {
              Vw[(w * 32 + i * 8 + 2 * e) * 72 + lane] = (bf16_t)(vpre[i][e] & 0xffffu);
              Vw[(w * 32 + i * 8 + 2 * e + 1) * 72 + lane] = (bf16_t)(vpre[i][e] >> 16);
          } }
    bf16x8 sb[4][2];
#pragma unroll
    for (int ks = 0; ks < 4; ++ks)
#pragma unroll
        for (int n = 0; n < 2; ++n) sb[ks][n] = __builtin_bit_cast(bf16x8, SF[(((size_t)u * 4 + ks) * 16 + 2 * w + n) * 64 + lane]);
    __syncthreads();
    f32x4 o[4][2];
#pragma unroll
    for (int mt = 0; mt < 4; ++mt) {
        o[mt][0] = (f32x4){0.f, 0.f, 0.f, 0.f}; o[mt][1] = (f32x4){0.f, 0.f, 0.f, 0.f};
#pragma unroll
        for (int ks = 0; ks < 4; ++ks) {
            const bf16_t* qp = Qs + (mt * 16 + c16) * 136 + (2 * ks) * 16 + quad * 4;
            const bf16x8 a = cat4(*(const s16x4*)qp, *(const s16x4*)(qp + 16));
            o[mt][0] = mfma16(a, sb[ks][0], o[mt][0]); o[mt][1] = mfma16(a, sb[ks][1], o[mt][1]);
        }
#pragma unroll
        for (int ks = 0; ks < 2; ++ks) {
            const bf16x8 a = *(const bf16x8*)(As + (mt * 16 + c16) * 72 + ks * 32 + quad * 8);
#pragma unroll
            for (int n = 0; n < 2; ++n) o[mt][n] = mfma16(a, *(const bf16x8*)(Vt + ((2 * w + n) * 16 + c16) * 72 + ks * 32 + quad * 8), o[mt][n]);
        }
    }
#pragma unroll
    for (int mt = 0; mt < 4; ++mt)
#pragma unroll
        for (int jj = 0; jj < 4; ++jj) {
            float q = o[mt][0][jj] * o[mt][0][jj] + o[mt][1][jj] * o[mt][1][jj];
            q += __shfl_xor(q, 1); q += __shfl_xor(q, 2); q += __shfl_xor(q, 4); q += __shfl_xor(q, 8);
            if (c16 == 0) SSw[w * 64 + mt * 16 + quad * 4 + jj] = q;
        }
    __syncthreads();
    const float gn0 = gng[h * 256 + (2 * w) * 16 + c16], gn1 = gng[h * 256 + (2 * w + 1) * 16 + c16];
#pragma unroll
    for (int mt = 0; mt < 4; ++mt)
#pragma unroll
        for (int jj = 0; jj < 4; ++jj) {
            const int i = mt * 16 + quad * 4 + jj;
            float tot = 0.f;
#pragma unroll
            for (int ww = 0; ww < 8; ++ww) tot += SSw[ww * 64 + i];
            const float rs = __builtin_amdgcn_rsqf(tot * (1.f / 256.f) + EPS);
#pragma unroll
            for (int n = 0; n < 2; ++n) {
                const int dv = (2 * w + n) * 16 + c16;
                const float gate = bf2f(gtv[mt][jj][n]);
                Gt[(row0 + i) * DM + 2048 + h * 256 + dv] = f2bf(o[mt][n][jj] * rs * (n ? gn1 : gn0) * silu(gate));
            }
        }
}

DI void s_swa_unit(unsigned char* lds, const bf16_t* H, bf16_t* Gt, const float* ck, const float* cv, const float* sinks, float* kout, float* vout, int u, int tid) {
    const int kvh = u & 3, b = u >> 2;
    float* Kl = (float*)lds;
    float* Vl = Kl + 128 * 65;
    float* Ql = Vl + 128 * 64;
    float* Pl = Ql + 512;
    const int lane = tid & 63, w = tid >> 6;
    const bf16_t* hrow = H + (size_t)(TP + b) * NP;
    __syncthreads();
    {
        float kr[16], vr[16];
#pragma unroll
        for (int i = 0; i < 16; ++i) {
            const int kk = w + 8 * i;
            if (kk < 127) { const size_t o = ((size_t)(b * 128 + kk + 1) * 4 + kvh) * 64 + lane; kr[i] = ck[o]; vr[i] = cv[o]; }
            else { const int p = 2 * (lane & 31) + (lane >> 5); kr[i] = bf2f(hrow[C_SK + kvh * 64 + p]); vr[i] = bf2f(hrow[C_SV + kvh * 64 + lane]); }
        }
#pragma unroll
        for (int i = 0; i < 16; ++i) {
            const int kk = w + 8 * i;
            if (kk < 127) { const size_t oo = ((size_t)(b * 128 + kk) * 4 + kvh) * 64 + lane; kout[oo] = kr[i]; vout[oo] = vr[i]; }
            Kl[kk * 65 + lane] = kr[i]; Vl[kk * 64 + lane] = vr[i];
        }
    }
    { const int p = 2 * (lane & 31) + (lane >> 5); Ql[w * 64 + lane] = bf2f(hrow[C_SQ + (kvh * 8 + w) * 64 + p]); }
    __syncthreads();
    float s0 = 0.f, s1 = 0.f;
    for (int d = 0; d < 64; ++d) { const float qd = Ql[w * 64 + d]; s0 += qd * Kl[lane * 65 + d]; s1 += qd * Kl[(lane + 64) * 65 + d]; }
    const float sink = sinks[kvh * 8 + w];
    const float mx = fmaxf(wave_max(fmaxf(s0, s1)), sink);
    const float p0 = __expf(s0 - mx), p1 = __expf(s1 - mx);
    const float inv = __builtin_amdgcn_rcpf(wave_sum(p0 + p1) + __expf(sink - mx));
    Pl[w * 128 + lane] = p0 * inv; Pl[w * 128 + lane + 64] = p1 * inv;
    __syncthreads();
    float o = 0.f;
    for (int kk = 0; kk < 128; ++kk) o += Pl[w * 128 + kk] * Vl[kk * 64 + lane];
    const float gate = bf2f(hrow[C_SG + (kvh * 8 + w) * 64 + lane]);
    Gt[(size_t)(TP + b) * DM + (kvh * 8 + w) * 64 + lane] = f2bf(o * silu(gate));
}
DI void s_gla_unit(unsigned char* lds, const bf16_t* H, bf16_t* Gt, const float* wg, const float* bg, const float* gng, const float* sin_, float* sout, int u, int tid) {
    const int h = u & 3, b = u >> 2;
    float* gE = (float*)lds; float* qv = gE + 128; float* kv = qv + 128; float* vv = kv + 128; float* Osum = vv + 256; float* red = Osum + 2048;
    const int lane = tid & 63, w = tid >> 6;
    const bf16_t* hrow = H + (size_t)(TP + b) * NP;
    __syncthreads();
    if (tid < 128) {
        float z = bg[h * 128 + tid];
#pragma unroll
        for (int r = 0; r < 16; ++r) z += bf2f(hrow[C_LR + r]) * wg[r * 512 + h * 128 + tid];
        gE[tid] = __expf(logsig16(z)); qv[tid] = bf2f(hrow[C_GQ + h * 128 + tid]); kv[tid] = bf2f(hrow[C_GK + h * 128 + tid]);
    }
    if (tid < 256) vv[tid] = bf2f(hrow[C_GV + h * 256 + tid]);
    __syncthreads();
    const float* S0 = sin_ + (size_t)(b * 4 + h) * 128 * 256;
    float* S1 = sout + (size_t)(b * 4 + h) * 128 * 256;
    const f32x4 v4 = *(const f32x4*)(vv + lane * 4);
    f32x4 oacc = {0.f, 0.f, 0.f, 0.f};
    f32x4 srow[16];
#pragma unroll
    for (int r = 0; r < 16; ++r) srow[r] = *(const f32x4*)(S0 + (16 * w + r) * 256 + lane * 4);
#pragma unroll
    for (int r = 0; r < 16; ++r) {
        const int dk = 16 * w + r;
        const f32x4 sv = srow[r] * gE[dk] + v4 * kv[dk];
        *(f32x4*)(S1 + dk * 256 + lane * 4) = sv;
        oacc += sv * qv[dk];
    }
    *(f32x4*)(Osum + w * 256 + lane * 4) = oacc;
    __syncthreads();
    float o = 0.f;
    if (tid < 256) {
#pragma unroll
        for (int ww = 0; ww < 8; ++ww) o += Osum[ww * 256 + tid];
        const float q = wave_sum(o * o);
        if (lane == 0) red[w] = q;
    }
    __syncthreads();
    if (tid < 256) {
        const float rs = __builtin_amdgcn_rsqf((red[0] + red[1] + red[2] + red[3]) * (1.f / 256.f) + EPS);
        const float gate = bf2f(hrow[C_GG + h * 256 + tid]);
        Gt[(size_t)(TP + b) * DM + 2048 + h * 256 + tid] = f2bf(o * rs * gng[h * 256 + tid] * silu(gate));
    }
}
DI void s_mem_unit(unsigned char* lds, const bf16_t* H, bf16_t* Gt, const float* mk, const float* mv, int u, int tid) {
    const int h = u & 3, b = u >> 2;
    float* Sc = (float*)lds; float* Osum = Sc + 256;
    const int lane = tid & 63, w = tid >> 6;
    const bf16_t* hrow = H + (size_t)(TP + b) * NP;
    __syncthreads();
    const u32x2 qw = *(const u32x2*)(hrow + C_MQ + h * 256 + lane * 4);
    const f32x4 q4 = {bflo(qw.x), bfhi(qw.x), bflo(qw.y), bfhi(qw.y)};
    const float* kbase = mk + ((size_t)(b * 256 + w * 32) * 4 + h) * 256 + lane * 4;
    const float* vbase = mv + ((size_t)(b * 256 + w * 32) * 4 + h) * 256 + lane * 4;
    float vals[32];
    {
        f32x4 kr[32];
#pragma unroll
        for (int r = 0; r < 32; ++r) kr[r] = *(const f32x4*)(kbase + (size_t)r * 1024);
#pragma unroll
        for (int r = 0; r < 32; ++r) vals[r] = (q4[0] * kr[r][0] + q4[1] * kr[r][1]) + (q4[2] * kr[r][2] + q4[3] * kr[r][3]);
    }
#pragma unroll
    for (int i = 0; i < 16; ++i) { const bool hi = lane & 32; const float send = hi ? vals[i] : vals[i + 16], keep = hi ? vals[i + 16] : vals[i]; vals[i] = keep + __shfl_xor(send, 32); }
#pragma unroll
    for (int i = 0; i < 8; ++i) { const bool hi = lane & 16; const float send = hi ? vals[i] : vals[i + 8], keep = hi ? vals[i + 8] : vals[i]; vals[i] = keep + __shfl_xor(send, 16); }
#pragma unroll
    for (int i = 0; i < 4; ++i) { const bool hi = lane & 8; const float send = hi ? vals[i] : vals[i + 4], keep = hi ? vals[i + 4] : vals[i]; vals[i] = keep + __shfl_xor(send, 8); }
#pragma unroll
    for (int i = 0; i < 2; ++i) { const bool hi = lane & 4; const float send = hi ? vals[i] : vals[i + 2], keep = hi ? vals[i + 2] : vals[i]; vals[i] = keep + __shfl_xor(send, 4); }
    { const bool hi = lane & 2; const float send = hi ? vals[0] : vals[1], keep = hi ? vals[1] : vals[0]; vals[0] = keep + __shfl_xor(send, 2); }
    vals[0] += __shfl_xor(vals[0], 1);
    if ((lane & 1) == 0) Sc[w * 32 + (lane >> 1)] = vals[0];
    f32x4 vr[32];
#pragma unroll
    for (int r = 0; r < 32; ++r) vr[r] = *(const f32x4*)(vbase + (size_t)r * 1024);
    __syncthreads();
    const f32x4 sv = *(const f32x4*)(Sc + lane * 4);
    const float mx = wave_max(fmaxf(fmaxf(sv[0], sv[1]), fmaxf(sv[2], sv[3])));
    const float inv = __builtin_amdgcn_rcpf(wave_sum((__expf(sv[0] - mx) + __expf(sv[1] - mx)) + (__expf(sv[2] - mx) + __expf(sv[3] - mx))));
    f32x4 oacc = {0.f, 0.f, 0.f, 0.f};
#pragma unroll
    for (int r = 0; r < 32; ++r) oacc += vr[r] * (__expf(Sc[w * 32 + r] - mx) * inv);
    *(f32x4*)(Osum + w * 256 + lane * 4) = oacc;
    __syncthreads();
    if (tid < 256) {
        float o = 0.f;
#pragma unroll
        for (int ww = 0; ww < 8; ++ww) o += Osum[ww * 256 + tid];
        const float gate = bf2f(hrow[C_MG + h * 256 + tid]);
        Gt[(size_t)(TP + b) * DM + 3072 + h * 256 + tid] = f2bf(o * silu(gate));
    }
}

#ifndef MK_ONE_LAUNCH
#define MK_ONE_LAUNCH 1
#endif
constexpr int N_PHASES = 12;
#ifndef PH_MASK
#define PH_MASK 0xFFFF
#endif
#define PHM(b) ((PH_MASK >> (b)) & 1)
#ifndef DUP_PH
#define DUP_PH 0
#endif
#ifndef DUP_SEL
#define DUP_SEL 0
#endif
#ifndef DUP_SYNC
#define DUP_SYNC 0
#endif
#ifndef DUP_P0
#define DUP_P0 0
#endif

__global__ void __launch_bounds__(512, 2) mk_fwd(Args a) {
    extern __shared__ __attribute__((aligned(16))) unsigned char lds[];
    const int G = gridDim.x, bid = blockIdx.x;
    unsigned char* ws = a.ws;
    bf16_t* XN = (bf16_t*)(ws + WS_XN);
    bf16_t* Hb = (bf16_t*)(ws + WS_H);
    bf16_t* Gt = (bf16_t*)(ws + WS_G);
    float* X1 = (float*)(ws + WS_X1);
    float* rope = (float*)(ws + WS_ROPE);
    float* RSq = (float*)(ws + WS_RS);
    const float* x_prompt = a.in[0]; const float* mem_prompt = a.in[1]; const float* x_sample = a.in[2];
    volatile LAS unsigned* bst = (volatile LAS unsigned*)((LAS unsigned char*)lds + (LDS_BYTES - 16));
    if (threadIdx.x < 4) bst[threadIdx.x] = 0u;
    __syncthreads();
    XcdBarrier xbar = xcd_barrier_post((unsigned*)(ws + WS_CTL), bst);
#define GRID_SYNC() xcd_barrier(xbar)

    if (a.ph_lo == 0) {
        int tidp = threadIdx.x; asm volatile("" : "+v"(tidp));
        const int tid = tidp, lane = tid & 63, wave = __builtin_amdgcn_readfirstlane(tid >> 6);
        for (int rep0 = 0; rep0 <= DUP_P0; ++rep0) if (PHM(0)) {
            float* scr = (float*)(lds + wave * 16640);
            const int gw = bid * 8 + wave, NGW = G * 8;
            constexpr int I_IN = 64 * 153, I_OUT = 64 * 64, I_MEM = 64 * 32, I_L = I_IN + I_OUT + I_MEM;
            auto mk_item = [&](int it) {
                TrItem t; const int l = it / I_L; int r = it - l * I_L;
                if (r < I_IN) { t.W = a.in[9] + (size_t)l * DM * NIN; t.WT = (bf16_t*)(ws + WS_WIN + l * SZ_WIN); t.N = NIN; t.item = r; t.inmap = 1; return t; }
                r -= I_IN;
                if (r < I_OUT) { t.W = a.in[16] + (size_t)l * DM * DM; t.WT = (bf16_t*)(ws + WS_WOUT + l * SZ_WOUT); t.N = DM; t.item = r; t.inmap = 0; return t; }
                r -= I_OUT;
                t.W = a.in[15] + (size_t)l * DM * 2048; t.WT = (bf16_t*)(ws + WS_WMEM + l * SZ_WMEM); t.N = 2048; t.item = r; t.inmap = 0; return t;
            };
            {
                int it = gw;
                f32x4 tv[16];
                TrItem cur = mk_item(it < 2 * I_L ? it : 0);
                if (it < 2 * I_L) tr_load(cur, tv, lane);
                while (it < 2 * I_L) {
                    const int nx = it + NGW;
                    f32x4 tn[16]; TrItem nxt = cur;
                    if (nx < 2 * I_L) { nxt = mk_item(nx); tr_load(nxt, tn, lane); }
                    tr_store(cur, tv, scr, lane);
#pragma unroll
                    for (int i = 0; i < 16; ++i) tv[i] = tn[i];
                    cur = nxt; it = nx;
                }
            }
            for (int i = bid * 512 + tid; i < 2 * 240 * 512; i += G * 512) {
                const int l = i / (240 * 512), r = i - l * 240 * 512;
                ((u32x4*)(ws + WS_WIN + l * SZ_WIN + (size_t)NIN * DM * 2))[r] = (u32x4){0u, 0u, 0u, 0u};
            }
            for (int i = bid * 512 + tid; i < 2049 * 32; i += G * 512) rope_entry(rope, i);
            for (int i = bid * 512 + tid; i < 2 * MR; i += G * 512) RSq[i] = 0.f;
            for (int m = gw; m < MREAL + 2048; m += NGW) {
                if (m < TP) norm_row(x_prompt + (size_t)m * DM, a.in[8], XN + (size_t)m * DM, nullptr, lane);
                else if (m < MREAL) norm_row(x_sample + (size_t)(m - TP) * DM, a.in[8], XN + (size_t)m * DM, nullptr, lane);
                else { const int mm = m - MREAL, l = mm >> 10, r = mm & 1023;
                       norm_row(mem_prompt + (size_t)r * DM, a.in[14] + l * DM, (bf16_t*)(ws + WS_MN + l * SZ_MN) + (size_t)r * DM, nullptr, lane); }
            }
        }
        if (a.ph_hi > 1) GRID_SYNC();
        if (a.ph_hi > 1000) cg::this_grid().sync();
    }
    for (int ph = a.ph_lo < 1 ? 1 : a.ph_lo, rep = 0; ph < a.ph_hi; ) {
        int tidp = threadIdx.x; asm volatile("" : "+v"(tidp));
        const int tid = tidp, lane = tid & 63, wave = __builtin_amdgcn_readfirstlane(tid >> 6);
        {
            const int l = (ph - 1) / 6, k = (ph - 1) % 6;
            if (k == 5 && l == 0) { ++ph; continue; }
            if (k == 0) {
                if (PHM(1)) {
                    pg8::Gemm g{XN, (const bf16_t*)(ws + WS_WIN + l * SZ_WIN), TP, NP, DM};
                    pg8::StaticOrder S; S.init(TP, NP, G, bid);
                    EpiIn E{Hb, rope, a.out + O_KP + (size_t)l * 131072, a.out + O_VP + (size_t)l * 131072, l == 0 ? nullptr : RSq};
                    pg8::gemm_phase<EpiIn, pg8::StaticOrder, true, true>((PG8_LAS unsigned char*)lds, g, S, E);
                }
                if (PHM(2)) {
                    pg8::Gemm g{(const bf16_t*)(ws + WS_MN + l * SZ_MN), (const bf16_t*)(ws + WS_WMEM + l * SZ_WMEM), 1024, 2048, DM};
                    const int nwg1 = (TP / 256) * (NP / 256);
                    pg8::StaticOrder S; S.init(1024, 2048, G, (bid + G - (nwg1 % G)) % G);
                    EpiMem E{(bf16_t*)(ws + WS_MKV + l * SZ_MKV), a.out + O_MKP + (size_t)l * 1048576, a.out + O_MVP + (size_t)l * 1048576};
                    pg8::gemm_phase<EpiMem, pg8::StaticOrder, true, true>((PG8_LAS unsigned char*)lds, g, S, E);
                }
            } else if (k >= 1 && k <= 3) {
                const float* sinks = a.in[10] + l * 32;
                const float* wg = a.in[11] + l * 16 * 512; const float* bg = a.in[12] + l * 512; const float* gng = a.in[13] + l * 1024;
                const bf16_t* MKV = (const bf16_t*)(ws + WS_MKV + l * SZ_MKV);
                u32x2* Ug = (u32x2*)(ws + WS_U); u32x4* SF = (u32x4*)(ws + WS_SF); unsigned char* IMG = ws + WS_IMG; float* EBLg = (float*)(ws + WS_EBL);
                unsigned* qctr = (unsigned*)(ws + WS_CTL) + 8192 + (ph * 2 + rep) * 64;
#define QUEUE_LOOP_BEGIN(NTOT) { int u = bid; while (u < (NTOT)) { unsigned nxt_ = 0u; if (threadIdx.x == 0) nxt_ = atomicAdd(qctr, 1u) + (unsigned)G;
#define QUEUE_LOOP_END() __syncthreads(); if (threadIdx.x == 0) bst[2] = nxt_; __syncthreads(); u = (int)bst[2]; } }
                if (k == 1) {
                    EpiInS ES{Hb, rope, a.out + O_KS + (size_t)l * 1048576, a.out + O_VS + (size_t)l * 1048576, l == 0 ? nullptr : RSq};
                    QUEUE_LOOP_BEGIN(256 + 512 + NP / 32)
                        int tid = tidp; asm volatile("" : "+v"(tid));
                        if (u < 256) { if (PHM(4)) mem_unit(lds, Hb, MKV, Gt, u, tid); }
                        else if (u < 768) { if (PHM(3)) gla_prep_unit(lds, Hb, wg, bg, Ug, EBLg, IMG, u - 256, tid); }
                        else skinny_task<EpiInS>(lds, XN + (size_t)TP * DM, (const bf16_t*)(ws + WS_WIN + l * SZ_WIN), u - 768, tid, ES);
                    QUEUE_LOOP_END()
                } else if (k == 2) {
                    const bool dsel = (DUP_SEL != 0 && rep == 1 && ph == DUP_PH);
                    if (PHM(3) && (!dsel || DUP_SEL == 5)) { for (int tt = bid * 8 + wave; tt < 2048; tt += G * 8) gla_scan_task(Ug, EBLg, (u32x2*)SF, a.out + O_SP + (size_t)l * 524288, tt, lane); }
                    QUEUE_LOOP_BEGIN(256 + 384)
                        int tid = tidp; asm volatile("" : "+v"(tid));
                        const int utype = u < 256 ? 1 : (u < 384 ? 2 : (u < 512 ? 3 : 4));
                        if (dsel && utype != DUP_SEL) {}
                        else if (u < 256) { if (PHM(5)) swa_unit(lds, Hb, Gt, sinks, u, tid); }
                        else if (!PHM(6)) {}
                        else if (u < 384) s_mem_unit(lds, Hb, Gt, a.in[6] + (size_t)l * 8388608, a.in[7] + (size_t)l * 8388608, u - 256, tid);
                        else if (u < 512) s_gla_unit(lds, Hb, Gt, wg, bg, gng, a.in[5] + (size_t)l * 4194304, a.out + O_SS + (size_t)l * 4194304, u - 384, tid);
                        else s_swa_unit(lds, Hb, Gt, a.in[3] + (size_t)l * 1048576, a.in[4] + (size_t)l * 1048576, sinks, a.out + O_KS + (size_t)l * 1048576, a.out + O_VS + (size_t)l * 1048576, u - 512, tid);
                    QUEUE_LOOP_END()
                } else {
                    EpiResS ES{l == 0 ? x_sample : X1 + (size_t)TP * DM, (l == 0 ? X1 : a.out) + (size_t)TP * DM, l == 0 ? a.in[8] + DM : a.in[17], XN, RSq + l * MR, l};
                    QUEUE_LOOP_BEGIN(512 + DM / 32)
                        int tid = tidp; asm volatile("" : "+v"(tid));
                        if (u < 512) { if (PHM(3)) gla_out_unit(lds, Hb, Gt, gng, SF, IMG, u, tid); }
                        else skinny_task<EpiResS>(lds, Gt + (size_t)TP * DM, (const bf16_t*)(ws + WS_WOUT + l * SZ_WOUT), u - 512, tid, ES);
                    QUEUE_LOOP_END()
                }
                __syncthreads();
            } else if (k == 4) { if (PHM(7)) {
                pg8::Gemm g{Gt, (const bf16_t*)(ws + WS_WOUT + l * SZ_WOUT), TP, DM, DM};
                PanelOrder S; S.init(G, bid);
                if (l == 0) {
                    EpiRes E{x_prompt, nullptr, a.in[8] + DM, XN, RSq, 0};
                    pg8::gemm_phase<EpiRes, PanelOrder, true, true>((PG8_LAS unsigned char*)lds, g, S, E);
                } else {
                    if (bid < TS) {
                        const int row = TP + bid;
                        const float rs = __builtin_amdgcn_rsqf(RSq[MR + row] * (1.f / DM) + EPS);
                        f32x4* yr = (f32x4*)(a.out + (size_t)row * DM);
                        const f32x4 y0 = yr[tid], y1 = yr[tid + 512];
                        yr[tid] = y0 * rs; yr[tid + 512] = y1 * rs;
                    }
                    EpiFin E{XN, a.in[8] + DM, a.out, a.in[17], RSq + MR, (unsigned*)(ws + WS_CTL) + 4096};
                    pg8::gemm_phase<EpiFin, PanelOrder, true, true>((PG8_LAS unsigned char*)lds, g, S, E);
                }
            } } else if (PHM(8)) {
                const int gw = bid * 8 + wave, NGW = G * 8;
                for (int m = gw; m < MREAL; m += NGW) {
                    if (l == 0) norm_row(X1 + (size_t)m * DM, a.in[8] + DM, XN + (size_t)m * DM, nullptr, lane);
                    else {
                        const float rs = __builtin_amdgcn_rsqf(RSq[MR + m] * (1.f / DM) + EPS);
                        f32x4* yr = (f32x4*)(a.out + (size_t)m * DM) + lane;
                        f32x4 yv[16];
#pragma unroll
                        for (int j = 0; j < 16; ++j) yv[j] = yr[64 * j];
#pragma unroll
                        for (int j = 0; j < 16; ++j) yr[64 * j] = yv[j] * rs;
                    }
                }
            }
        }
        if (ph + 1 < a.ph_hi) { GRID_SYNC(); if (DUP_SYNC) { GRID_SYNC(); } }
        if (DUP_PH != 0 && ph == DUP_PH && rep == 0) rep = 1; else ++ph;
    }
}

extern "C" void kernel_launch(void* const* d_in, const int* in_sizes, int n_in, void* d_out, int out_size, void* d_ws, size_t ws_size, hipStream_t stream) {
    static int grid = 0;
    if (grid == 0) {
        if (n_in != 18 || (size_t)out_size != O_END || ws_size < WS_END) { fprintf(stderr, "kernel_launch: unexpected shapes (n_in %d, out %d, ws %zu); nothing launched\n", n_in, out_size, ws_size); grid = -1; return; }
        int dev = 0, cus = 0, per_cu = 0;
        if (hipGetDevice(&dev) != hipSuccess || hipDeviceGetAttribute(&cus, hipDeviceAttributeMultiprocessorCount, dev) != hipSuccess) { grid = -1; return; }
        if (hipFuncSetAttribute((const void*)mk_fwd, hipFuncAttributeMaxDynamicSharedMemorySize, LDS_BYTES) != hipSuccess) { fprintf(stderr, "kernel_launch: hipFuncSetAttribute failed\n"); grid = -1; return; }
        if (hipOccupancyMaxActiveBlocksPerMultiprocessor(&per_cu, (const void*)mk_fwd, 512, LDS_BYTES) != hipSuccess || per_cu < 1) { fprintf(stderr, "kernel_launch: occupancy query says %d\n", per_cu); per_cu = 1; }
        (void)hipGetLastError();
        grid = cus * per_cu;
    }
    if (grid < 0) return;
    if (hipMemsetAsync((char*)d_ws + WS_CTL, 0, CTL_BYTES, stream) != hipSuccess) { fprintf(stderr, "kernel_launch: memset failed\n"); return; }
    Args a{};
    for (int i = 0; i < 18; ++i) a.in[i] = (const float*)d_in[i];
    a.out = (float*)d_out; a.ws = (unsigned char*)d_ws;
#if MK_ONE_LAUNCH
    a.ph_lo = 0; a.ph_hi = N_PHASES;
    void* args[] = {&a};
    hipError_t e = hipLaunchCooperativeKernel((const void*)mk_fwd, dim3(grid), dim3(512), args, LDS_BYTES, stream);
    if (e != hipSuccess) fprintf(stderr, "kernel_launch: cooperative launch failed: %s (grid %d)\n", hipGetErrorString(e), grid);
#else
    for (int ph = 0; ph < N_PHASES; ++ph) {
        a.ph_lo = ph; a.ph_hi = ph + 1;
        hipLaunchKernelGGL(mk_fwd, dim3(grid), dim3(512), LDS_BYTES, stream, a);
    }
#endif
}
```

```cpp
#include <hip/hip_runtime.h>
#include <hip/hip_cooperative_groups.h>
#include <cstdio>
#include <cstdint>
namespace cg = cooperative_groups;
#define MK_ONE_LAUNCH 1
namespace pg8 {
#define PG8_LAS __attribute__((address_space(3)))
typedef unsigned short bf16_t;
typedef short bf16x8 __attribute__((ext_vector_type(8)));
typedef float f32x4 __attribute__((ext_vector_type(4)));
typedef unsigned u32x4 __attribute__((ext_vector_type(4)));
constexpr int BM = 256, BK = 64, HALF = 128, HTB = HALF * BK * 2  , STAGE_BYTES = 8 * HTB, NXCD = 8, WGM = 8;

__host__ __device__ __forceinline__ int lds_byte(int r, int c) { const int st = (r >> 4) * 2 + (c >> 5), rr = r & 15, cc = c & 31, ob = rr * 64 + cc * 2; return st * 1024 + (ob ^ (((ob >> 9) & 1) << 5)); }
__host__ __device__ __forceinline__ void stage_rc(int b, int& R, int& C) { const int st = b / 1024, sb = b % 1024, swz = sb ^ (((sb >> 9) & 1) << 5); R = (st >> 1) * 16 + swz / 64; C = (st & 1) * 32 + (swz % 64) / 2; }
__host__ __device__ __forceinline__ int perm32(int rho) { const int n = rho >> 4, i = rho & 15; return 8 * (i >> 2) + 4 * n + (i & 3); }

struct Unit { int pm, pn, sel; };
struct Gemm { const bf16_t* A; const bf16_t* Bt; int M, N, K; const bf16_t* A2; const bf16_t* Bt2; };

struct StaticOrder {
    int nM, nN, nwg, G, c;
    __host__ __device__ void init(int M, int N, int G_, int c_) { nM = M / BM; nN = N / BM; nwg = nM * nN; G = G_; c = c_; }
    __host__ __device__ bool next(int i, Unit& u) const {
        const long L = (long)i * G + c; if (L >= nwg) return false;
        int wgid = (int)L; { const int q = nwg / NXCD, r = nwg % NXCD, xcd = wgid % NXCD, off = wgid / NXCD; wgid = (xcd < r ? xcd * (q + 1) : r * (q + 1) + (xcd - r) * q) + off; }
        const int nig = WGM * nN, gid = wgid / nig, fm = gid * WGM, gsz = (nM - fm) < WGM ? (nM - fm) : WGM;
        u.pm = fm + ((wgid % nig) % gsz); u.pn = (wgid % nig) / gsz; u.sel = 0; return true;
    }
    __device__ __forceinline__ void a_ready(const Unit&) const {}
    __device__ __forceinline__ void done(const Unit&) const {}
};

__device__ __forceinline__ unsigned cvt_pk_bf16(float lo, float hi) { unsigned r; asm volatile("v_cvt_pk_bf16_f32 %0, %1, %2" : "=v"(r) : "v"(lo), "v"(hi)); return r; }
typedef float f32x2 __attribute__((ext_vector_type(2)));
template <class Epi, class Sched, bool ALIGN_EPI = false, bool SP2 = false>
__device__ __forceinline__ void gemm_phase(PG8_LAS unsigned char* lds, const Gemm g, const Sched& S, const Epi& E) {
    int tid_ = threadIdx.x; asm volatile("" : "+v"(tid_));
    const int tid = tid_, wid = __builtin_amdgcn_readfirstlane(tid >> 6), lane = tid & 63, wr = wid >> 2, wc = wid & 3, fr = lane & 15, fq = lane >> 4;
    const int K = g.K, nt = K / BK;
    unsigned voffA[2], voffB[2];
#pragma unroll
    for (int i = 0; i < 2; ++i) { int R, C; stage_rc(tid * 16 + i * 8192, R, C); const int Rb = Epi::PERM ? ((R & ~31) + perm32(R & 31)) : R;
        voffA[i] = (unsigned)(R * K + C) * 2u; voffB[i] = (unsigned)(Rb * K + C) * 2u; }
    const size_t kstep = (size_t)(BK * 2);
    const size_t hstep = (size_t)HALF * K * 2;
    const size_t tstep = 2 * hstep;
    const unsigned ldsw = (unsigned)wid * 1024u;
    const int aoff = lds_byte(wr * 64 + fr, fq * 8), boff = lds_byte(wc * 32 + fr, fq * 8);
#define PG8_SA(b, h) (((b) * 2 + (h)) * HTB)
#define PG8_SB(b, h) ((4 + (b) * 2 + (h)) * HTB)
#define PG8_STAGE(bufoff, gbase, voff) do { _Pragma("unroll") for (int _i = 0; _i < 2; ++_i) \
        __builtin_amdgcn_global_load_lds((const unsigned*)((const char*)(gbase) + (voff)[_i]), (PG8_LAS unsigned*)(lds + (bufoff) + ldsw + _i * 8192), 16, 0, 0); } while (0)
#define PG8_LDA(dst, b, h) do { _Pragma("unroll") for (int m = 0; m < 4; ++m) _Pragma("unroll") for (int k = 0; k < 2; ++k) dst[m][k] = *(const PG8_LAS bf16x8*)(lds + PG8_SA(b, h) + aoff + m * 2048 + k * 1024); } while (0)
#define PG8_LDB(dst, b, h) do { _Pragma("unroll") for (int n = 0; n < 2; ++n) _Pragma("unroll") for (int k = 0; k < 2; ++k) dst[n][k] = *(const PG8_LAS bf16x8*)(lds + PG8_SB(b, h) + boff + n * 2048 + k * 1024); } while (0)
#define PG8_MMA(ai, bj, At, Bt) do { __builtin_amdgcn_s_setprio(1); _Pragma("unroll") for (int m = 0; m < 4; ++m) _Pragma("unroll") for (int n = 0; n < 2; ++n) _Pragma("unroll") for (int k = 0; k < 2; ++k) \
        acc[ai][bj][m][n] = __builtin_amdgcn_mfma_f32_16x16x32_bf16(Bt[n][k], At[m][k], acc[ai][bj][m][n], 0, 0, 0); __builtin_amdgcn_s_setprio(0); } while (0)
#define PG8_WAIT_V(n) asm volatile("s_waitcnt vmcnt(" #n ")" ::: "memory")
#define PG8_WAIT_L(n) asm volatile("s_waitcnt lgkmcnt(" #n ")" ::: "memory")
#define PG8_BAR __builtin_amdgcn_s_barrier()
#define PG8_SCHED __builtin_amdgcn_sched_barrier(0)
    Unit cur, nxt; int ui = 0;
    if (!S.next(0, cur)) return;
    f32x4 acc[2][2][4][2];
#pragma unroll
    for (int a = 0; a < 2; ++a)
#pragma unroll
        for (int b = 0; b < 2; ++b)
#pragma unroll
            for (int m = 0; m < 4; ++m)
#pragma unroll
                for (int n = 0; n < 2; ++n) acc[a][b][m][n] = (f32x4){0.f, 0.f, 0.f, 0.f};
    bf16x8 At[4][2], B0[2][2], B1[2][2];
    const char* cA = (const char*)(cur.sel ? g.A2 : g.A) + (size_t)cur.pm * tstep; const char* cB = (const char*)(cur.sel ? g.Bt2 : g.Bt) + (size_t)cur.pn * tstep;
    S.a_ready(cur);
    if constexpr (SP2) {
        PG8_STAGE(PG8_SB(0, 0), cB, voffB); PG8_STAGE(PG8_SB(0, 1), cB + hstep, voffB); PG8_STAGE(PG8_SA(0, 0), cA, voffA); PG8_STAGE(PG8_SA(0, 1), cA + hstep, voffA);
        if (wr == 1) PG8_BAR;
        PG8_WAIT_V(2); PG8_BAR;
        PG8_STAGE(PG8_SB(1, 0), cB + kstep, voffB); PG8_STAGE(PG8_SA(1, 0), cA + kstep, voffA); PG8_STAGE(PG8_SB(1, 1), cB + hstep + kstep, voffB);
        PG8_WAIT_V(6); PG8_BAR;
    } else {
        PG8_STAGE(PG8_SB(0, 0), cB, voffB); PG8_STAGE(PG8_SA(0, 0), cA, voffA); PG8_STAGE(PG8_SB(0, 1), cB + hstep, voffB); PG8_STAGE(PG8_SA(0, 1), cA + hstep, voffA);
        if (wr == 1) PG8_BAR;
        PG8_WAIT_V(4); PG8_BAR;
        PG8_STAGE(PG8_SB(1, 0), cB + kstep, voffB); PG8_STAGE(PG8_SA(1, 0), cA + kstep, voffA); PG8_STAGE(PG8_SB(1, 1), cB + hstep + kstep, voffB);
        PG8_WAIT_V(6); PG8_BAR;
    }
    for (;;) {
        const bool has_next = S.next(ui + 1, nxt);
        const char* nA = has_next ? (const char*)(nxt.sel ? g.A2 : g.A) + (size_t)nxt.pm * tstep : cA; const char* nB = has_next ? (const char*)(nxt.sel ? g.Bt2 : g.Bt) + (size_t)nxt.pn * tstep : cB;
        for (int t = 0; t < nt; t += 2) {
            const bool last = (t == nt - 2);
            const char* a1 = cA + (size_t)(t + 1) * kstep;
            const char* a2 = last ? nA : cA + (size_t)(t + 2) * kstep; const char* b2 = last ? nB : cB + (size_t)(t + 2) * kstep;
            const char* a3 = a2 + kstep; const char* b3 = b2 + kstep;
            if (last && has_next) S.a_ready(nxt);
            if constexpr (SP2) {
            PG8_LDB(B0, 0, 0); PG8_LDB(B1, 0, 1); PG8_SCHED; PG8_LDA(At, 0, 0); PG8_STAGE(PG8_SA(1, 1), a1 + hstep, voffA);
            PG8_WAIT_V(8); PG8_WAIT_L(0); PG8_BAR; PG8_MMA(0, 0, At, B0); PG8_MMA(0, 1, At, B1); PG8_BAR; PG8_SCHED;
            PG8_LDA(At, 0, 1); PG8_STAGE(PG8_SB(0, 0), b2, voffB); PG8_STAGE(PG8_SB(0, 1), b2 + hstep, voffB); PG8_STAGE(PG8_SA(0, 0), a2, voffA);
            PG8_WAIT_V(8); PG8_WAIT_L(0); PG8_BAR; PG8_MMA(1, 0, At, B0); PG8_MMA(1, 1, At, B1); PG8_BAR; PG8_SCHED;
            PG8_LDB(B0, 1, 0); PG8_LDB(B1, 1, 1); PG8_SCHED; PG8_LDA(At, 1, 0); PG8_STAGE(PG8_SA(0, 1), a2 + hstep, voffA);
            PG8_WAIT_V(8); PG8_WAIT_L(0); PG8_BAR; PG8_MMA(0, 0, At, B0); PG8_MMA(0, 1, At, B1); PG8_BAR; PG8_SCHED;
            PG8_LDA(At, 1, 1); PG8_STAGE(PG8_SB(1, 0), b3, voffB); PG8_STAGE(PG8_SB(1, 1), b3 + hstep, voffB); PG8_STAGE(PG8_SA(1, 0), a3, voffA);
            PG8_WAIT_V(8); PG8_WAIT_L(0); PG8_BAR; PG8_MMA(1, 0, At, B0); PG8_MMA(1, 1, At, B1); PG8_BAR; PG8_SCHED;
            } else {
            PG8_LDB(B0, 0, 0); PG8_SCHED; PG8_LDA(At, 0, 0); PG8_STAGE(PG8_SA(1, 1), a1 + hstep, voffA);
            PG8_WAIT_L(8); PG8_BAR; PG8_WAIT_L(0); PG8_MMA(0, 0, At, B0); PG8_BAR; PG8_SCHED;
            PG8_LDB(B1, 0, 1); PG8_STAGE(PG8_SB(0, 0), b2, voffB);
            PG8_BAR; PG8_WAIT_L(0); PG8_MMA(0, 1, At, B1); PG8_BAR;
            PG8_LDA(At, 0, 1); PG8_STAGE(PG8_SA(0, 0), a2, voffA);
            PG8_BAR; PG8_WAIT_L(0); PG8_MMA(1, 0, At, B0); PG8_BAR; PG8_SCHED;
            PG8_STAGE(PG8_SB(0, 1), b2 + hstep, voffB);
            PG8_WAIT_V(6); PG8_BAR; PG8_MMA(1, 1, At, B1); PG8_BAR;
            PG8_LDB(B0, 1, 0); PG8_SCHED; PG8_LDA(At, 1, 0); PG8_STAGE(PG8_SA(0, 1), a2 + hstep, voffA);
            PG8_WAIT_L(8); PG8_BAR; PG8_WAIT_L(0); PG8_MMA(0, 0, At, B0); PG8_BAR; PG8_SCHED;
            PG8_LDB(B1, 1, 1); PG8_STAGE(PG8_SB(1, 0), b3, voffB);
            PG8_BAR; PG8_WAIT_L(0); PG8_MMA(0, 1, At, B1); PG8_BAR;
            PG8_LDA(At, 1, 1); PG8_STAGE(PG8_SA(1, 0), a3, voffA);
            PG8_BAR; PG8_WAIT_L(0); PG8_MMA(1, 0, At, B0); PG8_BAR; PG8_SCHED;
            PG8_STAGE(PG8_SB(1, 1), b3 + hstep, voffB);
            PG8_WAIT_V(6); PG8_BAR; PG8_MMA(1, 1, At, B1); PG8_BAR;
            }
        }
        if constexpr (ALIGN_EPI) { if (wr == 0) PG8_BAR; }
        if constexpr (!Epi::AFTER_DRAIN) { E(acc, cur, wr, wc, fr, fq); S.done(cur); }
        if (!has_next) break;
#pragma unroll
        for (int a = 0; a < 2; ++a)
#pragma unroll
            for (int b = 0; b < 2; ++b)
#pragma unroll
                for (int m = 0; m < 4; ++m)
#pragma unroll
                    for (int n = 0; n < 2; ++n) acc[a][b][m][n] = (f32x4){0.f, 0.f, 0.f, 0.f};
        cur = nxt; cA = nA; cB = nB; ++ui;
        if constexpr (ALIGN_EPI) { if (wr == 1) PG8_BAR; }
    }
    PG8_WAIT_V(0);
    if constexpr (!ALIGN_EPI) { if (wr == 0) PG8_BAR; }
    PG8_BAR;
    if constexpr (Epi::AFTER_DRAIN) { E.fused(acc, cur, wr, wc, fr, fq, lds, wid, lane); S.done(cur); }
#undef PG8_SA
#undef PG8_SB
#undef PG8_STAGE
#undef PG8_LDA
#undef PG8_LDB
#undef PG8_MMA
#undef PG8_WAIT_V
#undef PG8_WAIT_L
#undef PG8_BAR
#undef PG8_SCHED
}
}
#define LAS __attribute__((address_space(3)))
#define XB_TMO      128
#define XB_XCNT(j)  (256  + 64 * (j))
#define XB_XSUB(j)  (1280 + 64 * (j))
#define XB_XGEN(j)  (2304 + 64 * (j))
#define XB_TOP      3328
#define XB_TOPGEN   3392
#define XCD_BAR_WORDS 3456
#define XB_SPIN_CAP (1u << 18)

__device__ __forceinline__ unsigned xb_ld(unsigned* p)              { return __hip_atomic_load(p, __ATOMIC_RELAXED, __HIP_MEMORY_SCOPE_AGENT); }
__device__ __forceinline__ unsigned xb_add(unsigned* p, unsigned v) { return __hip_atomic_fetch_add(p, v, __ATOMIC_RELAXED, __HIP_MEMORY_SCOPE_AGENT); }
__device__ __forceinline__ unsigned xb_xcc_id() { return (unsigned)__builtin_amdgcn_s_getreg((3 << 11) | 20) & 0xFu; }
#define XB_SPIN(cond, bar) do { unsigned _sp = 0; while (cond) { __builtin_amdgcn_s_sleep(1); \
    if ((++_sp & 255u) == 0u) { if (xb_ld(&(bar)[XB_TMO])) break; if (_sp > XB_SPIN_CAP) { atomicAdd(&(bar)[XB_TMO], 1u); break; } } } } while (0)

struct XcdBarrier {
    unsigned* bar; unsigned x;
    volatile LAS unsigned* st;
};

__device__ __forceinline__ XcdBarrier xcd_barrier_post(unsigned* bar, volatile LAS unsigned* st) {
    XcdBarrier b; b.bar = bar; b.x = xb_xcc_id(); b.st = st;
    if (threadIdx.x == 0) (void)xb_add(&bar[XB_XCNT(b.x)], 1u);
    return b;
}
__device__ __forceinline__ void xcd_barrier_complete(unsigned* bar, unsigned x, unsigned& nloc, unsigned& nx) {
    const unsigned G = gridDim.x * gridDim.y * gridDim.z;
    unsigned sum, cnt, mine, sp = 0u;
    for (;;) {
        sum = 0u; cnt = 0u; mine = 0u;
#pragma unroll
        for (unsigned j = 0; j < 16; ++j) { const unsigned c = xb_ld(&bar[XB_XCNT(j)]); sum += c; cnt += (c > 0u) ? 1u : 0u; mine = (j == x) ? c : mine; }
        if (sum == G) break;
        __builtin_amdgcn_s_sleep(1);
        if ((++sp & 255u) == 0u) { if (xb_ld(&bar[XB_TMO])) break; if (sp > XB_SPIN_CAP) { atomicAdd(&bar[XB_TMO], 1u); break; } }
    }
    nloc = mine > 0u ? mine : 1u; nx = cnt > 0u ? cnt : 1u;
}

__device__ __forceinline__ void xcd_barrier(const XcdBarrier& b) {
    asm volatile("s_waitcnt vmcnt(0)" ::: "memory");
    __syncthreads();
    if (threadIdx.x == 0) {
        unsigned* bar = b.bar;
        __builtin_amdgcn_s_waitcnt(0);
        unsigned nloc = b.st[0], nx = b.st[1];
        if (nloc == 0u) { xcd_barrier_complete(bar, b.x, nloc, nx); b.st[0] = nloc; b.st[1] = nx; }
        const unsigned old = xb_add(&bar[XB_XSUB(b.x)], 1u);
        const unsigned gen = old / nloc;
        if (old + 1u == (gen + 1u) * nloc) {
            __builtin_amdgcn_fence(__ATOMIC_RELEASE, "agent");
            asm volatile("s_waitcnt vmcnt(0)" ::: "memory");
            const unsigned og = xb_add(&bar[XB_TOP], 1u);
            const unsigned tg = og / nx;
            if (og + 1u == (tg + 1u) * nx) xb_add(&bar[XB_TOPGEN], 1u);
            else XB_SPIN(xb_ld(&bar[XB_TOPGEN]) == tg, bar);
            __builtin_amdgcn_fence(__ATOMIC_ACQUIRE, "agent");
            xb_add(&bar[XB_XGEN(b.x)], 1u);
            asm volatile("s_waitcnt vmcnt(0)" ::: "memory");
        } else {
            XB_SPIN(xb_ld(&bar[XB_XGEN(b.x)]) == gen, bar);
            __builtin_amdgcn_fence(__ATOMIC_ACQUIRE, "agent");
            asm volatile("s_waitcnt vmcnt(0)" ::: "memory");
        }
    }
    __syncthreads();
}

#define DI __device__ __forceinline__
typedef unsigned short bf16_t;
typedef short bf16x8 __attribute__((ext_vector_type(8)));
typedef short s16x4 __attribute__((ext_vector_type(4)));
typedef float f32x4 __attribute__((ext_vector_type(4)));
typedef unsigned u32x4 __attribute__((ext_vector_type(4)));
typedef unsigned u32x2 __attribute__((ext_vector_type(2)));
typedef float f32x2_t __attribute__((ext_vector_type(2)));
typedef __bf16 bf16x2_t __attribute__((ext_vector_type(2)));

constexpr int DM = 4096, TP = 8192, SEQ = 2048, NBATCH = 4, TS = 32, MR = 8448, MREAL = 8224, NP = 9984, NIN = 9744;
constexpr int C_SQ = 0, C_SK = 2048, C_SV = 2304, C_SG = 2560, C_GQ = 4608, C_GK = 5120, C_GV = 5632, C_GG = 6656, C_MQ = 7680, C_MG = 8704, C_LR = 9728;
constexpr float EPS = 1e-6f;
constexpr size_t O_YP = 0, O_YS = 33554432, O_KP = 33685504, O_VP = 33947648, O_SP = 34209792, O_MKP = 35258368, O_MVP = 37355520, O_KS = 39452672, O_VS = 41549824, O_SS = 43646976, O_END = 52035584;
constexpr size_t MiB = 1u << 20;
constexpr size_t WS_WIN = 0;
constexpr size_t SZ_WIN = (size_t)NP * DM * 2;
constexpr size_t WS_WOUT = 160 * MiB;
constexpr size_t SZ_WOUT = (size_t)DM * DM * 2;
constexpr size_t WS_WMEM = 224 * MiB;
constexpr size_t SZ_WMEM = (size_t)2048 * DM * 2;
constexpr size_t WS_XN = 256 * MiB;
constexpr size_t WS_MN = 324 * MiB;
constexpr size_t SZ_MN = (size_t)1024 * DM * 2;
constexpr size_t WS_H = 340 * MiB;
constexpr size_t WS_MKV = 502 * MiB;
constexpr size_t SZ_MKV = (size_t)1024 * 2048 * 2;
constexpr size_t WS_G = 510 * MiB;
constexpr size_t WS_X1 = 576 * MiB;
constexpr size_t WS_ROPE = 708 * MiB;
constexpr size_t WS_U = 710 * MiB;
constexpr size_t WS_SF = 774 * MiB;
constexpr size_t WS_IMG = 806 * MiB;
constexpr size_t WS_EBL = 838 * MiB;
constexpr size_t WS_RS = 838 * MiB + 524288;
constexpr size_t WS_CTL = 839 * MiB;
constexpr size_t CTL_BYTES = 65536;
constexpr size_t WS_END = 840 * MiB;
static_assert(WS_WIN + 2 * SZ_WIN <= WS_WOUT && WS_XN + (size_t)MR * DM * 2 <= WS_MN && WS_H + (size_t)MR * NP * 2 <= WS_MKV && WS_G + (size_t)MR * DM * 2 <= WS_X1 && WS_X1 + (size_t)MR * DM * 4 <= WS_ROPE, "ws map");

constexpr int LDS_BYTES = 147456;

DI float bf2f(unsigned short u) { return __uint_as_float((unsigned)u << 16); }
DI float bflo(unsigned w) { return __uint_as_float(w << 16); }
DI float bfhi(unsigned w) { return __uint_as_float(w & 0xffff0000u); }
DI unsigned pk2(float lo, float hi) { f32x2_t v = {lo, hi}; bf16x2_t b = __builtin_convertvector(v, bf16x2_t); return __builtin_bit_cast(unsigned, b); }
DI unsigned short f2bf(float f) { return (unsigned short)(pk2(f, 0.f) & 0xffffu); }
DI float silu(float x) { return x * __builtin_amdgcn_rcpf(1.f + __expf(-x)); }
DI float wave_sum(float v) {
#pragma unroll
    for (int o = 1; o < 64; o <<= 1) v += __shfl_xor(v, o);
    return v;
}
DI float wave_max(float v) {
#pragma unroll
    for (int o = 1; o < 64; o <<= 1) v = fmaxf(v, __shfl_xor(v, o));
    return v;
}
DI f32x4 mfma16(bf16x8 a, bf16x8 b, f32x4 c) { return __builtin_amdgcn_mfma_f32_16x16x32_bf16(a, b, c, 0, 0, 0); }
DI bf16x8 pack8(f32x4 a, f32x4 b) { u32x4 p; p.x = pk2(a[0], a[1]); p.y = pk2(a[2], a[3]); p.z = pk2(b[0], b[1]); p.w = pk2(b[2], b[3]); return __builtin_bit_cast(bf16x8, p); }
DI bf16x8 cat4(s16x4 lo, s16x4 hi) { return __builtin_shufflevector(lo, hi, 0, 1, 2, 3, 4, 5, 6, 7); }

struct Args {
    const float* in[18]; float* out; unsigned char* ws; int ph_lo, ph_hi;
};

struct EpiIn {
    static constexpr bool PERM = true, AFTER_DRAIN = false;
    bf16_t* H; const float* rope; float* kp; float* vp; const float* RSin;
    DI void operator()(const f32x4 (&acc)[2][2][4][2], const pg8::Unit& u, int wr, int wc, int fr, int fq) const {
        const int pn = u.pn;
        const bool do_rope = pn < 9;
        float sc = 1.f;
        if (pn < 8) sc = 0.125f; else if (pn == 18 || pn == 19) sc = 0.08838834764831845f; else if (pn >= 30 && pn < 34) sc = 0.0625f;
        const int row0 = u.pm * 256 + wr * 64 + fr;
        const int colt = wc * 32 + 8 * fq;
#pragma unroll
        for (int ai = 0; ai < 2; ++ai) {
            f32x4 tr[4][2];
#pragma unroll
            for (int m = 0; m < 4; ++m) {
                tr[m][0] = (f32x4){1.f, 0.f, 1.f, 0.f}; tr[m][1] = (f32x4){1.f, 0.f, 1.f, 0.f};
                if (do_rope) {
                    const f32x4* rp = (const f32x4*)(rope + ((size_t)((row0 + ai * 128 + m * 16) & (SEQ - 1)) * 32 + 16 * (wc & 1) + 4 * fq) * 2);
                    tr[m][0] = rp[0]; tr[m][1] = rp[1];
                }
            }
            float rsv[4];
#pragma unroll
            for (int m = 0; m < 4; ++m) { rsv[m] = sc; if (RSin) rsv[m] = sc * __builtin_amdgcn_rsqf(RSin[row0 + ai * 128 + m * 16] * (1.f / DM) + EPS); }
#pragma unroll
            for (int m = 0; m < 4; ++m) {
                const int row = row0 + ai * 128 + m * 16;
                const f32x4 t0 = tr[m][0], t1 = tr[m][1];
#pragma unroll
                for (int bj = 0; bj < 2; ++bj) {
                    f32x4 v0 = acc[ai][bj][m][0], v1 = acc[ai][bj][m][1];
                    if (do_rope) {
                        float a, b;
                        a = v0[0]; b = v0[1]; v0[0] = a * t0[0] - b * t0[1]; v0[1] = b * t0[0] + a * t0[1];
                        a = v0[2]; b = v0[3]; v0[2] = a * t0[2] - b * t0[3]; v0[3] = b * t0[2] + a * t0[3];
                        a = v1[0]; b = v1[1]; v1[0] = a * t1[0] - b * t1[1]; v1[1] = b * t1[0] + a * t1[1];
                        a = v1[2]; b = v1[3]; v1[2] = a * t1[2] - b * t1[3]; v1[3] = b * t1[2] + a * t1[3];
                    }
                    v0 = v0 * rsv[m]; v1 = v1 * rsv[m];
                    u32x4 w4; w4.x = pk2(v0[0], v0[1]); w4.y = pk2(v0[2], v0[3]); w4.z = pk2(v1[0], v1[1]); w4.w = pk2(v1[2], v1[3]);
                    *(u32x4*)(H + (size_t)row * NP + pn * 256 + bj * 128 + colt) = w4;
                    if (pn == 8 || pn == 9) {
                        const int t = row & (SEQ - 1);
                        if (t >= SEQ - 128) {
                            const int kvh = bj * 2 + (wc >> 1);
                            float* dst = (pn == 8 ? kp : vp) + ((size_t)((row >> 11) * 128 + (t - (SEQ - 128))) * 4 + kvh) * 64;
                            if (pn == 8) {
                                const int d0 = 16 * (wc & 1) + 4 * fq;
                                *(f32x4*)(dst + d0) = (f32x4){v0[0], v0[2], v1[0], v1[2]};
                                *(f32x4*)(dst + d0 + 32) = (f32x4){v0[1], v0[3], v1[1], v1[3]};
                            } else {
                                const int p0 = 32 * (wc & 1) + 8 * fq;
                                *(f32x4*)(dst + p0) = v0; *(f32x4*)(dst + p0 + 4) = v1;
                            }
                        }
                    }
                }
            }
        }
    }
};
struct EpiInS {
    bf16_t* H; const float* rope; float* ks; float* vs; const float* RSin;
    DI void operator()(f32x4 v, int m, int n) const {
        const int pn = n >> 8;
        if (pn < 9) {
            const f32x4 t = *(const f32x4*)(rope + ((size_t)SEQ * 32 + ((n & 63) >> 1)) * 2);
            float a, b;
            a = v[0]; b = v[1]; v[0] = a * t[0] - b * t[1]; v[1] = b * t[0] + a * t[1];
            a = v[2]; b = v[3]; v[2] = a * t[2] - b * t[3]; v[3] = b * t[2] + a * t[3];
        }
        float sc = 1.f;
        if (pn < 8) sc = 0.125f; else if (pn == 18 || pn == 19) sc = 0.08838834764831845f; else if (pn >= 30 && pn < 34) sc = 0.0625f;
        if (RSin) sc *= __builtin_amdgcn_rsqf(RSin[TP + m] * (1.f / DM) + EPS);
        v = v * sc;
        u32x2 w2; w2.x = pk2(v[0], v[1]); w2.y = pk2(v[2], v[3]);
        *(u32x2*)(H + (size_t)(TP + m) * NP + n) = w2;
        if (pn == 8) {
            float* dst = ks + ((size_t)(m * 128 + 127) * 4 + ((n - C_SK) >> 6)) * 64; const int d0 = (n & 63) >> 1;
            dst[d0] = v[0]; dst[d0 + 32] = v[1]; dst[d0 + 1] = v[2]; dst[d0 + 33] = v[3];
        } else if (pn == 9) {
            float* dst = vs + ((size_t)(m * 128 + 127) * 4 + ((n - C_SV) >> 6)) * 64 + (n & 63);
            *(f32x4*)dst = v;
        }
    }
};
struct EpiResS {
    const float* base; float* X; const float* gnext; bf16_t* XNo; float* RS; int fin;
    DI void operator()(f32x4 v, int m, int n) const {
        const f32x4 x = *(const f32x4*)(base + (size_t)m * DM + n) + v;
        if (!fin) *(f32x4*)(X + (size_t)m * DM + n) = x;
        if (gnext) {
            const f32x4 y = x * *(const f32x4*)(gnext + n);
            if (fin) *(f32x4*)(X + (size_t)m * DM + n) = y;
            else { u32x2 w2; w2.x = pk2(y[0], y[1]); w2.y = pk2(y[2], y[3]); *(u32x2*)(XNo + (size_t)(TP + m) * DM + n) = w2; }
            float q = (x[0] * x[0] + x[1] * x[1]) + (x[2] * x[2] + x[3] * x[3]);
            q += __shfl_xor(q, 16); q += __shfl_xor(q, 32);
            if (((n >> 2) & 3) == 0) atomicAdd(RS + TP + m, q);
        }
    }
};
template <class EpiS>
DI void skinny_task(unsigned char* lds, const bf16_t* X, const bf16_t* Wt, int task, int tid, const EpiS& E) {
    const int lane = tid & 63, w = tid >> 6, c16 = lane & 15, quad = lane >> 4;
    const int ntl = w & 1, ksp = w >> 1;
    const int n0 = task * 32 + ntl * 16;
    f32x4 acc0 = {0.f, 0.f, 0.f, 0.f}, acc1 = {0.f, 0.f, 0.f, 0.f};
    const bf16_t* wp = Wt + (size_t)(n0 + c16) * DM + ksp * 1024 + quad * 8;
    const bf16_t* xp0 = X + (size_t)c16 * DM + ksp * 1024 + quad * 8;
    const bf16_t* xp1 = xp0 + 16 * DM;
    for (int k0 = 0; k0 < 32; k0 += 16) {
        bf16x8 av[16], b0v[16], b1v[16];
#pragma unroll
        for (int j = 0; j < 16; ++j) { av[j] = *(const bf16x8*)(wp + (k0 + j) * 32); b0v[j] = *(const bf16x8*)(xp0 + (k0 + j) * 32); b1v[j] = *(const bf16x8*)(xp1 + (k0 + j) * 32); }
#pragma unroll
        for (int j = 0; j < 16; ++j) { acc0 = mfma16(av[j], b0v[j], acc0); acc1 = mfma16(av[j], b1v[j], acc1); }
    }
    f32x4* red = (f32x4*)lds;
    __syncthreads();
    red[(w * 2 + 0) * 64 + lane] = acc0; red[(w * 2 + 1) * 64 + lane] = acc1;
    __syncthreads();
    if (w < 2) {
#pragma unroll
        for (int mt = 0; mt < 2; ++mt) {
            f32x4 v = red[((0 * 2 + w) * 2 + mt) * 64 + lane];
#pragma unroll
            for (int kp = 1; kp < 4; ++kp) v += red[((kp * 2 + w) * 2 + mt) * 64 + lane];
            E(v, mt * 16 + c16, n0 + quad * 4);
        }
    }
}
struct EpiMem {
    static constexpr bool PERM = true, AFTER_DRAIN = false;
    bf16_t* MKV; float* outk; float* outv;
    DI void operator()(const f32x4 (&acc)[2][2][4][2], const pg8::Unit& u, int wr, int wc, int fr, int fq) const {
        const int row0 = u.pm * 256 + wr * 64 + fr;
#pragma unroll
        for (int ai = 0; ai < 2; ++ai)
#pragma unroll
            for (int m = 0; m < 4; ++m) {
                const int row = row0 + ai * 128 + m * 16;
#pragma unroll
                for (int bj = 0; bj < 2; ++bj) {
                    const int col = u.pn * 256 + bj * 128 + wc * 32 + 8 * fq;
                    const f32x4 v0 = acc[ai][bj][m][0], v1 = acc[ai][bj][m][1];
                    u32x4 w4; w4.x = pk2(v0[0], v0[1]); w4.y = pk2(v0[2], v0[3]); w4.z = pk2(v1[0], v1[1]); w4.w = pk2(v1[2], v1[3]);
                    *(u32x4*)(MKV + (size_t)row * 2048 + col) = w4;
                    float* dst = (col < 1024) ? (outk + (size_t)row * 1024 + col) : (outv + (size_t)row * 1024 + (col - 1024));
                    *(f32x4*)dst = v0; *(f32x4*)(dst + 4) = v1;
                }
            }
    }
};
struct EpiRes {
    static constexpr bool PERM = true, AFTER_DRAIN = false;
    const float* baseP; float* X; const float* gnext; bf16_t* XNo; float* RS; int fin;
    DI void operator()(const f32x4 (&acc)[2][2][4][2], const pg8::Unit& u, int wr, int wc, int fr, int fq) const {
        const int row0 = u.pm * 256 + wr * 64 + fr;
        const int col0 = u.pn * 256 + wc * 32 + 8 * fq;
        f32x4 gv[2][2];
#pragma unroll
        for (int bj = 0; bj < 2; ++bj) { gv[bj][0] = (f32x4){0.f, 0.f, 0.f, 0.f}; gv[bj][1] = gv[bj][0];
            if (gnext) { gv[bj][0] = *(const f32x4*)(gnext + col0 + bj * 128); gv[bj][1] = *(const f32x4*)(gnext + col0 + bj * 128 + 4); } }
#pragma unroll
        for (int am = 0; am < 4; ++am) {
            const int ai = am >> 1, mb = (am & 1) * 2;
            f32x4 bv[2][2][2];
#pragma unroll
            for (int mm = 0; mm < 2; ++mm)
#pragma unroll
                for (int bj = 0; bj < 2; ++bj) {
                    const float* bp = baseP + (size_t)(row0 + ai * 128 + (mb + mm) * 16) * DM + col0 + bj * 128;
                    bv[mm][bj][0] = *(const f32x4*)bp; bv[mm][bj][1] = *(const f32x4*)(bp + 4);
                }
#pragma unroll
            for (int mm = 0; mm < 2; ++mm) {
                const int m = mb + mm;
                const int row = row0 + ai * 128 + m * 16;
                float q = 0.f;
#pragma unroll
                for (int bj = 0; bj < 2; ++bj) {
                    float* xp = X + (size_t)row * DM + col0 + bj * 128;
                    const f32x4 x0 = bv[mm][bj][0] + acc[ai][bj][m][0], x1 = bv[mm][bj][1] + acc[ai][bj][m][1];
                    if (!fin && X) { *(f32x4*)xp = x0; *(f32x4*)(xp + 4) = x1; }
                    if (gnext) {
                        const f32x4 y0 = x0 * gv[bj][0], y1 = x1 * gv[bj][1];
                        if (fin) { *(f32x4*)xp = y0; *(f32x4*)(xp + 4) = y1; }
                        else { u32x4 w4; w4.x = pk2(y0[0], y0[1]); w4.y = pk2(y0[2], y0[3]); w4.z = pk2(y1[0], y1[1]); w4.w = pk2(y1[2], y1[3]);
                               *(u32x4*)(XNo + (size_t)row * DM + col0 + bj * 128) = w4; }
                        q += ((x0[0] * x0[0] + x0[1] * x0[1]) + (x0[2] * x0[2] + x0[3] * x0[3])) + ((x1[0] * x1[0] + x1[1] * x1[1]) + (x1[2] * x1[2] + x1[3] * x1[3]));
                    }
                }
                if (gnext) { q += __shfl_xor(q, 16); q += __shfl_xor(q, 32); if (fq == 0) atomicAdd(RS + row, q); }
            }
        }
    }
};

struct EpiFin {
    static constexpr bool PERM = true, AFTER_DRAIN = false;
    const bf16_t* XNb; const float* g1; float* Y; const float* g; float* RS; unsigned* pcnt;
    DI void operator()(const f32x4 (&acc_)[2][2][4][2], const pg8::Unit& u, int wr, int wc, int fr, int fq) const {
        f32x4 (&acc)[2][2][4][2] = const_cast<f32x4 (&)[2][2][4][2]>(acc_);
        const int row0 = u.pm * 256 + wr * 64 + fr;
        const int col0 = u.pn * 256 + wc * 32 + 8 * fq;
        f32x4 gv[2][2];
#pragma unroll
        for (int bj = 0; bj < 2; ++bj) { gv[bj][0] = *(const f32x4*)(g + col0 + bj * 128); gv[bj][1] = *(const f32x4*)(g + col0 + bj * 128 + 4); }
        f32x4 rg[2][2];
#pragma unroll
        for (int bj = 0; bj < 2; ++bj)
#pragma unroll
            for (int hh = 0; hh < 2; ++hh) { const f32x4 t = *(const f32x4*)(g1 + col0 + bj * 128 + 4 * hh);
                rg[bj][hh] = (f32x4){__builtin_amdgcn_rcpf(t[0]), __builtin_amdgcn_rcpf(t[1]), __builtin_amdgcn_rcpf(t[2]), __builtin_amdgcn_rcpf(t[3])}; }
#pragma unroll
        for (int am = 0; am < 4; ++am) {
            const int ai = am >> 1, mb = (am & 1) * 2;
            u32x4 bw[2][2];
#pragma unroll
            for (int mm = 0; mm < 2; ++mm)
#pragma unroll
                for (int bj = 0; bj < 2; ++bj) bw[mm][bj] = *(const u32x4*)(XNb + (size_t)(row0 + ai * 128 + (mb + mm) * 16) * DM + col0 + bj * 128);
#pragma unroll
            for (int mm = 0; mm < 2; ++mm) {
                const int m = mb + mm;
                float q = 0.f;
#pragma unroll
                for (int bj = 0; bj < 2; ++bj) {
                    const u32x4 wv = bw[mm][bj];
                    const f32x4 x0 = (f32x4){bflo(wv.x), bfhi(wv.x), bflo(wv.y), bfhi(wv.y)} * rg[bj][0] + acc[ai][bj][m][0];
                    const f32x4 x1 = (f32x4){bflo(wv.z), bfhi(wv.z), bflo(wv.w), bfhi(wv.w)} * rg[bj][1] + acc[ai][bj][m][1];
                    q += ((x0[0] * x0[0] + x0[1] * x0[1]) + (x0[2] * x0[2] + x0[3] * x0[3])) + ((x1[0] * x1[0] + x1[1] * x1[1]) + (x1[2] * x1[2] + x1[3] * x1[3]));
                    acc[ai][bj][m][0] = x0 * gv[bj][0]; acc[ai][bj][m][1] = x1 * gv[bj][1];
                }
                q += __shfl_xor(q, 16); q += __shfl_xor(q, 32);
                if (fq == 0) atomicAdd(RS + row0 + ai * 128 + m * 16, q);
            }
        }
        asm volatile("s_waitcnt vmcnt(0)" ::: "memory");
        unsigned* pc = pcnt + 64 * u.pm;
        if (fr == 0 && fq == 0) __hip_atomic_fetch_add(pc, 1u, __ATOMIC_RELAXED, __HIP_MEMORY_SCOPE_AGENT);
        { unsigned sp = 0; while (__hip_atomic_load(pc, __ATOMIC_RELAXED, __HIP_MEMORY_SCOPE_AGENT) < 128u) { __builtin_amdgcn_s_sleep(2); if (++sp > (1u << 21)) break; } }
        asm volatile("" ::: "memory");
#pragma unroll
        for (int ai = 0; ai < 2; ++ai)
#pragma unroll
            for (int m = 0; m < 4; ++m) {
                const int row = row0 + ai * 128 + m * 16;
                const float rs = __builtin_amdgcn_rsqf(__hip_atomic_load(RS + row, __ATOMIC_RELAXED, __HIP_MEMORY_SCOPE_AGENT) * (1.f / DM) + EPS);
#pragma unroll
                for (int bj = 0; bj < 2; ++bj) {
                    float* yp = Y + (size_t)row * DM + col0 + bj * 128;
                    *(f32x4*)yp = acc[ai][bj][m][0] * rs; *(f32x4*)(yp + 4) = acc[ai][bj][m][1] * rs;
                }
            }
    }
};
struct EpiInMem {
    static constexpr bool PERM = true, AFTER_DRAIN = false;
    EpiIn ein; EpiMem emem;
    DI void operator()(const f32x4 (&acc)[2][2][4][2], const pg8::Unit& u, int wr, int wc, int fr, int fq) const { if (u.sel) emem(acc, u, wr, wc, fr, fq); else ein(acc, u, wr, wc, fr, fq); }
};
struct InMemOrder {
    pg8::StaticOrder so; int nin;
    DI void init(int G_, int c_) { so.init(TP, NP, G_, c_); nin = (TP / 256) * (NP / 256); }
    DI bool next(int i, pg8::Unit& u) const {
        const long L = (long)i * so.G + so.c;
        if (L < nin) return so.next(i, u);
        const int idx = (int)(L - nin); if (idx >= 32) return false;
        u.pm = idx & 3; u.pn = idx >> 2; u.sel = 1; return true;
    }
    DI void a_ready(const pg8::Unit&) const {}
    DI void done(const pg8::Unit&) const {}
};
struct PanelOrder {
    int G, c;
    DI void init(int G_, int c_) { G = G_; c = c_; }
    DI bool next(int i, pg8::Unit& u) const {
        if (G == 256) { if (i >= 2) return false; const int xcd = c & 7, r = c >> 3, j = xcd >> 1, hx = xcd & 1; u.pm = 16 * i + 4 * j + (r & 3); u.pn = 8 * hx + (r >> 2); u.sel = 0; return true; }
        const long L = (long)i * G + c; if (L >= 512) return false; u.pm = (int)(L >> 4); u.pn = (int)(L & 15); u.sel = 0; return true;
    }
    DI void a_ready(const pg8::Unit&) const {}
    DI void done(const pg8::Unit&) const {}
};

DI int dst_row_in(int s) {
    if (s < 2304) { const int d = s & 63; return (s & ~63) + 2 * (d & 31) + (d >> 5); }
    if (s < 6656) return s;
    if (s < 6672) return 9728 + (s - 6656);
    return s - 16;
}
struct TrItem { const float* W; bf16_t* WT; int N, item, inmap; };
DI void tr_load(const TrItem& t, f32x4 (&tv)[16], int lane) {
    const int nblk = (t.N + 63) >> 6, kb = t.item / nblk, nb = t.item - kb * nblk, k0 = 64 * kb, n0 = 64 * nb;
    const int cl = (lane & 15) * 4, rl = lane >> 4;
    const bool okc = (n0 + cl) < t.N;
#pragma unroll
    for (int i = 0; i < 16; ++i) { tv[i] = (f32x4){0.f, 0.f, 0.f, 0.f}; if (okc) tv[i] = *(const f32x4*)(t.W + (size_t)(k0 + 4 * i + rl) * t.N + n0 + cl); }
}
DI void tr_store(const TrItem& t, const f32x4 (&tv)[16], float* scr, int lane) {
    const int nblk = (t.N + 63) >> 6, kb = t.item / nblk, nb = t.item - kb * nblk, k0 = 64 * kb, n0 = 64 * nb;
    const int cl = (lane & 15) * 4, rl = lane >> 4;
#pragma unroll
    for (int i = 0; i < 16; ++i) { float* s = scr + (4 * i + rl) * 65 + cl; s[0] = tv[i][0]; s[1] = tv[i][1]; s[2] = tv[i][2]; s[3] = tv[i][3]; }
    asm volatile("s_waitcnt lgkmcnt(0)" ::: "memory");
    const int c = lane & 7;
#pragma unroll
    for (int j = 0; j < 8; ++j) {
        const int n = (lane >> 3) + 8 * j;
        if (n0 + n < t.N) {
            const float* s = scr + (8 * c) * 65 + n;
            u32x4 o; o.x = pk2(s[0], s[65]); o.y = pk2(s[2 * 65], s[3 * 65]); o.z = pk2(s[4 * 65], s[5 * 65]); o.w = pk2(s[6 * 65], s[7 * 65]);
            const int row = t.inmap ? dst_row_in(n0 + n) : (n0 + n);
            *(u32x4*)(t.WT + (size_t)row * DM + k0 + 8 * c) = o;
        }
    }
    asm volatile("s_waitcnt lgkmcnt(0)" ::: "memory");
}
DI void norm_row(const float* src, const float* g, bf16_t* dstb, float* dstf, int lane) {
    const f32x4* xr = (const f32x4*)src + lane;
    f32x4 v[16]; float s = 0.f;
#pragma unroll
    for (int j = 0; j < 16; ++j) { v[j] = xr[64 * j]; s += (v[j][0] * v[j][0] + v[j][1] * v[j][1]) + (v[j][2] * v[j][2] + v[j][3] * v[j][3]); }
    const f32x4* gr = (const f32x4*)g + lane;
    f32x4 gv[16];
#pragma unroll
    for (int j = 0; j < 16; ++j) gv[j] = gr[64 * j];
    const float rs = __builtin_amdgcn_rsqf(wave_sum(s) * (1.f / DM) + EPS);
#pragma unroll
    for (int j = 0; j < 16; ++j) {
        const f32x4 o = v[j] * rs * gv[j];
        if (dstb) { u32x2 w2; w2.x = pk2(o[0], o[1]); w2.y = pk2(o[2], o[3]); *((u32x2*)dstb + lane + 64 * j) = w2; }
        else *((f32x4*)dstf + lane + 64 * j) = o;
    }
}
DI void rope_entry(float* tab, int idx) {
    const int pi = idx >> 5, i = idx & 31;
    const double pos = pi < SEQ ? (double)pi : 16384.0;
    double inv = 1.0; for (int k = 0; k < i; ++k) inv *= 0.7498942093324559;
    const double a = pos * inv;
    const double q = __builtin_rint(a * 0.6366197723675814);
    const double r = (a - q * 1.5707963267948966) - q * 6.123233995736766e-17;
    const int qi = ((int)q) & 3;
    const double r2 = r * r;
    const double sn = r * (1.0 + r2 * (-1.0 / 6 + r2 * (1.0 / 120 + r2 * (-1.0 / 5040 + r2 * (1.0 / 362880 + r2 * (-1.0 / 39916800 + r2 * (1.0 / 6227020800.0)))))));
    const double cs = 1.0 + r2 * (-0.5 + r2 * (1.0 / 24 + r2 * (-1.0 / 720 + r2 * (1.0 / 40320 + r2 * (-1.0 / 3628800 + r2 * (1.0 / 479001600 + r2 * (-1.0 / 87178291200.0)))))));
    double c, s;
    if (qi == 0) { c = cs; s = sn; } else if (qi == 1) { c = -sn; s = cs; } else if (qi == 2) { c = -cs; s = -sn; } else { c = sn; s = -cs; }
    tab[2 * idx] = (float)c; tab[2 * idx + 1] = (float)s;
}

DI void swa_unit(unsigned char* lds, const bf16_t* H, bf16_t* Gt, const float* sinks, int u, int tid) {
    const int kvh = u & 3, blk = (u >> 2) & 15, b = u >> 6;
    bf16_t* Ks = (bf16_t*)lds;
    bf16_t* Vt = (bf16_t*)(lds + 39168);
    const int lane = tid & 63, w = tid >> 6, c16 = lane & 15, quad = lane >> 4;
    const int qi = w * 16 + c16;
    const size_t qrow = (size_t)(b * SEQ + blk * 128 + qi);
    bf16x8 qc0 = *(const bf16x8*)(H + qrow * NP + C_SQ + kvh * 512 + quad * 8), qc1 = *(const bf16x8*)(H + qrow * NP + C_SQ + kvh * 512 + 32 + quad * 8);
    __syncthreads();
    {
        const int r = tid >> 1, half = tid & 1;
        const int tok = blk * 128 - 128 + r;
        u32x4 kv[4], vv[4];
#pragma unroll
        for (int i = 0; i < 4; ++i) { kv[i] = (u32x4){0u, 0u, 0u, 0u}; vv[i] = (u32x4){0u, 0u, 0u, 0u}; }
        if (tok >= 0) {
            const bf16_t* src = H + (size_t)(b * SEQ + tok) * NP + kvh * 64 + half * 32;
#pragma unroll
            for (int i = 0; i < 4; ++i) { kv[i] = *(const u32x4*)(src + C_SK + i * 8); vv[i] = *(const u32x4*)(src + C_SV + i * 8); }
        }
#pragma unroll
        for (int i = 0; i < 4; ++i) *(u32x4*)(Ks + r * 72 + half * 32 + i * 8) = kv[i];
#pragma unroll
        for (int i = 0; i < 4; ++i)
#pragma unroll
            for (int e = 0; e < 4; ++e) {
                const unsigned wv = vv[i][e];
                Vt[(half * 32 + i * 8 + 2 * e) * 280 + r] = (bf16_t)(wv & 0xffffu);
                Vt[(half * 32 + i * 8 + 2 * e + 1) * 280 + r] = (bf16_t)(wv >> 16);
            }
        for (int i = tid; i < 576; i += 512) ((unsigned*)(Ks + 256 * 72))[i] = 0u;
        { const int d = tid >> 3, cc = 256 + (tid & 7) * 2; *(unsigned*)(Vt + d * 280 + cc) = 0u; }
    }
    __syncthreads();
    for (int g = 0; g < 8; ++g) {
        const int head = kvh * 8 + g;
        bf16x8 qf[2]; qf[0] = qc0; qf[1] = qc1;
        { const int hn = kvh * 8 + (g < 7 ? g + 1 : g);
          qc0 = *(const bf16x8*)(H + qrow * NP + C_SQ + hn * 64 + quad * 8); qc1 = *(const bf16x8*)(H + qrow * NP + C_SQ + hn * 64 + 32 + quad * 8); }
        u32x2 gwv[4];
#pragma unroll
        for (int mt = 0; mt < 4; ++mt) gwv[mt] = *(const u32x2*)(H + qrow * NP + C_SG + head * 64 + mt * 16 + quad * 4);
        f32x4 s[10];
#pragma unroll
        for (int i = 0; i < 10; ++i) {
            s[i] = (f32x4){0.f, 0.f, 0.f, 0.f};
            const bf16_t* kp = Ks + ((w + i) * 16 + c16) * 72 + quad * 8;
#pragma unroll
            for (int ks = 0; ks < 2; ++ks) s[i] = mfma16(*(const bf16x8*)(kp + ks * 32), qf[ks], s[i]);
        }
        const float sink = sinks[head];
        float mx = sink;
        int qiv = qi + 128 - (w * 16 + quad * 4); asm volatile("" : "+v"(qiv));
        const int lowlim = blk > 0 ? 0 : 128;
#pragma unroll
        for (int i = 0; i < 10; ++i)
#pragma unroll
            for (int j = 0; j < 4; ++j) {
                const int sj = (w + i) * 16 + quad * 4 + j, diff = qiv - (i * 16 + j);
                const bool valid = (unsigned)diff < 128u && sj >= lowlim;
                s[i][j] = valid ? s[i][j] : -INFINITY;
                mx = fmaxf(mx, s[i][j]);
            }
        mx = fmaxf(mx, __shfl_xor(mx, 16)); mx = fmaxf(mx, __shfl_xor(mx, 32));
        float sum = 0.f;
#pragma unroll
        for (int i = 0; i < 10; ++i)
#pragma unroll
            for (int j = 0; j < 4; ++j) { const float p = __expf(s[i][j] - mx); s[i][j] = p; sum += p; }
        sum += __shfl_xor(sum, 16); sum += __shfl_xor(sum, 32);
        sum += __expf(sink - mx);
        const float inv = __builtin_amdgcn_rcpf(sum);
        f32x4 o[4];
#pragma unroll
        for (int mt = 0; mt < 4; ++mt) o[mt] = (f32x4){0.f, 0.f, 0.f, 0.f};
#pragma unroll
        for (int st = 0; st < 5; ++st) {
            const bf16x8 pb = pack8(s[2 * st], s[2 * st + 1]);
#pragma unroll
            for (int mt = 0; mt < 4; ++mt) {
                const bf16_t* vp = Vt + (mt * 16 + c16) * 280 + (w + 2 * st) * 16 + quad * 4;
                o[mt] = mfma16(cat4(*(const s16x4*)vp, *(const s16x4*)(vp + 16)), pb, o[mt]);
            }
        }
#pragma unroll
        for (int mt = 0; mt < 4; ++mt) {
            const int d = mt * 16 + quad * 4;
            const u32x2 gw = gwv[mt];
            u32x2 ow;
            ow.x = pk2(o[mt][0] * inv * silu(bflo(gw.x)), o[mt][1] * inv * silu(bfhi(gw.x)));
            ow.y = pk2(o[mt][2] * inv * silu(bflo(gw.y)), o[mt][3] * inv * silu(bfhi(gw.y)));
            *(u32x2*)(Gt + qrow * DM + head * 64 + d) = ow;
        }
    }
}

DI void mem_unit(unsigned char* lds, const bf16_t* H, const bf16_t* MKV, bf16_t* Gt, int u, int tid) {
    const int qt = u & 15, h = (u >> 4) & 3, b = u >> 6;
    bf16_t* Kc = (bf16_t*)lds;
    bf16_t* Vc = (bf16_t*)(lds + 33792);
    const int lane = tid & 63, w = tid >> 6, c16 = lane & 15, quad = lane >> 4;
    const size_t qrow = (size_t)(b * SEQ + qt * 128 + w * 16 + c16);
    const int srow = tid >> 3, seg = tid & 7;
    const bf16_t* ksrc = MKV + (size_t)(b * 256 + srow) * 2048 + h * 256 + seg * 32;
    const bf16_t* vsrc = MKV + (size_t)(b * 256 + lane) * 2048 + 1024 + h * 256 + w * 32;
    u32x4 pre[4];
#pragma unroll
    for (int i = 0; i < 4; ++i) pre[i] = *(const u32x4*)(ksrc + i * 8);
    bf16x8 qf[8];
#pragma unroll
    for (int ks = 0; ks < 8; ++ks) qf[ks] = *(const bf16x8*)(H + qrow * NP + C_MQ + h * 256 + ks * 32 + quad * 8);
    f32x4 s[16];
#pragma unroll
    for (int c = 0; c < 4; ++c) {
        __syncthreads();
#pragma unroll
        for (int i = 0; i < 4; ++i) *(u32x4*)(Kc + srow * 264 + seg * 32 + i * 8) = pre[i];
        if (c < 3) {
#pragma unroll
            for (int i = 0; i < 4; ++i) pre[i] = *(const u32x4*)(ksrc + (size_t)(c + 1) * 64 * 2048 + i * 8);
        } else {
#pragma unroll
            for (int i = 0; i < 4; ++i) pre[i] = *(const u32x4*)(vsrc + i * 8);
        }
        __syncthreads();
#pragma unroll
        for (int kt = 0; kt < 4; ++kt) {
            f32x4 a = {0.f, 0.f, 0.f, 0.f};
            const bf16_t* kp = Kc + (kt * 16 + c16) * 264 + quad * 8;
#pragma unroll
            for (int ks = 0; ks < 8; ++ks) a = mfma16(*(const bf16x8*)(kp + ks * 32), qf[ks], a);
            s[c * 4 + kt] = a;
        }
    }
    u32x2 gwv[16];
#pragma unroll
    for (int mt = 0; mt < 16; ++mt) gwv[mt] = *(const u32x2*)(H + qrow * NP + C_MG + h * 256 + mt * 16 + quad * 4);
    float mx = -INFINITY;
#pragma unroll
    for (int i = 0; i < 16; ++i)
#pragma unroll
        for (int j = 0; j < 4; ++j) mx = fmaxf(mx, s[i][j]);
    mx = fmaxf(mx, __shfl_xor(mx, 16)); mx = fmaxf(mx, __shfl_xor(mx, 32));
    float sum = 0.f;
#pragma unroll
    for (int i = 0; i < 16; ++i)
#pragma unroll
        for (int j = 0; j < 4; ++j) { const float p = __expf(s[i][j] - mx); s[i][j] = p; sum += p; }
    sum += __shfl_xor(sum, 16); sum += __shfl_xor(sum, 32);
    const float inv = __builtin_amdgcn_rcpf(sum);
    bf16x8 pbv[8];
#pragma unroll
    for (int i = 0; i < 8; ++i) pbv[i] = pack8(s[2 * i], s[2 * i + 1]);
    f32x4 o[16];
#pragma unroll
    for (int mt = 0; mt < 16; ++mt) o[mt] = (f32x4){0.f, 0.f, 0.f, 0.f};
#pragma unroll
    for (int c = 0; c < 4; ++c) {
        __syncthreads();
#pragma unroll
        for (int i = 0; i < 4; ++i)
#pragma unroll
            for (int e = 0; e < 4; ++e) {
                Vc[(w * 32 + i * 8 + 2 * e) * 72 + lane] = (bf16_t)(pre[i][e] & 0xffffu);
                Vc[(w * 32 + i * 8 + 2 * e + 1) * 72 + lane] = (bf16_t)(pre[i][e] >> 16);
            }
        if (c < 3) {
#pragma unroll
            for (int i = 0; i < 4; ++i) pre[i] = *(const u32x4*)(vsrc + (size_t)(c + 1) * 64 * 2048 + i * 8);
        }
        __syncthreads();
#pragma unroll
        for (int st = 0; st < 2; ++st) {
            const bf16x8 pb = pbv[c * 2 + st];
#pragma unroll
            for (int mt = 0; mt < 16; ++mt) {
                const bf16_t* vp = Vc + (mt * 16 + c16) * 72 + (2 * st) * 16 + quad * 4;
                o[mt] = mfma16(cat4(*(const s16x4*)vp, *(const s16x4*)(vp + 16)), pb, o[mt]);
            }
        }
    }
#pragma unroll
    for (int mt = 0; mt < 16; ++mt) {
        const int d = mt * 16 + quad * 4;
        const u32x2 gw = gwv[mt];
        u32x2 ow;
        ow.x = pk2(o[mt][0] * inv * silu(bflo(gw.x)), o[mt][1] * inv * silu(bfhi(gw.x)));
        ow.y = pk2(o[mt][2] * inv * silu(bflo(gw.y)), o[mt][3] * inv * silu(bfhi(gw.y)));
        *(u32x2*)(Gt + qrow * DM + 3072 + h * 256 + d) = ow;
    }
}

DI float logsig16(float z) { return (fminf(z, 0.f) - __logf(1.f + __expf(-fabsf(z)))) * 0.0625f; }

constexpr int GI_QS = 0, GI_AS = 17408, GI_VT = 26624, GI_BYTES = 63488, GI_IMG = 26624;
DI void gla_prep_unit(unsigned char* lds, const bf16_t* H, const float* wg, const float* bg, u32x2* Ug, float* EBLg, unsigned char* IMG, int u, int tid) {
    const int ch = u & 31, h = (u >> 5) & 3, b = u >> 7;
    bf16_t* Qs = (bf16_t*)(lds + GI_QS);
    bf16_t* As = (bf16_t*)(lds + GI_AS);
    bf16_t* Vt = (bf16_t*)(lds + GI_VT);
    bf16_t* Ks = (bf16_t*)(lds + 63488);
    bf16_t* Kt = (bf16_t*)(lds + 80896);
    float* LR = (float*)(lds + 99328);
    float* WgL = (float*)(lds + 103424);
    float* GT = (float*)(lds + 111616);
    const int lane = tid & 63, w = tid >> 6, c16 = lane & 15, quad = lane >> 4;
    const size_t row0 = (size_t)(b * SEQ + ch * 64);
    __syncthreads();
    { const int i = tid >> 3, r2 = (tid & 7) * 2; const unsigned wv = *(const unsigned*)(H + (row0 + i) * NP + C_LR + r2); LR[i * 16 + r2] = bflo(wv); LR[i * 16 + r2 + 1] = bfhi(wv); }
#pragma unroll
    for (int r = 0; r < 4; ++r) { const int idx = tid + 512 * r; WgL[idx] = wg[(idx >> 7) * 512 + h * 128 + (idx & 127)]; }
    const int dk = tid & 127, ig = tid >> 7;
    const float bgc = bg[h * 128 + dk];
    unsigned short qr[16], kr[16];
#pragma unroll
    for (int ii = 0; ii < 16; ++ii) { const bf16_t* src = H + (row0 + ig * 16 + ii) * NP + h * 128 + dk; qr[ii] = src[C_GQ]; kr[ii] = src[C_GK]; }
    u32x4 vpre[4];
#pragma unroll
    for (int i = 0; i < 4; ++i) vpre[i] = *(const u32x4*)(H + (row0 + lane) * NP + C_GV + h * 256 + w * 32 + i * 8);
    __syncthreads();
    float bb[16];
    {
        float wgc[16];
#pragma unroll
        for (int r = 0; r < 16; ++r) wgc[r] = WgL[r * 128 + dk];
        float run = 0.f;
#pragma unroll
        for (int ii = 0; ii < 16; ++ii) {
            const int i = ig * 16 + ii;
            float z = bgc;
#pragma unroll
            for (int r = 0; r < 16; ++r) z += LR[i * 16 + r] * wgc[r];
            run += logsig16(z); bb[ii] = run;
        }
        GT[ig * 128 + dk] = run;
    }
#pragma unroll
    for (int i = 0; i < 4; ++i)
#pragma unroll
        for (int e = 0; e < 4; ++e) {
            Vt[(w * 32 + i * 8 + 2 * e) * 72 + lane] = (bf16_t)(vpre[i][e] & 0xffffu);
            Vt[(w * 32 + i * 8 + 2 * e + 1) * 72 + lane] = (bf16_t)(vpre[i][e] >> 16);
        }
    __syncthreads();
    {
        const float t0 = GT[dk], t1 = GT[128 + dk], t2 = GT[256 + dk], t3 = GT[384 + dk];
        const float bl = (t0 + t1) + (t2 + t3);
        const float off = (ig > 0 ? t0 : 0.f) + (ig > 1 ? t1 : 0.f) + (ig > 2 ? t2 : 0.f);
#pragma unroll
        for (int ii = 0; ii < 16; ++ii) {
            const int i = ig * 16 + ii;
            const float bv = off + bb[ii], q = bf2f(qr[ii]), k = bf2f(kr[ii]);
            Qs[i * 136 + dk] = f2bf(q * __expf(bv));
            Ks[i * 136 + dk] = f2bf(k * __expf(-bv));
            Kt[dk * 72 + i] = f2bf(k * __expf(bl - bv));
        }
        if (ig == 0) EBLg[(size_t)u * 128 + dk] = __expf(bl);
    }
    __syncthreads();
#pragma unroll
    for (int tt = 0; tt < 2; ++tt) {
        const int t = 2 * w + tt, mt = t >> 2, nt = t & 3;
        f32x4 a = {0.f, 0.f, 0.f, 0.f};
        if (nt <= mt) {
#pragma unroll
            for (int ks = 0; ks < 4; ++ks)
                a = mfma16(*(const bf16x8*)(Qs + (mt * 16 + c16) * 136 + ks * 32 + quad * 8), *(const bf16x8*)(Ks + (nt * 16 + c16) * 136 + ks * 32 + quad * 8), a);
        }
#pragma unroll
        for (int jj = 0; jj < 4; ++jj) { const int i = mt * 16 + quad * 4 + jj, j = nt * 16 + c16; As[i * 72 + j] = f2bf(j <= i ? a[jj] : 0.f); }
    }
#pragma unroll
    for (int kt = 0; kt < 8; ++kt) {
        f32x4 s0 = {0.f, 0.f, 0.f, 0.f}, s1 = {0.f, 0.f, 0.f, 0.f};
#pragma unroll
        for (int ks = 0; ks < 2; ++ks) {
            const bf16x8 a = *(const bf16x8*)(Kt + (kt * 16 + c16) * 72 + ks * 32 + quad * 8);
            s0 = mfma16(a, *(const bf16x8*)(Vt + ((2 * w) * 16 + c16) * 72 + ks * 32 + quad * 8), s0);
            s1 = mfma16(a, *(const bf16x8*)(Vt + ((2 * w + 1) * 16 + c16) * 72 + ks * 32 + quad * 8), s1);
        }
        { u32x2 p0, p1; p0.x = pk2(s0[0], s0[1]); p0.y = pk2(s0[2], s0[3]); p1.x = pk2(s1[0], s1[1]); p1.y = pk2(s1[2], s1[3]);
          Ug[((size_t)(u * 8 + kt) * 16 + 2 * w) * 64 + lane] = p0; Ug[((size_t)(u * 8 + kt) * 16 + 2 * w + 1) * 64 + lane] = p1; }
    }
    __syncthreads();
    { u32x4* dst = (u32x4*)(IMG + (size_t)u * GI_IMG); const u32x4* srcl = (const u32x4*)lds;
      for (int i = tid; i < GI_IMG / 16; i += 512) dst[i] = srcl[i]; }
}
DI void gla_scan_task(const u32x2* Ug, const float* EBLg, u32x2* SF2, float* state_out, int t, int lane) {
    const int nt = t & 15, kt = (t >> 4) & 7, bh = t >> 7;
    const int c16 = lane & 15, quad = lane >> 4;
    f32x4 s0 = {0.f, 0.f, 0.f, 0.f};
    for (int n0 = 0; n0 < 32; n0 += 16) {
        f32x4 ev[16], uv[16];
#pragma unroll
        for (int j = 0; j < 16; ++j) {
            const size_t u = (size_t)bh * 32 + n0 + j;
            ev[j] = *(const f32x4*)(EBLg + u * 128 + kt * 16 + quad * 4);
            { const u32x2 p = Ug[((u * 8 + kt) * 16 + nt) * 64 + lane]; uv[j] = (f32x4){bflo(p.x), bfhi(p.x), bflo(p.y), bfhi(p.y)}; }
        }
#pragma unroll
        for (int j = 0; j < 16; ++j) {
            const size_t u = (size_t)bh * 32 + n0 + j;
            u32x2 pk; pk.x = pk2(s0[0], s0[1]); pk.y = pk2(s0[2], s0[3]);
            SF2[(((u * 4 + (kt >> 1)) * 16 + nt) * 64 + lane) * 2 + (kt & 1)] = pk;
            s0 = s0 * ev[j] + uv[j];
        }
    }
#pragma unroll
    for (int jj = 0; jj < 4; ++jj) state_out[((size_t)bh * 128 + kt * 16 + quad * 4 + jj) * 256 + nt * 16 + c16] = s0[jj];
}
DI void gla_out_unit(unsigned char* lds, const bf16_t* H, bf16_t* Gt, const float* gng, const u32x4* SF, const unsigned char* IMG, int u, int tid) {
    const int ch = u & 31, h = (u >> 5) & 3, b = u >> 7;
    const bf16_t* Qs = (const bf16_t*)(lds + GI_QS);
    const bf16_t* As = (const bf16_t*)(lds + GI_AS);
    const bf16_t* Vt = (const bf16_t*)(lds + GI_VT);
    float* SSw = (float*)(lds + GI_BYTES);
    const int lane = tid & 63, w = tid >> 6, c16 = lane & 15, quad = lane >> 4;
    const size_t row0 = (size_t)(b * SEQ + ch * 64);
    unsigned short gtv[4][4][2];
#pragma unroll
    for (int mt = 0; mt < 4; ++mt)
#pragma unroll
        for (int jj = 0; jj < 4; ++jj)
#pragma unroll
            for (int n = 0; n < 2; ++n) gtv[mt][jj][n] = H[(row0 + mt * 16 + quad * 4 + jj) * NP + C_GG + h * 256 + (2 * w + n) * 16 + c16];
    u32x4 vpre[4];
#pragma unroll
    for (int i = 0; i < 4; ++i) vpre[i] = *(const u32x4*)(H + (row0 + lane) * NP + C_GV + h * 256 + w * 32 + i * 8);
    __syncthreads();
    { const u32x4* src = (const u32x4*)(IMG + (size_t)u * GI_IMG); u32x4* dstl = (u32x4*)lds;
      for (int i = tid; i < GI_IMG / 16; i += 512) dstl[i] = src[i]; }
    { bf16_t* Vw = (bf16_t*)(lds + GI_VT);
#pragma unroll
      for (int i = 0; i < 4; ++i)
#pragma unroll
          for (int e = 0; e < 4; ++e) {
              Vw[(w * 32 + i * 8 + 2 * e) * 72 + lane] = (bf16_t)(vpre[i][e] & 0xffffu);
              Vw[(w * 32 + i * 8 + 2 * e + 1) * 72 + lane] = (bf16_t)(vpre[i][e] >> 16);
          } }
    bf16x8 sb[4][2];
#pragma unroll
    for (int ks = 0; ks < 4; ++ks)
#pragma unroll
        for (int n = 0; n < 2; ++n) sb[ks][n] = __builtin_bit_cast(bf16x8, SF[(((size_t)u * 4 + ks) * 16 + 2 * w + n) * 64 + lane]);
    __syncthreads();
    f32x4 o[4][2];
#pragma unroll
    for (int mt = 0; mt < 4; ++mt) {
        o[mt][0] = (f32x4){0.f, 0.f, 0.f, 0.f}; o[mt][1] = (f32x4){0.f, 0.f, 0.f, 0.f};
#pragma unroll
        for (int ks = 0; ks < 4; ++ks) {
            const bf16_t* qp = Qs + (mt * 16 + c16) * 136 + (2 * ks) * 16 + quad * 4;
            const bf16x8 a = cat4(*(const s16x4*)qp, *(const s16x4*)(qp + 16));
            o[mt][0] = mfma16(a, sb[ks][0], o[mt][0]); o[mt][1] = mfma16(a, sb[ks][1], o[mt][1]);
        }
#pragma unroll
        for (int ks = 0; ks < 2; ++ks) {
            const bf16x8 a = *(const bf16x8*)(As + (mt * 16 + c16) * 72 + ks * 32 + quad * 8);
#pragma unroll
            for (int n = 0; n < 2; ++n) o[mt][n] = mfma16(a, *(const bf16x8*)(Vt + ((2 * w + n) * 16 + c16) * 72 + ks * 32 + quad * 8), o[mt][n]);
        }
    }
#pragma unroll
    for (int mt = 0; mt < 4; ++mt)
#pragma unroll
        for (int jj = 0; jj < 4; ++jj) {
            float q = o[mt][0][jj] * o[mt][0][jj] + o[mt][1][jj] * o[mt][1][jj];
            q += __shfl_xor(q, 1); q += __shfl_xor(q, 2); q += __shfl_xor(q, 4); q += __shfl_xor(q, 8);
            if (c16 == 0) SSw[w * 64 + mt * 16 + quad * 4 + jj] = q;
        }
    __syncthreads();
    const float gn0 = gng[h * 256 + (2 * w) * 16 + c16], gn1 = gng[h * 256 + (2 * w + 1) * 16 + c16];
#pragma unroll
    for (int mt = 0; mt < 4; ++mt)
#pragma unroll
        for (int jj = 0; jj < 4; ++jj) {
            const int i = mt * 16 + quad * 4 + jj;
            float tot = 0.f;
#pragma unroll
            for (int ww = 0; ww < 8; ++ww) tot += SSw[ww * 64 + i];
            const float rs = __builtin_amdgcn_rsqf(tot * (1.f / 256.f) + EPS);
#pragma unroll
            for (int n = 0; n < 2; ++n) {
                const int dv = (2 * w + n) * 16 + c16;
                const float gate = bf2f(gtv[mt][jj][n]);
                Gt[(row0 + i) * DM + 2048 + h * 256 + dv] = f2bf(o[mt][n][jj] * rs * (n ? gn1 : gn0) * silu(gate));
            }
        }
}

DI void s_swa_unit(unsigned char* lds, const bf16_t* H, bf16_t* Gt, const float* ck, const float* cv, const float* sinks, float* kout, float* vout, int u, int tid) {
    const int kvh = u & 3, b = u >> 2;
    float* Kl = (float*)lds;
    float* Vl = Kl + 128 * 65;
    float* Ql = Vl + 128 * 64;
    float* Pl = Ql + 512;
    const int lane = tid & 63, w = tid >> 6;
    const bf16_t* hrow = H + (size_t)(TP + b) * NP;
    __syncthreads();
    {
        float kr[16], vr[16];
#pragma unroll
        for (int i = 0; i < 16; ++i) {
            const int kk = w + 8 * i;
            if (kk < 127) { const size_t o = ((size_t)(b * 128 + kk + 1) * 4 + kvh) * 64 + lane; kr[i] = ck[o]; vr[i] = cv[o]; }
            else { const int p = 2 * (lane & 31) + (lane >> 5); kr[i] = bf2f(hrow[C_SK + kvh * 64 + p]); vr[i] = bf2f(hrow[C_SV + kvh * 64 + lane]); }
        }
#pragma unroll
        for (int i = 0; i < 16; ++i) {
            const int kk = w + 8 * i;
            if (kk < 127) { const size_t oo = ((size_t)(b * 128 + kk) * 4 + kvh) * 64 + lane; kout[oo] = kr[i]; vout[oo] = vr[i]; }
            Kl[kk * 65 + lane] = kr[i]; Vl[kk * 64 + lane] = vr[i];
        }
    }
    { const int p = 2 * (lane & 31) + (lane >> 5); Ql[w * 64 + lane] = bf2f(hrow[C_SQ + (kvh * 8 + w) * 64 + p]); }
    __syncthreads();
    float s0 = 0.f, s1 = 0.f;
    for (int d = 0; d < 64; ++d) { const float qd = Ql[w * 64 + d]; s0 += qd * Kl[lane * 65 + d]; s1 += qd * Kl[(lane + 64) * 65 + d]; }
    const float sink = sinks[kvh * 8 + w];
    const float mx = fmaxf(wave_max(fmaxf(s0, s1)), sink);
    const float p0 = __expf(s0 - mx), p1 = __expf(s1 - mx);
    const float inv = __builtin_amdgcn_rcpf(wave_sum(p0 + p1) + __expf(sink - mx));
    Pl[w * 128 + lane] = p0 * inv; Pl[w * 128 + lane + 64] = p1 * inv;
    __syncthreads();
    float o = 0.f;
    for (int kk = 0; kk < 128; ++kk) o += Pl[w * 128 + kk] * Vl[kk * 64 + lane];
    const float gate = bf2f(hrow[C_SG + (kvh * 8 + w) * 64 + lane]);
    Gt[(size_t)(TP + b) * DM + (kvh * 8 + w) * 64 + lane] = f2bf(o * silu(gate));
}
DI void s_gla_unit(unsigned char* lds, const bf16_t* H, bf16_t* Gt, const float* wg, const float* bg, const float* gng, const float* sin_, float* sout, int u, int tid) {
    const int h = u & 3, b = u >> 2;
    float* gE = (float*)lds; float* qv = gE + 128; float* kv = qv + 128; float* vv = kv + 128; float* Osum = vv + 256; float* red = Osum + 2048;
    const int lane = tid & 63, w = tid >> 6;
    const bf16_t* hrow = H + (size_t)(TP + b) * NP;
    __syncthreads();
    if (tid < 128) {
        float z = bg[h * 128 + tid];
#pragma unroll
        for (int r = 0; r < 16; ++r) z += bf2f(hrow[C_LR + r]) * wg[r * 512 + h * 128 + tid];
        gE[tid] = __expf(logsig16(z)); qv[tid] = bf2f(hrow[C_GQ + h * 128 + tid]); kv[tid] = bf2f(hrow[C_GK + h * 128 + tid]);
    }
    if (tid < 256) vv[tid] = bf2f(hrow[C_GV + h * 256 + tid]);
    __syncthreads();
    const float* S0 = sin_ + (size_t)(b * 4 + h) * 128 * 256;
    float* S1 = sout + (size_t)(b * 4 + h) * 128 * 256;
    const f32x4 v4 = *(const f32x4*)(vv + lane * 4);
    f32x4 oacc = {0.f, 0.f, 0.f, 0.f};
    f32x4 srow[16];
#pragma unroll
    for (int r = 0; r < 16; ++r) srow[r] = *(const f32x4*)(S0 + (16 * w + r) * 256 + lane * 4);
#pragma unroll
    for (int r = 0; r < 16; ++r) {
        const int dk = 16 * w + r;
        const f32x4 sv = srow[r] * gE[dk] + v4 * kv[dk];
        *(f32x4*)(S1 + dk * 256 + lane * 4) = sv;
        oacc += sv * qv[dk];
    }
    *(f32x4*)(Osum + w * 256 + lane * 4) = oacc;
    __syncthreads();
    float o = 0.f;
    if (tid < 256) {
#pragma unroll
        for (int ww = 0; ww < 8; ++ww) o += Osum[ww * 256 + tid];
        const float q = wave_sum(o * o);
        if (lane == 0) red[w] = q;
    }
    __syncthreads();
    if (tid < 256) {
        const float rs = __builtin_amdgcn_rsqf((red[0] + red[1] + red[2] + red[3]) * (1.f / 256.f) + EPS);
        const float gate = bf2f(hrow[C_GG + h * 256 + tid]);
        Gt[(size_t)(TP + b) * DM + 2048 + h * 256 + tid] = f2bf(o * rs * gng[h * 256 + tid] * silu(gate));
    }
}
DI void s_mem_unit(unsigned char* lds, const bf16_t* H, bf16_t* Gt, const float* mk, const float* mv, int u, int tid) {
    const int h = u & 3, b = u >> 2;
    float* Sc = (float*)lds; float* Osum = Sc + 256;
    const int lane = tid & 63, w = tid >> 6;
    const bf16_t* hrow = H + (size_t)(TP + b) * NP;
    __syncthreads();
    const u32x2 qw = *(const u32x2*)(hrow + C_MQ + h * 256 + lane * 4);
    const f32x4 q4 = {bflo(qw.x), bfhi(qw.x), bflo(qw.y), bfhi(qw.y)};
    const float* kbase = mk + ((size_t)(b * 256 + w * 32) * 4 + h) * 256 + lane * 4;
    const float* vbase = mv + ((size_t)(b * 256 + w * 32) * 4 + h) * 256 + lane * 4;
    float vals[32];
    {
        f32x4 kr[32];
#pragma unroll
        for (int r = 0; r < 32; ++r) kr[r] = *(const f32x4*)(kbase + (size_t)r * 1024);
#pragma unroll
        for (int r = 0; r < 32; ++r) vals[r] = (q4[0] * kr[r][0] + q4[1] * kr[r][1]) + (q4[2] * kr[r][2] + q4[3] * kr[r][3]);
    }
#pragma unroll
    for (int i = 0; i < 16; ++i) { const bool hi = lane & 32; const float send = hi ? vals[i] : vals[i + 16], keep = hi ? vals[i + 16] : vals[i]; vals[i] = keep + __shfl_xor(send, 32); }
#pragma unroll
    for (int i = 0; i < 8; ++i) { const bool hi = lane & 16; const float send = hi ? vals[i] : vals[i + 8], keep = hi ? vals[i + 8] : vals[i]; vals[i] = keep + __shfl_xor(send, 16); }
#pragma unroll
    for (int i = 0; i < 4; ++i) { const bool hi = lane & 8; const float send = hi ? vals[i] : vals[i + 4], keep = hi ? vals[i + 4] : vals[i]; vals[i] = keep + __shfl_xor(send, 8); }
#pragma unroll
    for (int i = 0; i < 2; ++i) { const bool hi = lane & 4; const float send = hi ? vals[i] : vals[i + 2], keep = hi ? vals[i + 2] : vals[i]; vals[i] = keep + __shfl_xor(send, 4); }
    { const bool hi = lane & 2; const float send = hi ? vals[0] : vals[1], keep = hi ? vals[1] : vals[0]; vals[0] = keep + __shfl_xor(send, 2); }
    vals[0] += __shfl_xor(vals[0], 1);
    if ((lane & 1) == 0) Sc[w * 32 + (lane >> 1)] = vals[0];
    f32x4 vr[32];
#pragma unroll
    for (int r = 0; r < 32; ++r) vr[r] = *(const f32x4*)(vbase + (size_t)r * 1024);
    __syncthreads();
    const f32x4 sv = *(const f32x4*)(Sc + lane * 4);
    const float mx = wave_max(fmaxf(fmaxf(sv[0], sv[1]), fmaxf(sv[2], sv[3])));
    const float inv = __builtin_amdgcn_rcpf(wave_sum((__expf(sv[0] - mx) + __expf(sv[1] - mx)) + (__expf(sv[2] - mx) + __expf(sv[3] - mx))));
    f32x4 oacc = {0.f, 0.f, 0.f, 0.f};
#pragma unroll
    for (int r = 0; r < 32; ++r) oacc += vr[r] * (__expf(Sc[w * 32 + r] - mx) * inv);
    *(f32x4*)(Osum + w * 256 + lane * 4) = oacc;
    __syncthreads();
    if (tid < 256) {
        float o = 0.f;
#pragma unroll
        for (int ww = 0; ww < 8; ++ww) o += Osum[ww * 256 + tid];
        const float gate = bf2f(hrow[C_MG + h * 256 + tid]);
        Gt[(size_t)(TP + b) * DM + 3072 + h * 256 + tid] = f2bf(o * silu(gate));
    }
}

#ifndef MK_ONE_LAUNCH
#define MK_ONE_LAUNCH 1
#endif
constexpr int N_PHASES = 12;
#ifndef PH_MASK
#define PH_MASK 0xFFFF
#endif
#define PHM(b) ((PH_MASK >> (b)) & 1)
#ifndef DUP_PH
#define DUP_PH 0
#endif
#ifndef DUP_SEL
#define DUP_SEL 0
#endif
#ifndef DUP_SYNC
#define DUP_SYNC 0
#endif
#ifndef DUP_P0
#define DUP_P0 0
#endif

__global__ void __launch_bounds__(512, 2) mk_fwd(Args a) {
    extern __shared__ __attribute__((aligned(16))) unsigned char lds[];
    const int G = gridDim.x, bid = blockIdx.x;
    unsigned char* ws = a.ws;
    bf16_t* XN = (bf16_t*)(ws + WS_XN);
    bf16_t* Hb = (bf16_t*)(ws + WS_H);
    bf16_t* Gt = (bf16_t*)(ws + WS_G);
    float* X1 = (float*)(ws + WS_X1);
    float* rope = (float*)(ws + WS_ROPE);
    float* RSq = (float*)(ws + WS_RS);
    const float* x_prompt = a.in[0]; const float* mem_prompt = a.in[1]; const float* x_sample = a.in[2];
    volatile LAS unsigned* bst = (volatile LAS unsigned*)((LAS unsigned char*)lds + (LDS_BYTES - 16));
    if (threadIdx.x < 4) bst[threadIdx.x] = 0u;
    __syncthreads();
    XcdBarrier xbar = xcd_barrier_post((unsigned*)(ws + WS_CTL), bst);
#define GRID_SYNC() xcd_barrier(xbar)

    if (a.ph_lo == 0) {
        int tidp = threadIdx.x; asm volatile("" : "+v"(tidp));
        const int tid = tidp, lane = tid & 63, wave = __builtin_amdgcn_readfirstlane(tid >> 6);
        for (int rep0 = 0; rep0 <= DUP_P0; ++rep0) if (PHM(0)) {
            float* scr = (float*)(lds + wave * 16640);
            const int gw = bid * 8 + wave, NGW = G * 8;
            constexpr int I_IN = 64 * 153, I_OUT = 64 * 64, I_MEM = 64 * 32, I_L = I_IN + I_OUT + I_MEM;
            auto mk_item = [&](int it) {
                TrItem t; const int l = it / I_L; int r = it - l * I_L;
                if (r < I_IN) { t.W = a.in[9] + (size_t)l * DM * NIN; t.WT = (bf16_t*)(ws + WS_WIN + l * SZ_WIN); t.N = NIN; t.item = r; t.inmap = 1; return t; }
                r -= I_IN;
                if (r < I_OUT) { t.W = a.in[16] + (size_t)l * DM * DM; t.WT = (bf16_t*)(ws + WS_WOUT + l * SZ_WOUT); t.N = DM; t.item = r; t.inmap = 0; return t; }
                r -= I_OUT;
                t.W = a.in[15] + (size_t)l * DM * 2048; t.WT = (bf16_t*)(ws + WS_WMEM + l * SZ_WMEM); t.N = 2048; t.item = r; t.inmap = 0; return t;
            };
            {
                int it = gw;
                f32x4 tv[16];
                TrItem cur = mk_item(it < 2 * I_L ? it : 0);
                if (it < 2 * I_L) tr_load(cur, tv, lane);
                while (it < 2 * I_L) {
                    const int nx = it + NGW;
                    f32x4 tn[16]; TrItem nxt = cur;
                    if (nx < 2 * I_L) { nxt = mk_item(nx); tr_load(nxt, tn, lane); }
                    tr_store(cur, tv, scr, lane);
#pragma unroll
                    for (int i = 0; i < 16; ++i) tv[i] = tn[i];
                    cur = nxt; it = nx;
                }
            }
            for (int i = bid * 512 + tid; i < 2 * 240 * 512; i += G * 512) {
                const int l = i / (240 * 512), r = i - l * 240 * 512;
                ((u32x4*)(ws + WS_WIN + l * SZ_WIN + (size_t)NIN * DM * 2))[r] = (u32x4){0u, 0u, 0u, 0u};
            }
            for (int i = bid * 512 + tid; i < 2049 * 32; i += G * 512) rope_entry(rope, i);
            for (int i = bid * 512 + tid; i < 2 * MR; i += G * 512) RSq[i] = 0.f;
            for (int m = gw; m < MREAL + 2048; m += NGW) {
                if (m < TP) norm_row(x_prompt + (size_t)m * DM, a.in[8], XN + (size_t)m * DM, nullptr, lane);
                else if (m < MREAL) norm_row(x_sample + (size_t)(m - TP) * DM, a.in[8], XN + (size_t)m * DM, nullptr, lane);
                else { const int mm = m - MREAL, l = mm >> 10, r = mm & 1023;
                       norm_row(mem_prompt + (size_t)r * DM, a.in[14] + l * DM, (bf16_t*)(ws + WS_MN + l * SZ_MN) + (size_t)r * DM, nullptr, lane); }
            }
        }
        if (a.ph_hi > 1) GRID_SYNC();
        if (a.ph_hi > 1000) cg::this_grid().sync();
    }
    for (int ph = a.ph_lo < 1 ? 1 : a.ph_lo, rep = 0; ph < a.ph_hi; ) {
        int tidp = threadIdx.x; asm volatile("" : "+v"(tidp));
        const int tid = tidp, lane = tid & 63, wave = __builtin_amdgcn_readfirstlane(tid >> 6);
        {
            const int l = (ph - 1) / 6, k = (ph - 1) % 6;
            if (k == 5 && l == 0) { ++ph; continue; }
            if (k == 0) {
                if (PHM(1)) {
                    pg8::Gemm g{XN, (const bf16_t*)(ws + WS_WIN + l * SZ_WIN), TP, NP, DM, (const bf16_t*)(ws + WS_MN + l * SZ_MN), (const bf16_t*)(ws + WS_WMEM + l * SZ_WMEM)};
                    InMemOrder S; S.init(G, bid);
                    EpiInMem E{EpiIn{Hb, rope, a.out + O_KP + (size_t)l * 131072, a.out + O_VP + (size_t)l * 131072, l == 0 ? nullptr : RSq},
                               EpiMem{(bf16_t*)(ws + WS_MKV + l * SZ_MKV), a.out + O_MKP + (size_t)l * 1048576, a.out + O_MVP + (size_t)l * 1048576}};
                    pg8::gemm_phase<EpiInMem, InMemOrder, true, true>((PG8_LAS unsigned char*)lds, g, S, E);
                }
            } else if (k >= 1 && k <= 3) {
                const float* sinks = a.in[10] + l * 32;
                const float* wg = a.in[11] + l * 16 * 512; const float* bg = a.in[12] + l * 512; const float* gng = a.in[13] + l * 1024;
                const bf16_t* MKV = (const bf16_t*)(ws + WS_MKV + l * SZ_MKV);
                u32x2* Ug = (u32x2*)(ws + WS_U); u32x4* SF = (u32x4*)(ws + WS_SF); unsigned char* IMG = ws + WS_IMG; float* EBLg = (float*)(ws + WS_EBL);
                unsigned* qctr = (unsigned*)(ws + WS_CTL) + 8192 + (ph * 2 + rep) * 64;
#define QUEUE_LOOP_BEGIN(NTOT) { int u = bid; while (u < (NTOT)) { unsigned nxt_ = 0u; if (threadIdx.x == 0) nxt_ = atomicAdd(qctr, 1u) + (unsigned)G;
#define QUEUE_LOOP_END() __syncthreads(); if (threadIdx.x == 0) bst[2] = nxt_; __syncthreads(); u = (int)bst[2]; } }
                if (k == 1) {
                    EpiInS ES{Hb, rope, a.out + O_KS + (size_t)l * 1048576, a.out + O_VS + (size_t)l * 1048576, l == 0 ? nullptr : RSq};
                    QUEUE_LOOP_BEGIN(256 + 512 + NP / 32)
                        int tid = tidp; asm volatile("" : "+v"(tid));
                        if (u < 256) { if (PHM(4)) mem_unit(lds, Hb, MKV, Gt, u, tid); }
                        else if (u < 768) { if (PHM(3)) gla_prep_unit(lds, Hb, wg, bg, Ug, EBLg, IMG, u - 256, tid); }
                        else skinny_task<EpiInS>(lds, XN + (size_t)TP * DM, (const bf16_t*)(ws + WS_WIN + l * SZ_WIN), u - 768, tid, ES);
                    QUEUE_LOOP_END()
                } else if (k == 2) {
                    const bool dsel = (DUP_SEL != 0 && rep == 1 && ph == DUP_PH);
                    if (PHM(3) && (!dsel || DUP_SEL == 5)) { for (int tt = bid * 8 + wave; tt < 2048; tt += G * 8) gla_scan_task(Ug, EBLg, (u32x2*)SF, a.out + O_SP + (size_t)l * 524288, tt, lane); }
                    QUEUE_LOOP_BEGIN(256 + 384)
                        int tid = tidp; asm volatile("" : "+v"(tid));
                        const int utype = u < 256 ? 1 : (u < 384 ? 2 : (u < 512 ? 3 : 4));
                        if (dsel && utype != DUP_SEL) {}
                        else if (u < 256) { if (PHM(5)) swa_unit(lds, Hb, Gt, sinks, u, tid); }
                        else if (!PHM(6)) {}
                        else if (u < 384) s_mem_unit(lds, Hb, Gt, a.in[6] + (size_t)l * 8388608, a.in[7] + (size_t)l * 8388608, u - 256, tid);
                        else if (u < 512) s_gla_unit(lds, Hb, Gt, wg, bg, gng, a.in[5] + (size_t)l * 4194304, a.out + O_SS + (size_t)l * 4194304, u - 384, tid);
                        else s_swa_unit(lds, Hb, Gt, a.in[3] + (size_t)l * 1048576, a.in[4] + (size_t)l * 1048576, sinks, a.out + O_KS + (size_t)l * 1048576, a.out + O_VS + (size_t)l * 1048576, u - 512, tid);
                    QUEUE_LOOP_END()
                } else {
                    EpiResS ES{l == 0 ? x_sample : X1 + (size_t)TP * DM, (l == 0 ? X1 : a.out) + (size_t)TP * DM, l == 0 ? a.in[8] + DM : a.in[17], XN, RSq + l * MR, l};
                    QUEUE_LOOP_BEGIN(512 + DM / 32)
                        int tid = tidp; asm volatile("" : "+v"(tid));
                        if (u < 512) { if (PHM(3)) gla_out_unit(lds, Hb, Gt, gng, SF, IMG, u, tid); }
                        else skinny_task<EpiResS>(lds, Gt + (size_t)TP * DM, (const bf16_t*)(ws + WS_WOUT + l * SZ_WOUT), u - 512, tid, ES);
                    QUEUE_LOOP_END()
                }
                __syncthreads();
            } else if (k == 4) { if (PHM(7)) {
                pg8::Gemm g{Gt, (const bf16_t*)(ws + WS_WOUT + l * SZ_WOUT), TP, DM, DM, nullptr, nullptr};
                PanelOrder S; S.init(G, bid);
                if (l == 0) {
                    EpiRes E{x_prompt, nullptr, a.in[8] + DM, XN, RSq, 0};
                    pg8::gemm_phase<EpiRes, PanelOrder, true, true>((PG8_LAS unsigned char*)lds, g, S, E);
                } else {
                    if (bid < TS) {
                        const int row = TP + bid;
                        const float rs = __builtin_amdgcn_rsqf(RSq[MR + row] * (1.f / DM) + EPS);
                        f32x4* yr = (f32x4*)(a.out + (size_t)row * DM);
                        const f32x4 y0 = yr[tid], y1 = yr[tid + 512];
                        yr[tid] = y0 * rs; yr[tid + 512] = y1 * rs;
                    }
                    EpiFin E{XN, a.in[8] + DM, a.out, a.in[17], RSq + MR, (unsigned*)(ws + WS_CTL) + 4096};
                    pg8::gemm_phase<EpiFin, PanelOrder, true, true>((PG8_LAS unsigned char*)lds, g, S, E);
                }
            } } else if (PHM(8)) {
                const int gw = bid * 8 + wave, NGW = G * 8;
                for (int m = gw; m < MREAL; m += NGW) {
                    if (l == 0) norm_row(X1 + (size_t)m * DM, a.in[8] + DM, XN + (size_t)m * DM, nullptr, lane);
                    else {
                        const float rs = __builtin_amdgcn_rsqf(RSq[MR + m] * (1.f / DM) + EPS);
                        f32x4* yr = (f32x4*)(a.out + (size_t)m * DM) + lane;
                        f32x4 yv[16];
#pragma unroll
                        for (int j = 0; j < 16; ++j) yv[j] = yr[64 * j];
#pragma unroll
                        for (int j = 0; j < 16; ++j) yr[64 * j] = yv[j] * rs;
                    }
                }
            }
        }
        if (ph + 1 < a.ph_hi) { GRID_SYNC(); if (DUP_SYNC) { GRID_SYNC(); } }
        if (DUP_PH != 0 && ph == DUP_PH && rep == 0) rep = 1; else ++ph;
    }
}

extern "C" void kernel_launch(void* const* d_in, const int* in_sizes, int n_in, void* d_out, int out_size, void* d_ws, size_t ws_size, hipStream_t stream) {
    static int grid = 0;
    if (grid == 0) {
        if (n_in != 18 || (size_t)out_size != O_END || ws_size < WS_END) { fprintf(stderr, "kernel_launch: unexpected shapes (n_in %d, out %d, ws %zu); nothing launched\n", n_in, out_size, ws_size); grid = -1; return; }
        int dev = 0, cus = 0, per_cu = 0;
        if (hipGetDevice(&dev) != hipSuccess || hipDeviceGetAttribute(&cus, hipDeviceAttributeMultiprocessorCount, dev) != hipSuccess) { grid = -1; return; }
        if (hipFuncSetAttribute((const void*)mk_fwd, hipFuncAttributeMaxDynamicSharedMemorySize, LDS_BYTES) != hipSuccess) { fprintf(stderr, "kernel_launch: hipFuncSetAttribute failed\n"); grid = -1; return; }
        if (hipOccupancyMaxActiveBlocksPerMultiprocessor(&per_cu, (const void*)mk_fwd, 512, LDS_BYTES) != hipSuccess || per_cu < 1) { fprintf(stderr, "kernel_launch: occupancy query says %d\n", per_cu); per_cu = 1; }
        (void)hipGetLastError();
        grid = cus * per_cu;
    }
    if (grid < 0) return;
    if (hipMemsetAsync((char*)d_ws + WS_CTL, 0, CTL_BYTES, stream) != hipSuccess) { fprintf(stderr, "kernel_launch: memset failed\n"); return; }
    Args a{};
    for (int i = 0; i < 18; ++i) a.in[i] = (const float*)d_in[i];
    a.out = (float*)d_out; a.ws = (unsigned char*)d_ws;
#if MK_ONE_LAUNCH
    a.ph_lo = 0; a.ph_hi = N_PHASES;
    void* args[] = {&a};
    hipError_t e = hipLaunchCooperativeKernel((const void*)mk_fwd, dim3(grid), dim3(512), args, LDS_BYTES, stream);
    if (e != hipSuccess) fprintf(stderr, "kernel_launch: cooperative launch failed: %s (grid %d)\n", hipGetErrorString(e), grid);
#else
    for (int ph = 0; ph < N_PHASES; ++ph) {
        a.ph_lo = ph; a.ph_hi = ph + 1;
        hipLaunchKernelGGL(mk_fwd, dim3(grid), dim3(512), LDS_BYTES, stream, a);
    }
#endif
}
```

```cpp
#include <hip/hip_runtime.h>
#include <hip/hip_cooperative_groups.h>
#include <cstdio>
#include <cstdint>
namespace cg = cooperative_groups;
#define MK_ONE_LAUNCH 1
namespace pg8 {
#define PG8_LAS __attribute__((address_space(3)))
typedef unsigned short bf16_t;
typedef short bf16x8 __attribute__((ext_vector_type(8)));
typedef float f32x4 __attribute__((ext_vector_type(4)));
typedef unsigned u32x4 __attribute__((ext_vector_type(4)));
constexpr int BM = 256, BK = 64, HALF = 128, HTB = HALF * BK * 2  , STAGE_BYTES = 8 * HTB, NXCD = 8, WGM = 8;

__host__ __device__ __forceinline__ int lds_byte(int r, int c) { const int st = (r >> 4) * 2 + (c >> 5), rr = r & 15, cc = c & 31, ob = rr * 64 + cc * 2; return st * 1024 + (ob ^ (((ob >> 9) & 1) << 5)); }
__host__ __device__ __forceinline__ void stage_rc(int b, int& R, int& C) { const int st = b / 1024, sb = b % 1024, swz = sb ^ (((sb >> 9) & 1) << 5); R = (st >> 1) * 16 + swz / 64; C = (st & 1) * 32 + (swz % 64) / 2; }
__host__ __device__ __forceinline__ int perm32(int rho) { const int n = rho >> 4, i = rho & 15; return 8 * (i >> 2) + 4 * n + (i & 3); }

struct Unit { int pm, pn, sel; };
struct Gemm { const bf16_t* A; const bf16_t* Bt; int M, N, K; const bf16_t* A2; const bf16_t* Bt2; };

struct StaticOrder {
    int nM, nN, nwg, G, c;
    __host__ __device__ void init(int M, int N, int G_, int c_) { nM = M / BM; nN = N / BM; nwg = nM * nN; G = G_; c = c_; }
    __host__ __device__ bool next(int i, Unit& u) const {
        const long L = (long)i * G + c; if (L >= nwg) return false;
        int wgid = (int)L; { const int q = nwg / NXCD, r = nwg % NXCD, xcd = wgid % NXCD, off = wgid / NXCD; wgid = (xcd < r ? xcd * (q + 1) : r * (q + 1) + (xcd - r) * q) + off; }
        const int nig = WGM * nN, gid = wgid / nig, fm = gid * WGM, gsz = (nM - fm) < WGM ? (nM - fm) : WGM;
        u.pm = fm + ((wgid % nig) % gsz); u.pn = (wgid % nig) / gsz; u.sel = 0; return true;
    }
    __device__ __forceinline__ void a_ready(const Unit&) const {}
    __device__ __forceinline__ void done(const Unit&) const {}
};

__device__ __forceinline__ unsigned cvt_pk_bf16(float lo, float hi) { unsigned r; asm volatile("v_cvt_pk_bf16_f32 %0, %1, %2" : "=v"(r) : "v"(lo), "v"(hi)); return r; }
typedef float f32x2 __attribute__((ext_vector_type(2)));
template <class Epi, class Sched, bool ALIGN_EPI = false, bool SP2 = false>
__device__ __forceinline__ void gemm_phase(PG8_LAS unsigned char* lds, const Gemm g, const Sched& S, const Epi& E) {
    int tid_ = threadIdx.x; asm volatile("" : "+v"(tid_));
    const int tid = tid_, wid = __builtin_amdgcn_readfirstlane(tid >> 6), lane = tid & 63, wr = wid >> 2, wc = wid & 3, fr = lane & 15, fq = lane >> 4;
    const int K = g.K, nt = K / BK;
    unsigned voffA[2], voffB[2];
#pragma unroll
    for (int i = 0; i < 2; ++i) { int R, C; stage_rc(tid * 16 + i * 8192, R, C); const int Rb = Epi::PERM ? ((R & ~31) + perm32(R & 31)) : R;
        voffA[i] = (unsigned)(R * K + C) * 2u; voffB[i] = (unsigned)(Rb * K + C) * 2u; }
    const size_t kstep = (size_t)(BK * 2);
    const size_t hstep = (size_t)HALF * K * 2;
    const size_t tstep = 2 * hstep;
    const unsigned ldsw = (unsigned)wid * 1024u;
    const int aoff = lds_byte(wr * 64 + fr, fq * 8), boff = lds_byte(wc * 32 + fr, fq * 8);
#define PG8_SA(b, h) (((b) * 2 + (h)) * HTB)
#define PG8_SB(b, h) ((4 + (b) * 2 + (h)) * HTB)
#define PG8_STAGE(bufoff, gbase, voff) do { _Pragma("unroll") for (int _i = 0; _i < 2; ++_i) \
        __builtin_amdgcn_global_load_lds((const unsigned*)((const char*)(gbase) + (voff)[_i]), (PG8_LAS unsigned*)(lds + (bufoff) + ldsw + _i * 8192), 16, 0, 0); } while (0)
#define PG8_LDA(dst, b, h) do { _Pragma("unroll") for (int m = 0; m < 4; ++m) _Pragma("unroll") for (int k = 0; k < 2; ++k) dst[m][k] = *(const PG8_LAS bf16x8*)(lds + PG8_SA(b, h) + aoff + m * 2048 + k * 1024); } while (0)
#define PG8_LDB(dst, b, h) do { _Pragma("unroll") for (int n = 0; n < 2; ++n) _Pragma("unroll") for (int k = 0; k < 2; ++k) dst[n][k] = *(const PG8_LAS bf16x8*)(lds + PG8_SB(b, h) + boff + n * 2048 + k * 1024); } while (0)
#define PG8_MMA(ai, bj, At, Bt) do { __builtin_amdgcn_s_setprio(1); _Pragma("unroll") for (int m = 0; m < 4; ++m) _Pragma("unroll") for (int n = 0; n < 2; ++n) _Pragma("unroll") for (int k = 0; k < 2; ++k) \
        acc[ai][bj][m][n] = __builtin_amdgcn_mfma_f32_16x16x32_bf16(Bt[n][k], At[m][k], acc[ai][bj][m][n], 0, 0, 0); __builtin_amdgcn_s_setprio(0); } while (0)
#define PG8_WAIT_V(n) asm volatile("s_waitcnt vmcnt(" #n ")" ::: "memory")
#define PG8_WAIT_L(n) asm volatile("s_waitcnt lgkmcnt(" #n ")" ::: "memory")
#define PG8_BAR __builtin_amdgcn_s_barrier()
#define PG8_SCHED __builtin_amdgcn_sched_barrier(0)
    Unit cur, nxt; int ui = 0;
    if (!S.next(0, cur)) return;
    f32x4 acc[2][2][4][2];
#pragma unroll
    for (int a = 0; a < 2; ++a)
#pragma unroll
        for (int b = 0; b < 2; ++b)
#pragma unroll
            for (int m = 0; m < 4; ++m)
#pragma unroll
                for (int n = 0; n < 2; ++n) acc[a][b][m][n] = (f32x4){0.f, 0.f, 0.f, 0.f};
    bf16x8 At[4][2], B0[2][2], B1[2][2];
    const char* cA = (const char*)(cur.sel ? g.A2 : g.A) + (size_t)cur.pm * tstep; const char* cB = (const char*)(cur.sel ? g.Bt2 : g.Bt) + (size_t)cur.pn * tstep;
    S.a_ready(cur);
    if constexpr (SP2) {
        PG8_STAGE(PG8_SB(0, 0), cB, voffB); PG8_STAGE(PG8_SB(0, 1), cB + hstep, voffB); PG8_STAGE(PG8_SA(0, 0), cA, voffA); PG8_STAGE(PG8_SA(0, 1), cA + hstep, voffA);
        if (wr == 1) PG8_BAR;
        PG8_WAIT_V(2); PG8_BAR;
        PG8_STAGE(PG8_SB(1, 0), cB + kstep, voffB); PG8_STAGE(PG8_SA(1, 0), cA + kstep, voffA); PG8_STAGE(PG8_SB(1, 1), cB + hstep + kstep, voffB);
        PG8_WAIT_V(6); PG8_BAR;
    } else {
        PG8_STAGE(PG8_SB(0, 0), cB, voffB); PG8_STAGE(PG8_SA(0, 0), cA, voffA); PG8_STAGE(PG8_SB(0, 1), cB + hstep, voffB); PG8_STAGE(PG8_SA(0, 1), cA + hstep, voffA);
        if (wr == 1) PG8_BAR;
        PG8_WAIT_V(4); PG8_BAR;
        PG8_STAGE(PG8_SB(1, 0), cB + kstep, voffB); PG8_STAGE(PG8_SA(1, 0), cA + kstep, voffA); PG8_STAGE(PG8_SB(1, 1), cB + hstep + kstep, voffB);
        PG8_WAIT_V(6); PG8_BAR;
    }
    for (;;) {
        const bool has_next = S.next(ui + 1, nxt);
        const char* nA = has_next ? (const char*)(nxt.sel ? g.A2 : g.A) + (size_t)nxt.pm * tstep : cA; const char* nB = has_next ? (const char*)(nxt.sel ? g.Bt2 : g.Bt) + (size_t)nxt.pn * tstep : cB;
        for (int t = 0; t < nt; t += 2) {
            const bool last = (t == nt - 2);
            const char* a1 = cA + (size_t)(t + 1) * kstep;
            const char* a2 = last ? nA : cA + (size_t)(t + 2) * kstep; const char* b2 = last ? nB : cB + (size_t)(t + 2) * kstep;
            const char* a3 = a2 + kstep; const char* b3 = b2 + kstep;
            if (last && has_next) S.a_ready(nxt);
            if constexpr (SP2) {
            PG8_LDB(B0, 0, 0); PG8_LDB(B1, 0, 1); PG8_SCHED; PG8_LDA(At, 0, 0); PG8_STAGE(PG8_SA(1, 1), a1 + hstep, voffA);
            PG8_WAIT_V(8); PG8_WAIT_L(0); PG8_BAR; PG8_MMA(0, 0, At, B0); PG8_MMA(0, 1, At, B1); PG8_BAR; PG8_SCHED;
            PG8_LDA(At, 0, 1); PG8_STAGE(PG8_SB(0, 0), b2, voffB); PG8_STAGE(PG8_SB(0, 1), b2 + hstep, voffB); PG8_STAGE(PG8_SA(0, 0), a2, voffA);
            PG8_WAIT_V(8); PG8_WAIT_L(0); PG8_BAR; PG8_MMA(1, 0, At, B0); PG8_MMA(1, 1, At, B1); PG8_BAR; PG8_SCHED;
            PG8_LDB(B0, 1, 0); PG8_LDB(B1, 1, 1); PG8_SCHED; PG8_LDA(At, 1, 0); PG8_STAGE(PG8_SA(0, 1), a2 + hstep, voffA);
            PG8_WAIT_V(8); PG8_WAIT_L(0); PG8_BAR; PG8_MMA(0, 0, At, B0); PG8_MMA(0, 1, At, B1); PG8_BAR; PG8_SCHED;
            PG8_LDA(At, 1, 1); PG8_STAGE(PG8_SB(1, 0), b3, voffB); PG8_STAGE(PG8_SB(1, 1), b3 + hstep, voffB); PG8_STAGE(PG8_SA(1, 0), a3, voffA);
            PG8_WAIT_V(8); PG8_WAIT_L(0); PG8_BAR; PG8_MMA(1, 0, At, B0); PG8_MMA(1, 1, At, B1); PG8_BAR; PG8_SCHED;
            } else {
            PG8_LDB(B0, 0, 0); PG8_SCHED; PG8_LDA(At, 0, 0); PG8_STAGE(PG8_SA(1, 1), a1 + hstep, voffA);
            PG8_WAIT_L(8); PG8_BAR; PG8_WAIT_L(0); PG8_MMA(0, 0, At, B0); PG8_BAR; PG8_SCHED;
            PG8_LDB(B1, 0, 1); PG8_STAGE(PG8_SB(0, 0), b2, voffB);
            PG8_BAR; PG8_WAIT_L(0); PG8_MMA(0, 1, At, B1); PG8_BAR;
            PG8_LDA(At, 0, 1); PG8_STAGE(PG8_SA(0, 0), a2, voffA);
            PG8_BAR; PG8_WAIT_L(0); PG8_MMA(1, 0, At, B0); PG8_BAR; PG8_SCHED;
            PG8_STAGE(PG8_SB(0, 1), b2 + hstep, voffB);
            PG8_WAIT_V(6); PG8_BAR; PG8_MMA(1, 1, At, B1); PG8_BAR;
            PG8_LDB(B0, 1, 0); PG8_SCHED; PG8_LDA(At, 1, 0); PG8_STAGE(PG8_SA(0, 1), a2 + hstep, voffA);
            PG8_WAIT_L(8); PG8_BAR; PG8_WAIT_L(0); PG8_MMA(0, 0, At, B0); PG8_BAR; PG8_SCHED;
            PG8_LDB(B1, 1, 1); PG8_STAGE(PG8_SB(1, 0), b3, voffB);
            PG8_BAR; PG8_WAIT_L(0); PG8_MMA(0, 1, At, B1); PG8_BAR;
            PG8_LDA(At, 1, 1); PG8_STAGE(PG8_SA(1, 0), a3, voffA);
            PG8_BAR; PG8_WAIT_L(0); PG8_MMA(1, 0, At, B0); PG8_BAR; PG8_SCHED;
            PG8_STAGE(PG8_SB(1, 1), b3 + hstep, voffB);
            PG8_WAIT_V(6); PG8_BAR; PG8_MMA(1, 1, At, B1); PG8_BAR;
            }
        }
        if constexpr (ALIGN_EPI) { if (wr == 0) PG8_BAR; }
        if constexpr (!Epi::AFTER_DRAIN) { E(acc, cur, wr, wc, fr, fq); S.done(cur); }
        if (!has_next) break;
#pragma unroll
        for (int a = 0; a < 2; ++a)
#pragma unroll
            for (int b = 0; b < 2; ++b)
#pragma unroll
                for (int m = 0; m < 4; ++m)
#pragma unroll
                    for (int n = 0; n < 2; ++n) acc[a][b][m][n] = (f32x4){0.f, 0.f, 0.f, 0.f};
        cur = nxt; cA = nA; cB = nB; ++ui;
        if constexpr (ALIGN_EPI) { if (wr == 1) PG8_BAR; }
    }
    PG8_WAIT_V(0);
    if constexpr (!ALIGN_EPI) { if (wr == 0) PG8_BAR; }
    PG8_BAR;
    if constexpr (Epi::AFTER_DRAIN) { E.fused(acc, cur, wr, wc, fr, fq, lds, wid, lane); S.done(cur); }
#undef PG8_SA
#undef PG8_SB
#undef PG8_STAGE
#undef PG8_LDA
#undef PG8_LDB
#undef PG8_MMA
#undef PG8_WAIT_V
#undef PG8_WAIT_L
#undef PG8_BAR
#undef PG8_SCHED
}
}
#define LAS __attribute__((address_space(3)))
#define XB_TMO      128
#define XB_XCNT(j)  (256  + 64 * (j))
#define XB_XSUB(j)  (1280 + 64 * (j))
#define XB_XGEN(j)  (2304 + 64 * (j))
#define XB_TOP      3328
#define XB_TOPGEN   3392
#define XCD_BAR_WORDS 3456
#define XB_SPIN_CAP (1u << 18)

__device__ __forceinline__ unsigned xb_ld(unsigned* p)              { return __hip_atomic_load(p, __ATOMIC_RELAXED, __HIP_MEMORY_SCOPE_AGENT); }
__device__ __forceinline__ unsigned xb_add(unsigned* p, unsigned v) { return __hip_atomic_fetch_add(p, v, __ATOMIC_RELAXED, __HIP_MEMORY_SCOPE_AGENT); }
__device__ __forceinline__ unsigned xb_xcc_id() { return (unsigned)__builtin_amdgcn_s_getreg((3 << 11) | 20) & 0xFu; }
#define XB_SPIN(cond, bar) do { unsigned _sp = 0; while (cond) { __builtin_amdgcn_s_sleep(1); \
    if ((++_sp & 255u) == 0u) { if (xb_ld(&(bar)[XB_TMO])) break; if (_sp > XB_SPIN_CAP) { atomicAdd(&(bar)[XB_TMO], 1u); break; } } } } while (0)

struct XcdBarrier {
    unsigned* bar; unsigned x;
    volatile LAS unsigned* st;
};

__device__ __forceinline__ XcdBarrier xcd_barrier_post(unsigned* bar, volatile LAS unsigned* st) {
    XcdBarrier b; b.bar = bar; b.x = xb_xcc_id(); b.st = st;
    if (threadIdx.x == 0) (void)xb_add(&bar[XB_XCNT(b.x)], 1u);
    return b;
}
__device__ __forceinline__ void xcd_barrier_complete(unsigned* bar, unsigned x, unsigned& nloc, unsigned& nx) {
    const unsigned G = gridDim.x * gridDim.y * gridDim.z;
    unsigned sum, cnt, mine, sp = 0u;
    for (;;) {
        sum = 0u; cnt = 0u; mine = 0u;
#pragma unroll
        for (unsigned j = 0; j < 16; ++j) { const unsigned c = xb_ld(&bar[XB_XCNT(j)]); sum += c; cnt += (c > 0u) ? 1u : 0u; mine = (j == x) ? c : mine; }
        if (sum == G) break;
        __builtin_amdgcn_s_sleep(1);
        if ((++sp & 255u) == 0u) { if (xb_ld(&bar[XB_TMO])) break; if (sp > XB_SPIN_CAP) { atomicAdd(&bar[XB_TMO], 1u); break; } }
    }
    nloc = mine > 0u ? mine : 1u; nx = cnt > 0u ? cnt : 1u;
}

__device__ __forceinline__ void xcd_barrier(const XcdBarrier& b) {
    asm volatile("s_waitcnt vmcnt(0)" ::: "memory");
    __syncthreads();
    if (threadIdx.x == 0) {
        unsigned* bar = b.bar;
        __builtin_amdgcn_s_waitcnt(0);
        unsigned nloc = b.st[0], nx = b.st[1];
        if (nloc == 0u) { xcd_barrier_complete(bar, b.x, nloc, nx); b.st[0] = nloc; b.st[1] = nx; }
        const unsigned old = xb_add(&bar[XB_XSUB(b.x)], 1u);
        const unsigned gen = old / nloc;
        if (old + 1u == (gen + 1u) * nloc) {
            __builtin_amdgcn_fence(__ATOMIC_RELEASE, "agent");
            asm volatile("s_waitcnt vmcnt(0)" ::: "memory");
            const unsigned og = xb_add(&bar[XB_TOP], 1u);
            const unsigned tg = og / nx;
            if (og + 1u == (tg + 1u) * nx) xb_add(&bar[XB_TOPGEN], 1u);
            else XB_SPIN(xb_ld(&bar[XB_TOPGEN]) == tg, bar);
            __builtin_amdgcn_fence(__ATOMIC_ACQUIRE, "agent");
            xb_add(&bar[XB_XGEN(b.x)], 1u);
            asm volatile("s_waitcnt vmcnt(0)" ::: "memory");
        } else {
            XB_SPIN(xb_ld(&bar[XB_XGEN(b.x)]) == gen, bar);
            __builtin_amdgcn_fence(__ATOMIC_ACQUIRE, "agent");
            asm volatile("s_waitcnt vmcnt(0)" ::: "memory");
        }
    }
    __syncthreads();
}

#define DI __device__ __forceinline__
typedef unsigned short bf16_t;
typedef short bf16x8 __attribute__((ext_vector_type(8)));
typedef short s16x4 __attribute__((ext_vector_type(4)));
typedef float f32x4 __attribute__((ext_vector_type(4)));
typedef unsigned u32x4 __attribute__((ext_vector_type(4)));
typedef unsigned u32x2 __attribute__((ext_vector_type(2)));
typedef float f32x2_t __attribute__((ext_vector_type(2)));
typedef __bf16 bf16x2_t __attribute__((ext_vector_type(2)));

constexpr int DM = 4096, TP = 8192, SEQ = 2048, NBATCH = 4, TS = 32, MR = 8448, MREAL = 8224, NP = 9984, NIN = 9744;
constexpr int C_SQ = 0, C_SK = 2048, C_SV = 2304, C_SG = 2560, C_GQ = 4608, C_GK = 5120, C_GV = 5632, C_GG = 6656, C_MQ = 7680, C_MG = 8704, C_LR = 9728;
constexpr float EPS = 1e-6f;
constexpr size_t O_YP = 0, O_YS = 33554432, O_KP = 33685504, O_VP = 33947648, O_SP = 34209792, O_MKP = 35258368, O_MVP = 37355520, O_KS = 39452672, O_VS = 41549824, O_SS = 43646976, O_END = 52035584;
constexpr size_t MiB = 1u << 20;
constexpr size_t WS_WIN = 0;
constexpr size_t SZ_WIN = (size_t)NP * DM * 2;
constexpr size_t WS_WOUT = 160 * MiB;
constexpr size_t SZ_WOUT = (size_t)DM * DM * 2;
constexpr size_t WS_WMEM = 224 * MiB;
constexpr size_t SZ_WMEM = (size_t)2048 * DM * 2;
constexpr size_t WS_XN = 256 * MiB;
constexpr size_t WS_MN = 324 * MiB;
constexpr size_t SZ_MN = (size_t)1024 * DM * 2;
constexpr size_t WS_H = 340 * MiB;
constexpr size_t WS_MKV = 502 * MiB;
constexpr size_t SZ_MKV = (size_t)1024 * 2048 * 2;
constexpr size_t WS_G = 510 * MiB;
constexpr size_t WS_X1 = 576 * MiB;
constexpr size_t WS_ROPE = 708 * MiB;
constexpr size_t WS_U = 710 * MiB;
constexpr size_t WS_SF = 774 * MiB;
constexpr size_t WS_IMG = 806 * MiB;
constexpr size_t WS_EBL = 838 * MiB;
constexpr size_t WS_RS = 838 * MiB + 524288;
constexpr size_t WS_CTL = 839 * MiB;
constexpr size_t CTL_BYTES = 65536;
constexpr size_t WS_END = 840 * MiB;
static_assert(WS_WIN + 2 * SZ_WIN <= WS_WOUT && WS_XN + (size_t)MR * DM * 2 <= WS_MN && WS_H + (size_t)MR * NP * 2 <= WS_MKV && WS_G + (size_t)MR * DM * 2 <= WS_X1 && WS_X1 + (size_t)MR * DM * 4 <= WS_ROPE, "ws map");

constexpr int LDS_BYTES = 147456;

DI float bf2f(unsigned short u) { return __uint_as_float((unsigned)u << 16); }
DI float bflo(unsigned w) { return __uint_as_float(w << 16); }
DI float bfhi(unsigned w) { return __uint_as_float(w & 0xffff0000u); }
DI unsigned pk2(float lo, float hi) { f32x2_t v = {lo, hi}; bf16x2_t b = __builtin_convertvector(v, bf16x2_t); return __builtin_bit_cast(unsigned, b); }
DI unsigned short f2bf(float f) { return (unsigned short)(pk2(f, 0.f) & 0xffffu); }
DI float silu(float x) { return x * __builtin_amdgcn_rcpf(1.f + __expf(-x)); }
DI float wave_sum(float v) {
#pragma unroll
    for (int o = 1; o < 64; o <<= 1) v += __shfl_xor(v, o);
    return v;
}
DI float wave_max(float v) {
#pragma unroll
    for (int o = 1; o < 64; o <<= 1) v = fmaxf(v, __shfl_xor(v, o));
    return v;
}
DI f32x4 mfma16(bf16x8 a, bf16x8 b, f32x4 c) { return __builtin_amdgcn_mfma_f32_16x16x32_bf16(a, b, c, 0, 0, 0); }
DI bf16x8 pack8(f32x4 a, f32x4 b) { u32x4 p; p.x = pk2(a[0], a[1]); p.y = pk2(a[2], a[3]); p.z = pk2(b[0], b[1]); p.w = pk2(b[2], b[3]); return __builtin_bit_cast(bf16x8, p); }
DI bf16x8 cat4(s16x4 lo, s16x4 hi) { return __builtin_shufflevector(lo, hi, 0, 1, 2, 3, 4, 5, 6, 7); }

struct Args {
    const float* in[18]; float* out; unsigned char* ws; int ph_lo, ph_hi;
};

struct EpiIn {
    static constexpr bool PERM = true, AFTER_DRAIN = false;
    bf16_t* H; const float* rope; float* kp; float* vp; const float* RSin;
    DI void operator()(const f32x4 (&acc)[2][2][4][2], const pg8::Unit& u, int wr, int wc, int fr, int fq) const {
        const int pn = u.pn;
        const bool do_rope = pn < 9;
        float sc = 1.f;
        if (pn < 8) sc = 0.125f; else if (pn == 18 || pn == 19) sc = 0.08838834764831845f; else if (pn >= 30 && pn < 34) sc = 0.0625f;
        const int row0 = u.pm * 256 + wr * 64 + fr;
        const int colt = wc * 32 + 8 * fq;
#pragma unroll
        for (int ai = 0; ai < 2; ++ai) {
            f32x4 tr[4][2];
#pragma unroll
            for (int m = 0; m < 4; ++m) {
                tr[m][0] = (f32x4){1.f, 0.f, 1.f, 0.f}; tr[m][1] = (f32x4){1.f, 0.f, 1.f, 0.f};
                if (do_rope) {
                    const f32x4* rp = (const f32x4*)(rope + ((size_t)((row0 + ai * 128 + m * 16) & (SEQ - 1)) * 32 + 16 * (wc & 1) + 4 * fq) * 2);
                    tr[m][0] = rp[0]; tr[m][1] = rp[1];
                }
            }
            float rsv[4];
#pragma unroll
            for (int m = 0; m < 4; ++m) { rsv[m] = sc; if (RSin) rsv[m] = sc * __builtin_amdgcn_rsqf(RSin[row0 + ai * 128 + m * 16] * (1.f / DM) + EPS); }
#pragma unroll
            for (int m = 0; m < 4; ++m) {
                const int row = row0 + ai * 128 + m * 16;
                const f32x4 t0 = tr[m][0], t1 = tr[m][1];
#pragma unroll
                for (int bj = 0; bj < 2; ++bj) {
                    f32x4 v0 = acc[ai][bj][m][0], v1 = acc[ai][bj][m][1];
                    if (do_rope) {
                        float a, b;
                        a = v0[0]; b = v0[1]; v0[0] = a * t0[0] - b * t0[1]; v0[1] = b * t0[0] + a * t0[1];
                        a = v0[2]; b = v0[3]; v0[2] = a * t0[2] - b * t0[3]; v0[3] = b * t0[2] + a * t0[3];
                        a = v1[0]; b = v1[1]; v1[0] = a * t1[0] - b * t1[1]; v1[1] = b * t1[0] + a * t1[1];
                        a = v1[2]; b = v1[3]; v1[2] = a * t1[2] - b * t1[3]; v1[3] = b * t1[2] + a * t1[3];
                    }
                    v0 = v0 * rsv[m]; v1 = v1 * rsv[m];
                    u32x4 w4; w4.x = pk2(v0[0], v0[1]); w4.y = pk2(v0[2], v0[3]); w4.z = pk2(v1[0], v1[1]); w4.w = pk2(v1[2], v1[3]);
                    if (pn * 256 + bj * 128 + colt < NIN) *(u32x4*)(H + (size_t)row * NP + pn * 256 + bj * 128 + colt) = w4;
                    if (pn == 8 || pn == 9) {
                        const int t = row & (SEQ - 1);
                        if (t >= SEQ - 128) {
                            const int kvh = bj * 2 + (wc >> 1);
                            float* dst = (pn == 8 ? kp : vp) + ((size_t)((row >> 11) * 128 + (t - (SEQ - 128))) * 4 + kvh) * 64;
                            if (pn == 8) {
                                const int d0 = 16 * (wc & 1) + 4 * fq;
                                *(f32x4*)(dst + d0) = (f32x4){v0[0], v0[2], v1[0], v1[2]};
                                *(f32x4*)(dst + d0 + 32) = (f32x4){v0[1], v0[3], v1[1], v1[3]};
                            } else {
                                const int p0 = 32 * (wc & 1) + 8 * fq;
                                *(f32x4*)(dst + p0) = v0; *(f32x4*)(dst + p0 + 4) = v1;
                            }
                        }
                    }
                }
            }
        }
    }
};
struct EpiInS {
    bf16_t* H; const float* rope; float* ks; float* vs; const float* RSin;
    DI void operator()(f32x4 v, int m, int n) const {
        const int pn = n >> 8;
        if (pn < 9) {
            const f32x4 t = *(const f32x4*)(rope + ((size_t)SEQ * 32 + ((n & 63) >> 1)) * 2);
            float a, b;
            a = v[0]; b = v[1]; v[0] = a * t[0] - b * t[1]; v[1] = b * t[0] + a * t[1];
            a = v[2]; b = v[3]; v[2] = a * t[2] - b * t[3]; v[3] = b * t[2] + a * t[3];
        }
        float sc = 1.f;
        if (pn < 8) sc = 0.125f; else if (pn == 18 || pn == 19) sc = 0.08838834764831845f; else if (pn >= 30 && pn < 34) sc = 0.0625f;
        if (RSin) sc *= __builtin_amdgcn_rsqf(RSin[TP + m] * (1.f / DM) + EPS);
        v = v * sc;
        u32x2 w2; w2.x = pk2(v[0], v[1]); w2.y = pk2(v[2], v[3]);
        *(u32x2*)(H + (size_t)(TP + m) * NP + n) = w2;
        if (pn == 8) {
            float* dst = ks + ((size_t)(m * 128 + 127) * 4 + ((n - C_SK) >> 6)) * 64; const int d0 = (n & 63) >> 1;
            dst[d0] = v[0]; dst[d0 + 32] = v[1]; dst[d0 + 1] = v[2]; dst[d0 + 33] = v[3];
        } else if (pn == 9) {
            float* dst = vs + ((size_t)(m * 128 + 127) * 4 + ((n - C_SV) >> 6)) * 64 + (n & 63);
            *(f32x4*)dst = v;
        }
    }
};
struct EpiResS {
    const float* base; float* X; const float* gnext; bf16_t* XNo; float* RS; int fin;
    DI void operator()(f32x4 v, int m, int n) const {
        const f32x4 x = *(const f32x4*)(base + (size_t)m * DM + n) + v;
        if (!fin) *(f32x4*)(X + (size_t)m * DM + n) = x;
        if (gnext) {
            const f32x4 y = x * *(const f32x4*)(gnext + n);
            if (fin) *(f32x4*)(X + (size_t)m * DM + n) = y;
            else { u32x2 w2; w2.x = pk2(y[0], y[1]); w2.y = pk2(y[2], y[3]); *(u32x2*)(XNo + (size_t)(TP + m) * DM + n) = w2; }
            float q = (x[0] * x[0] + x[1] * x[1]) + (x[2] * x[2] + x[3] * x[3]);
            q += __shfl_xor(q, 16); q += __shfl_xor(q, 32);
            if (((n >> 2) & 3) == 0) atomicAdd(RS + TP + m, q);
        }
    }
};
template <class EpiS>
DI void skinny_task(unsigned char* lds, const bf16_t* X, const bf16_t* Wt, int task, int tid, const EpiS& E) {
    const int lane = tid & 63, w = tid >> 6, c16 = lane & 15, quad = lane >> 4;
    const int ntl = w & 1, ksp = w >> 1;
    const int n0 = task * 32 + ntl * 16;
    f32x4 acc0 = {0.f, 0.f, 0.f, 0.f}, acc1 = {0.f, 0.f, 0.f, 0.f};
    const bf16_t* wp = Wt + (size_t)(n0 + c16) * DM + ksp * 1024 + quad * 8;
    const bf16_t* xp0 = X + (size_t)c16 * DM + ksp * 1024 + quad * 8;
    const bf16_t* xp1 = xp0 + 16 * DM;
    for (int k0 = 0; k0 < 32; k0 += 16) {
        bf16x8 av[16], b0v[16], b1v[16];
#pragma unroll
        for (int j = 0; j < 16; ++j) { av[j] = *(const bf16x8*)(wp + (k0 + j) * 32); b0v[j] = *(const bf16x8*)(xp0 + (k0 + j) * 32); b1v[j] = *(const bf16x8*)(xp1 + (k0 + j) * 32); }
#pragma unroll
        for (int j = 0; j < 16; ++j) { acc0 = mfma16(av[j], b0v[j], acc0); acc1 = mfma16(av[j], b1v[j], acc1); }
    }
    f32x4* red = (f32x4*)lds;
    __syncthreads();
    red[(w * 2 + 0) * 64 + lane] = acc0; red[(w * 2 + 1) * 64 + lane] = acc1;
    __syncthreads();
    if (w < 2) {
#pragma unroll
        for (int mt = 0; mt < 2; ++mt) {
            f32x4 v = red[((0 * 2 + w) * 2 + mt) * 64 + lane];
#pragma unroll
            for (int kp = 1; kp < 4; ++kp) v += red[((kp * 2 + w) * 2 + mt) * 64 + lane];
            E(v, mt * 16 + c16, n0 + quad * 4);
        }
    }
}
struct EpiMem {
    static constexpr bool PERM = true, AFTER_DRAIN = false;
    bf16_t* MKV; float* outk; float* outv;
    DI void operator()(const f32x4 (&acc)[2][2][4][2], const pg8::Unit& u, int wr, int wc, int fr, int fq) const {
        const int row0 = u.pm * 256 + wr * 64 + fr;
#pragma unroll
        for (int ai = 0; ai < 2; ++ai)
#pragma unroll
            for (int m = 0; m < 4; ++m) {
                const int row = row0 + ai * 128 + m * 16;
#pragma unroll
                for (int bj = 0; bj < 2; ++bj) {
                    const int col = u.pn * 256 + bj * 128 + wc * 32 + 8 * fq;
                    const f32x4 v0 = acc[ai][bj][m][0], v1 = acc[ai][bj][m][1];
                    u32x4 w4; w4.x = pk2(v0[0], v0[1]); w4.y = pk2(v0[2], v0[3]); w4.z = pk2(v1[0], v1[1]); w4.w = pk2(v1[2], v1[3]);
                    *(u32x4*)(MKV + (size_t)row * 2048 + col) = w4;
                    float* dst = (col < 1024) ? (outk + (size_t)row * 1024 + col) : (outv + (size_t)row * 1024 + (col - 1024));
                    *(f32x4*)dst = v0; *(f32x4*)(dst + 4) = v1;
                }
            }
    }
};
struct EpiRes {
    static constexpr bool PERM = true, AFTER_DRAIN = false;
    const float* baseP; float* X; const float* gnext; bf16_t* XNo; float* RS; int fin;
    DI void operator()(const f32x4 (&acc)[2][2][4][2], const pg8::Unit& u, int wr, int wc, int fr, int fq) const {
        const int row0 = u.pm * 256 + wr * 64 + fr;
        const int col0 = u.pn * 256 + wc * 32 + 8 * fq;
        f32x4 gv[2][2];
#pragma unroll
        for (int bj = 0; bj < 2; ++bj) { gv[bj][0] = (f32x4){0.f, 0.f, 0.f, 0.f}; gv[bj][1] = gv[bj][0];
            if (gnext) { gv[bj][0] = *(const f32x4*)(gnext + col0 + bj * 128); gv[bj][1] = *(const f32x4*)(gnext + col0 + bj * 128 + 4); } }
#pragma unroll
        for (int am = 0; am < 4; ++am) {
            const int ai = am >> 1, mb = (am & 1) * 2;
            f32x4 bv[2][2][2];
#pragma unroll
            for (int mm = 0; mm < 2; ++mm)
#pragma unroll
                for (int bj = 0; bj < 2; ++bj) {
                    const float* bp = baseP + (size_t)(row0 + ai * 128 + (mb + mm) * 16) * DM + col0 + bj * 128;
                    bv[mm][bj][0] = *(const f32x4*)bp; bv[mm][bj][1] = *(const f32x4*)(bp + 4);
                }
#pragma unroll
            for (int mm = 0; mm < 2; ++mm) {
                const int m = mb + mm;
                const int row = row0 + ai * 128 + m * 16;
                float q = 0.f;
#pragma unroll
                for (int bj = 0; bj < 2; ++bj) {
                    float* xp = X + (size_t)row * DM + col0 + bj * 128;
                    const f32x4 x0 = bv[mm][bj][0] + acc[ai][bj][m][0], x1 = bv[mm][bj][1] + acc[ai][bj][m][1];
                    if (!fin && X) { *(f32x4*)xp = x0; *(f32x4*)(xp + 4) = x1; }
                    if (gnext) {
                        const f32x4 y0 = x0 * gv[bj][0], y1 = x1 * gv[bj][1];
                        if (fin) { *(f32x4*)xp = y0; *(f32x4*)(xp + 4) = y1; }
                        else { u32x4 w4; w4.x = pk2(y0[0], y0[1]); w4.y = pk2(y0[2], y0[3]); w4.z = pk2(y1[0], y1[1]); w4.w = pk2(y1[2], y1[3]);
                               *(u32x4*)(XNo + (size_t)row * DM + col0 + bj * 128) = w4; }
                        q += ((x0[0] * x0[0] + x0[1] * x0[1]) + (x0[2] * x0[2] + x0[3] * x0[3])) + ((x1[0] * x1[0] + x1[1] * x1[1]) + (x1[2] * x1[2] + x1[3] * x1[3]));
                    }
                }
                if (gnext) { q += __shfl_xor(q, 16); q += __shfl_xor(q, 32); if (fq == 0) atomicAdd(RS + row, q); }
            }
        }
    }
};

struct EpiFin {
    static constexpr bool PERM = true, AFTER_DRAIN = false;
    const bf16_t* XNb; const float* g1; float* Y; const float* g; float* RS; unsigned* pcnt;
    DI void operator()(const f32x4 (&acc_)[2][2][4][2], const pg8::Unit& u, int wr, int wc, int fr, int fq) const {
        f32x4 (&acc)[2][2][4][2] = const_cast<f32x4 (&)[2][2][4][2]>(acc_);
        const int row0 = u.pm * 256 + wr * 64 + fr;
        const int col0 = u.pn * 256 + wc * 32 + 8 * fq;
        f32x4 gv[2][2];
#pragma unroll
        for (int bj = 0; bj < 2; ++bj) { gv[bj][0] = *(const f32x4*)(g + col0 + bj * 128); gv[bj][1] = *(const f32x4*)(g + col0 + bj * 128 + 4); }
        f32x4 rg[2][2];
#pragma unroll
        for (int bj = 0; bj < 2; ++bj)
#pragma unroll
            for (int hh = 0; hh < 2; ++hh) { const f32x4 t = *(const f32x4*)(g1 + col0 + bj * 128 + 4 * hh);
                rg[bj][hh] = (f32x4){__builtin_amdgcn_rcpf(t[0]), __builtin_amdgcn_rcpf(t[1]), __builtin_amdgcn_rcpf(t[2]), __builtin_amdgcn_rcpf(t[3])}; }
#pragma unroll
        for (int am = 0; am < 4; ++am) {
            const int ai = am >> 1, mb = (am & 1) * 2;
            u32x4 bw[2][2];
#pragma unroll
            for (int mm = 0; mm < 2; ++mm)
#pragma unroll
                for (int bj = 0; bj < 2; ++bj) bw[mm][bj] = *(const u32x4*)(XNb + (size_t)(row0 + ai * 128 + (mb + mm) * 16) * DM + col0 + bj * 128);
#pragma unroll
            for (int mm = 0; mm < 2; ++mm) {
                const int m = mb + mm;
                float q = 0.f;
#pragma unroll
                for (int bj = 0; bj < 2; ++bj) {
                    const u32x4 wv = bw[mm][bj];
                    const f32x4 x0 = (f32x4){bflo(wv.x), bfhi(wv.x), bflo(wv.y), bfhi(wv.y)} * rg[bj][0] + acc[ai][bj][m][0];
                    const f32x4 x1 = (f32x4){bflo(wv.z), bfhi(wv.z), bflo(wv.w), bfhi(wv.w)} * rg[bj][1] + acc[ai][bj][m][1];
                    q += ((x0[0] * x0[0] + x0[1] * x0[1]) + (x0[2] * x0[2] + x0[3] * x0[3])) + ((x1[0] * x1[0] + x1[1] * x1[1]) + (x1[2] * x1[2] + x1[3] * x1[3]));
                    acc[ai][bj][m][0] = x0 * gv[bj][0]; acc[ai][bj][m][1] = x1 * gv[bj][1];
                }
                q += __shfl_xor(q, 16); q += __shfl_xor(q, 32);
                if (fq == 0) atomicAdd(RS + row0 + ai * 128 + m * 16, q);
            }
        }
        asm volatile("s_waitcnt vmcnt(0)" ::: "memory");
        unsigned* pc = pcnt + 64 * u.pm;
        if (fr == 0 && fq == 0) __hip_atomic_fetch_add(pc, 1u, __ATOMIC_RELAXED, __HIP_MEMORY_SCOPE_AGENT);
        { unsigned sp = 0; while (__hip_atomic_load(pc, __ATOMIC_RELAXED, __HIP_MEMORY_SCOPE_AGENT) < 128u) { __builtin_amdgcn_s_sleep(2); if (++sp > (1u << 21)) break; } }
        asm volatile("" ::: "memory");
#pragma unroll
        for (int ai = 0; ai < 2; ++ai)
#pragma unroll
            for (int m = 0; m < 4; ++m) {
                const int row = row0 + ai * 128 + m * 16;
                const float rs = __builtin_amdgcn_rsqf(__hip_atomic_load(RS + row, __ATOMIC_RELAXED, __HIP_MEMORY_SCOPE_AGENT) * (1.f / DM) + EPS);
#pragma unroll
                for (int bj = 0; bj < 2; ++bj) {
                    float* yp = Y + (size_t)row * DM + col0 + bj * 128;
                    *(f32x4*)yp = acc[ai][bj][m][0] * rs; *(f32x4*)(yp + 4) = acc[ai][bj][m][1] * rs;
                }
            }
    }
};
struct EpiInMem {
    static constexpr bool PERM = true, AFTER_DRAIN = false;
    EpiIn ein; EpiMem emem;
    DI void operator()(const f32x4 (&acc)[2][2][4][2], const pg8::Unit& u, int wr, int wc, int fr, int fq) const { if (u.sel) emem(acc, u, wr, wc, fr, fq); else ein(acc, u, wr, wc, fr, fq); }
};
struct InMemOrder {
    pg8::StaticOrder so; int nin;
    DI void init(int G_, int c_) { so.init(TP, NP, G_, c_); nin = (TP / 256) * (NP / 256); }
    DI bool next(int i, pg8::Unit& u) const {
        const long L = (long)i * so.G + so.c;
        if (L < nin) return so.next(i, u);
        const int idx = (int)(L - nin); if (idx >= 32) return false;
        u.pm = idx & 3; u.pn = idx >> 2; u.sel = 1; return true;
    }
    DI void a_ready(const pg8::Unit&) const {}
    DI void done(const pg8::Unit&) const {}
};
struct PanelOrder {
    int G, c;
    DI void init(int G_, int c_) { G = G_; c = c_; }
    DI bool next(int i, pg8::Unit& u) const {
        if (G == 256) { if (i >= 2) return false; const int xcd = c & 7, r = c >> 3, j = xcd >> 1, hx = xcd & 1; u.pm = 16 * i + 4 * j + (r & 3); u.pn = 8 * hx + (r >> 2); u.sel = 0; return true; }
        const long L = (long)i * G + c; if (L >= 512) return false; u.pm = (int)(L >> 4); u.pn = (int)(L & 15); u.sel = 0; return true;
    }
    DI void a_ready(const pg8::Unit&) const {}
    DI void done(const pg8::Unit&) const {}
};

DI int dst_row_in(int s) {
    if (s < 2304) { const int d = s & 63; return (s & ~63) + 2 * (d & 31) + (d >> 5); }
    if (s < 6656) return s;
    if (s < 6672) return 9728 + (s - 6656);
    return s - 16;
}
struct TrItem { const float* W; bf16_t* WT; int N, item, inmap; };
DI void tr_load(const TrItem& t, f32x4 (&tv)[16], int lane) {
    const int nblk = (t.N + 63) >> 6, kb = t.item / nblk, nb = t.item - kb * nblk, k0 = 64 * kb, n0 = 64 * nb;
    const int cl = (lane & 15) * 4, rl = lane >> 4;
    const bool okc = (n0 + cl) < t.N;
#pragma unroll
    for (int i = 0; i < 16; ++i) { tv[i] = (f32x4){0.f, 0.f, 0.f, 0.f}; if (okc) tv[i] = *(const f32x4*)(t.W + (size_t)(k0 + 4 * i + rl) * t.N + n0 + cl); }
}
DI void tr_store(const TrItem& t, const f32x4 (&tv)[16], float* scr, int lane) {
    const int nblk = (t.N + 63) >> 6, kb = t.item / nblk, nb = t.item - kb * nblk, k0 = 64 * kb, n0 = 64 * nb;
    const int cl = (lane & 15) * 4, rl = lane >> 4;
#pragma unroll
    for (int i = 0; i < 16; ++i) { float* s = scr + (4 * i + rl) * 65 + cl; s[0] = tv[i][0]; s[1] = tv[i][1]; s[2] = tv[i][2]; s[3] = tv[i][3]; }
    asm volatile("s_waitcnt lgkmcnt(0)" ::: "memory");
    const int c = lane & 7;
#pragma unroll
    for (int j = 0; j < 8; ++j) {
        const int n = (lane >> 3) + 8 * j;
        if (n0 + n < t.N) {
            const float* s = scr + (8 * c) * 65 + n;
            u32x4 o; o.x = pk2(s[0], s[65]); o.y = pk2(s[2 * 65], s[3 * 65]); o.z = pk2(s[4 * 65], s[5 * 65]); o.w = pk2(s[6 * 65], s[7 * 65]);
            const int row = t.inmap ? dst_row_in(n0 + n) : (n0 + n);
            *(u32x4*)(t.WT + (size_t)row * DM + k0 + 8 * c) = o;
        }
    }
    asm volatile("s_waitcnt lgkmcnt(0)" ::: "memory");
}
DI void norm_row(const float* src, const float* g, bf16_t* dstb, float* dstf, int lane) {
    const f32x4* xr = (const f32x4*)src + lane;
    f32x4 v[16]; float s = 0.f;
#pragma unroll
    for (int j = 0; j < 16; ++j) { v[j] = xr[64 * j]; s += (v[j][0] * v[j][0] + v[j][1] * v[j][1]) + (v[j][2] * v[j][2] + v[j][3] * v[j][3]); }
    const f32x4* gr = (const f32x4*)g + lane;
    f32x4 gv[16];
#pragma unroll
    for (int j = 0; j < 16; ++j) gv[j] = gr[64 * j];
    const float rs = __builtin_amdgcn_rsqf(wave_sum(s) * (1.f / DM) + EPS);
#pragma unroll
    for (int j = 0; j < 16; ++j) {
        const f32x4 o = v[j] * rs * gv[j];
        if (dstb) { u32x2 w2; w2.x = pk2(o[0], o[1]); w2.y = pk2(o[2], o[3]); *((u32x2*)dstb + lane + 64 * j) = w2; }
        else *((f32x4*)dstf + lane + 64 * j) = o;
    }
}
DI void rope_entry(float* tab, int idx) {
    const int pi = idx >> 5, i = idx & 31;
    const double pos = pi < SEQ ? (double)pi : 16384.0;
    double inv = 1.0; for (int k = 0; k < i; ++k) inv *= 0.7498942093324559;
    const double a = pos * inv;
    const double q = __builtin_rint(a * 0.6366197723675814);
    const double r = (a - q * 1.5707963267948966) - q * 6.123233995736766e-17;
    const int qi = ((int)q) & 3;
    const double r2 = r * r;
    const double sn = r * (1.0 + r2 * (-1.0 / 6 + r2 * (1.0 / 120 + r2 * (-1.0 / 5040 + r2 * (1.0 / 362880 + r2 * (-1.0 / 39916800 + r2 * (1.0 / 6227020800.0)))))));
    const double cs = 1.0 + r2 * (-0.5 + r2 * (1.0 / 24 + r2 * (-1.0 / 720 + r2 * (1.0 / 40320 + r2 * (-1.0 / 3628800 + r2 * (1.0 / 479001600 + r2 * (-1.0 / 87178291200.0)))))));
    double c, s;
    if (qi == 0) { c = cs; s = sn; } else if (qi == 1) { c = -sn; s = cs; } else if (qi == 2) { c = -cs; s = -sn; } else { c = sn; s = -cs; }
    tab[2 * idx] = (float)c; tab[2 * idx + 1] = (float)s;
}

DI void swa_unit(unsigned char* lds, const bf16_t* H, bf16_t* Gt, const float* sinks, int u, int tid) {
    const int kvh = u & 3, blk = (u >> 2) & 15, b = u >> 6;
    bf16_t* Ks = (bf16_t*)lds;
    bf16_t* Vt = (bf16_t*)(lds + 39168);
    const int lane = tid & 63, w = tid >> 6, c16 = lane & 15, quad = lane >> 4;
    const int qi = w * 16 + c16;
    const size_t qrow = (size_t)(b * SEQ + blk * 128 + qi);
    bf16x8 qc0 = *(const bf16x8*)(H + qrow * NP + C_SQ + kvh * 512 + quad * 8), qc1 = *(const bf16x8*)(H + qrow * NP + C_SQ + kvh * 512 + 32 + quad * 8);
    __syncthreads();
    {
        const int r = tid >> 1, half = tid & 1;
        const int tok = blk * 128 - 128 + r;
        u32x4 kv[4], vv[4];
#pragma unroll
        for (int i = 0; i < 4; ++i) { kv[i] = (u32x4){0u, 0u, 0u, 0u}; vv[i] = (u32x4){0u, 0u, 0u, 0u}; }
        if (tok >= 0) {
            const bf16_t* src = H + (size_t)(b * SEQ + tok) * NP + kvh * 64 + half * 32;
#pragma unroll
            for (int i = 0; i < 4; ++i) { kv[i] = *(const u32x4*)(src + C_SK + i * 8); vv[i] = *(const u32x4*)(src + C_SV + i * 8); }
        }
#pragma unroll
        for (int i = 0; i < 4; ++i) *(u32x4*)(Ks + r * 72 + half * 32 + i * 8) = kv[i];
#pragma unroll
        for (int i = 0; i < 4; ++i)
#pragma unroll
            for (int e = 0; e < 4; ++e) {
                const unsigned wv = vv[i][e];
                Vt[(half * 32 + i * 8 + 2 * e) * 280 + r] = (bf16_t)(wv & 0xffffu);
                Vt[(half * 32 + i * 8 + 2 * e + 1) * 280 + r] = (bf16_t)(wv >> 16);
            }
        for (int i = tid; i < 576; i += 512) ((unsigned*)(Ks + 256 * 72))[i] = 0u;
        { const int d = tid >> 3, cc = 256 + (tid & 7) * 2; *(unsigned*)(Vt + d * 280 + cc) = 0u; }
    }
    __syncthreads();
    for (int g = 0; g < 8; ++g) {
        const int head = kvh * 8 + g;
        bf16x8 qf[2]; qf[0] = qc0; qf[1] = qc1;
        { const int hn = kvh * 8 + (g < 7 ? g + 1 : g);
          qc0 = *(const bf16x8*)(H + qrow * NP + C_SQ + hn * 64 + quad * 8); qc1 = *(const bf16x8*)(H + qrow * NP + C_SQ + hn * 64 + 32 + quad * 8); }
        u32x2 gwv[4];
#pragma unroll
        for (int mt = 0; mt < 4; ++mt) gwv[mt] = *(const u32x2*)(H + qrow * NP + C_SG + head * 64 + mt * 16 + quad * 4);
        f32x4 s[10];
#pragma unroll
        for (int i = 0; i < 10; ++i) {
            s[i] = (f32x4){0.f, 0.f, 0.f, 0.f};
            const bf16_t* kp = Ks + ((w + i) * 16 + c16) * 72 + quad * 8;
#pragma unroll
            for (int ks = 0; ks < 2; ++ks) s[i] = mfma16(*(const bf16x8*)(kp + ks * 32), qf[ks], s[i]);
        }
        const float sink = sinks[head];
        float mx = sink;
        int qiv = qi + 128 - (w * 16 + quad * 4); asm volatile("" : "+v"(qiv));
        const int lowlim = blk > 0 ? 0 : 128;
#pragma unroll
        for (int i = 0; i < 10; ++i)
#pragma unroll
            for (int j = 0; j < 4; ++j) {
                const int sj = (w + i) * 16 + quad * 4 + j, diff = qiv - (i * 16 + j);
                const bool valid = (unsigned)diff < 128u && sj >= lowlim;
                s[i][j] = valid ? s[i][j] : -INFINITY;
                mx = fmaxf(mx, s[i][j]);
            }
        mx = fmaxf(mx, __shfl_xor(mx, 16)); mx = fmaxf(mx, __shfl_xor(mx, 32));
        float sum = 0.f;
#pragma unroll
        for (int i = 0; i < 10; ++i)
#pragma unroll
            for (int j = 0; j < 4; ++j) { const float p = __expf(s[i][j] - mx); s[i][j] = p; sum += p; }
        sum += __shfl_xor(sum, 16); sum += __shfl_xor(sum, 32);
        sum += __expf(sink - mx);
        const float inv = __builtin_amdgcn_rcpf(sum);
        f32x4 o[4];
#pragma unroll
        for (int mt = 0; mt < 4; ++mt) o[mt] = (f32x4){0.f, 0.f, 0.f, 0.f};
#pragma unroll
        for (int st = 0; st < 5; ++st) {
            const bf16x8 pb = pack8(s[2 * st], s[2 * st + 1]);
#pragma unroll
            for (int mt = 0; mt < 4; ++mt) {
                const bf16_t* vp = Vt + (mt * 16 + c16) * 280 + (w + 2 * st) * 16 + quad * 4;
                o[mt] = mfma16(cat4(*(const s16x4*)vp, *(const s16x4*)(vp + 16)), pb, o[mt]);
            }
        }
#pragma unroll
        for (int mt = 0; mt < 4; ++mt) {
            const int d = mt * 16 + quad * 4;
            const u32x2 gw = gwv[mt];
            u32x2 ow;
            ow.x = pk2(o[mt][0] * inv * silu(bflo(gw.x)), o[mt][1] * inv * silu(bfhi(gw.x)));
            ow.y = pk2(o[mt][2] * inv * silu(bflo(gw.y)), o[mt][3] * inv * silu(bfhi(gw.y)));
            *(u32x2*)(Gt + qrow * DM + head * 64 + d) = ow;
        }
    }
}

DI void mem_unit(unsigned char* lds, const bf16_t* H, const bf16_t* MKV, bf16_t* Gt, int u, int tid) {
    const int qt = u & 15, h = (u >> 4) & 3, b = u >> 6;
    bf16_t* Kc = (bf16_t*)lds;
    bf16_t* Vc = (bf16_t*)(lds + 33792);
    const int lane = tid & 63, w = tid >> 6, c16 = lane & 15, quad = lane >> 4;
    const size_t qrow = (size_t)(b * SEQ + qt * 128 + w * 16 + c16);
    const int srow = tid >> 3, seg = tid & 7;
    const bf16_t* ksrc = MKV + (size_t)(b * 256 + srow) * 2048 + h * 256 + seg * 32;
    const bf16_t* vsrc = MKV + (size_t)(b * 256 + lane) * 2048 + 1024 + h * 256 + w * 32;
    u32x4 pre[4];
#pragma unroll
    for (int i = 0; i < 4; ++i) pre[i] = *(const u32x4*)(ksrc + i * 8);
    bf16x8 qf[8];
#pragma unroll
    for (int ks = 0; ks < 8; ++ks) qf[ks] = *(const bf16x8*)(H + qrow * NP + C_MQ + h * 256 + ks * 32 + quad * 8);
    f32x4 s[16];
#pragma unroll
    for (int c = 0; c < 4; ++c) {
        __syncthreads();
#pragma unroll
        for (int i = 0; i < 4; ++i) *(u32x4*)(Kc + srow * 264 + seg * 32 + i * 8) = pre[i];
        if (c < 3) {
#pragma unroll
            for (int i = 0; i < 4; ++i) pre[i] = *(const u32x4*)(ksrc + (size_t)(c + 1) * 64 * 2048 + i * 8);
        } else {
#pragma unroll
            for (int i = 0; i < 4; ++i) pre[i] = *(const u32x4*)(vsrc + i * 8);
        }
        __syncthreads();
#pragma unroll
        for (int kt = 0; kt < 4; ++kt) {
            f32x4 a = {0.f, 0.f, 0.f, 0.f};
            const bf16_t* kp = Kc + (kt * 16 + c16) * 264 + quad * 8;
#pragma unroll
            for (int ks = 0; ks < 8; ++ks) a = mfma16(*(const bf16x8*)(kp + ks * 32), qf[ks], a);
            s[c * 4 + kt] = a;
        }
    }
    u32x2 gwv[16];
#pragma unroll
    for (int mt = 0; mt < 16; ++mt) gwv[mt] = *(const u32x2*)(H + qrow * NP + C_MG + h * 256 + mt * 16 + quad * 4);
    float mx = -INFINITY;
#pragma unroll
    for (int i = 0; i < 16; ++i)
#pragma unroll
        for (int j = 0; j < 4; ++j) mx = fmaxf(mx, s[i][j]);
    mx = fmaxf(mx, __shfl_xor(mx, 16)); mx = fmaxf(mx, __shfl_xor(mx, 32));
    float sum = 0.f;
#pragma unroll
    for (int i = 0; i < 16; ++i)
#pragma unroll
        for (int j = 0; j < 4; ++j) { const float p = __expf(s[i][j] - mx); s[i][j] = p; sum += p; }
    sum += __shfl_xor(sum, 16); sum += __shfl_xor(sum, 32);
    const float inv = __builtin_amdgcn_rcpf(sum);
    bf16x8 pbv[8];
#pragma unroll
    for (int i = 0; i < 8; ++i) pbv[i] = pack8(s[2 * i], s[2 * i + 1]);
    f32x4 o[16];
#pragma unroll
    for (int mt = 0; mt < 16; ++mt) o[mt] = (f32x4){0.f, 0.f, 0.f, 0.f};
#pragma unroll
    for (int c = 0; c < 4; ++c) {
        __syncthreads();
#pragma unroll
        for (int i = 0; i < 4; ++i)
#pragma unroll
            for (int e = 0; e < 4; ++e) {
                Vc[(w * 32 + i * 8 + 2 * e) * 72 + lane] = (bf16_t)(pre[i][e] & 0xffffu);
                Vc[(w * 32 + i * 8 + 2 * e + 1) * 72 + lane] = (bf16_t)(pre[i][e] >> 16);
            }
        if (c < 3) {
#pragma unroll
            for (int i = 0; i < 4; ++i) pre[i] = *(const u32x4*)(vsrc + (size_t)(c + 1) * 64 * 2048 + i * 8);
        }
        __syncthreads();
#pragma unroll
        for (int st = 0; st < 2; ++st) {
            const bf16x8 pb = pbv[c * 2 + st];
#pragma unroll
            for (int mt = 0; mt < 16; ++mt) {
                const bf16_t* vp = Vc + (mt * 16 + c16) * 72 + (2 * st) * 16 + quad * 4;
                o[mt] = mfma16(cat4(*(const s16x4*)vp, *(const s16x4*)(vp + 16)), pb, o[mt]);
            }
        }
    }
#pragma unroll
    for (int mt = 0; mt < 16; ++mt) {
        const int d = mt * 16 + quad * 4;
        const u32x2 gw = gwv[mt];
        u32x2 ow;
        ow.x = pk2(o[mt][0] * inv * silu(bflo(gw.x)), o[mt][1] * inv * silu(bfhi(gw.x)));
        ow.y = pk2(o[mt][2] * inv * silu(bflo(gw.y)), o[mt][3] * inv * silu(bfhi(gw.y)));
        *(u32x2*)(Gt + qrow * DM + 3072 + h * 256 + d) = ow;
    }
}

DI float logsig16(float z) { return (fminf(z, 0.f) - __logf(1.f + __expf(-fabsf(z)))) * 0.0625f; }

constexpr int GI_QS = 0, GI_AS = 17408, GI_VT = 26624, GI_BYTES = 63488, GI_IMG = 26624;
DI void gla_prep_unit(unsigned char* lds, const bf16_t* H, const float* wg, const float* bg, u32x2* Ug, float* EBLg, unsigned char* IMG, int u, int tid) {
    const int ch = u & 31, h = (u >> 5) & 3, b = u >> 7;
    bf16_t* Qs = (bf16_t*)(lds + GI_QS);
    bf16_t* As = (bf16_t*)(lds + GI_AS);
    bf16_t* Vt = (bf16_t*)(lds + GI_VT);
    bf16_t* Ks = (bf16_t*)(lds + 63488);
    bf16_t* Kt = (bf16_t*)(lds + 80896);
    float* LR = (float*)(lds + 99328);
    float* WgL = (float*)(lds + 103424);
    float* GT = (float*)(lds + 111616);
    const int lane = tid & 63, w = tid >> 6, c16 = lane & 15, quad = lane >> 4;
    const size_t row0 = (size_t)(b * SEQ + ch * 64);
    __syncthreads();
    { const int i = tid >> 3, r2 = (tid & 7) * 2; const unsigned wv = *(const unsigned*)(H + (row0 + i) * NP + C_LR + r2); LR[i * 16 + r2] = bflo(wv); LR[i * 16 + r2 + 1] = bfhi(wv); }
#pragma unroll
    for (int r = 0; r < 4; ++r) { const int idx = tid + 512 * r; WgL[idx] = wg[(idx >> 7) * 512 + h * 128 + (idx & 127)]; }
    const int dk = tid & 127, ig = tid >> 7;
    const float bgc = bg[h * 128 + dk];
    unsigned short qr[16], kr[16];
#pragma unroll
    for (int ii = 0; ii < 16; ++ii) { const bf16_t* src = H + (row0 + ig * 16 + ii) * NP + h * 128 + dk; qr[ii] = src[C_GQ]; kr[ii] = src[C_GK]; }
    u32x4 vpre[4];
#pragma unroll
    for (int i = 0; i < 4; ++i) vpre[i] = *(const u32x4*)(H + (row0 + lane) * NP + C_GV + h * 256 + w * 32 + i * 8);
    __syncthreads();
    float bb[16];
    {
        float wgc[16];
#pragma unroll
        for (int r = 0; r < 16; ++r) wgc[r] = WgL[r * 128 + dk];
        float run = 0.f;
#pragma unroll
        for (int ii = 0; ii < 16; ++ii) {
            const int i = ig * 16 + ii;
            float z = bgc;
#pragma unroll
            for (int r = 0; r < 16; ++r) z += LR[i * 16 + r] * wgc[r];
            run += logsig16(z); bb[ii] = run;
        }
        GT[ig * 128 + dk] = run;
    }
#pragma unroll
    for (int i = 0; i < 4; ++i)
#pragma unroll
        for (int e = 0; e < 4; ++e) {
            Vt[(w * 32 + i * 8 + 2 * e) * 72 + lane] = (bf16_t)(vpre[i][e] & 0xffffu);
            Vt[(w * 32 + i * 8 + 2 * e + 1) * 72 + lane] = (bf16_t)(vpre[i][e] >> 16);
        }
    __syncthreads();
    {
        const float t0 = GT[dk], t1 = GT[128 + dk], t2 = GT[256 + dk], t3 = GT[384 + dk];
        const float bl = (t0 + t1) + (t2 + t3);
        const float off = (ig > 0 ? t0 : 0.f) + (ig > 1 ? t1 : 0.f) + (ig > 2 ? t2 : 0.f);
#pragma unroll
        for (int ii = 0; ii < 16; ++ii) {
            const int i = ig * 16 + ii;
            const float bv = off + bb[ii], q = bf2f(qr[ii]), k = bf2f(kr[ii]);
            Qs[i * 136 + dk] = f2bf(q * __expf(bv));
            Ks[i * 136 + dk] = f2bf(k * __expf(-bv));
            Kt[dk * 72 + i] = f2bf(k * __expf(bl - bv));
        }
        if (ig == 0) EBLg[(size_t)u * 128 + dk] = __expf(bl);
    }
    __syncthreads();
#pragma unroll
    for (int tt = 0; tt < 2; ++tt) {
        const int t = 2 * w + tt, mt = t >> 2, nt = t & 3;
        f32x4 a = {0.f, 0.f, 0.f, 0.f};
        if (nt <= mt) {
#pragma unroll
            for (int ks = 0; ks < 4; ++ks)
                a = mfma16(*(const bf16x8*)(Qs + (mt * 16 + c16) * 136 + ks * 32 + quad * 8), *(const bf16x8*)(Ks + (nt * 16 + c16) * 136 + ks * 32 + quad * 8), a);
        }
#pragma unroll
        for (int jj = 0; jj < 4; ++jj) { const int i = mt * 16 + quad * 4 + jj, j = nt * 16 + c16; As[i * 72 + j] = f2bf(j <= i ? a[jj] : 0.f); }
    }
#pragma unroll
    for (int kt = 0; kt < 8; ++kt) {
        f32x4 s0 = {0.f, 0.f, 0.f, 0.f}, s1 = {0.f, 0.f, 0.f, 0.f};
#pragma unroll
        for (int ks = 0; ks < 2; ++ks) {
            const bf16x8 a = *(const bf16x8*)(Kt + (kt * 16 + c16) * 72 + ks * 32 + quad * 8);
            s0 = mfma16(a, *(const bf16x8*)(Vt + ((2 * w) * 16 + c16) * 72 + ks * 32 + quad * 8), s0);
            s1 = mfma16(a, *(const bf16x8*)(Vt + ((2 * w + 1) * 16 + c16) * 72 + ks * 32 + quad * 8), s1);
        }
        { u32x2 p0, p1; p0.x = pk2(s0[0], s0[1]); p0.y = pk2(s0[2], s0[3]); p1.x = pk2(s1[0], s1[1]); p1.y = pk2(s1[2], s1[3]);
          Ug[((size_t)(u * 8 + kt) * 16 + 2 * w) * 64 + lane] = p0; Ug[((size_t)(u * 8 + kt) * 16 + 2 * w + 1) * 64 + lane] = p1; }
    }
    __syncthreads();
    { u32x4* dst = (u32x4*)(IMG + (size_t)u * GI_IMG); const u32x4* srcl = (const u32x4*)lds;
      for (int i = tid; i < GI_IMG / 16; i += 512) dst[i] = srcl[i]; }
}
DI void gla_scan_task(const u32x2* Ug, const float* EBLg, u32x2* SF2, float* state_out, int t, int lane) {
    const int nt = t & 15, kt = (t >> 4) & 7, bh = t >> 7;
    const int c16 = lane & 15, quad = lane >> 4;
    f32x4 s0 = {0.f, 0.f, 0.f, 0.f};
    for (int n0 = 0; n0 < 32; n0 += 16) {
        f32x4 ev[16], uv[16];
#pragma unroll
        for (int j = 0; j < 16; ++j) {
            const size_t u = (size_t)bh * 32 + n0 + j;
            ev[j] = *(const f32x4*)(EBLg + u * 128 + kt * 16 + quad * 4);
            { const u32x2 p = Ug[((u * 8 + kt) * 16 + nt) * 64 + lane]; uv[j] = (f32x4){bflo(p.x), bfhi(p.x), bflo(p.y), bfhi(p.y)}; }
        }
#pragma unroll
        for (int j = 0; j < 16; ++j) {
            const size_t u = (size_t)bh * 32 + n0 + j;
            u32x2 pk; pk.x = pk2(s0[0], s0[1]); pk.y = pk2(s0[2], s0[3]);
            if (n0 + j > 0) SF2[(((u * 4 + (kt >> 1)) * 16 + nt) * 64 + lane) * 2 + (kt & 1)] = pk;
            s0 = s0 * ev[j] + uv[j];
        }
    }
#pragma unroll
    for (int jj = 0; jj < 4; ++jj) state_out[((size_t)bh * 128 + kt * 16 + quad * 4 + jj) * 256 + nt * 16 + c16] = s0[jj];
}
DI void gla_out_unit(unsigned char* lds, const bf16_t* H, bf16_t* Gt, const float* gng, const u32x4* SF, const unsigned char* IMG, int u, int tid) {
    const int ch = u & 31, h = (u >> 5) & 3, b = u >> 7;
    const bf16_t* Qs = (const bf16_t*)(lds + GI_QS);
    const bf16_t* As = (const bf16_t*)(lds + GI_AS);
    const bf16_t* Vt = (const bf16_t*)(lds + GI_VT);
    float* SSw = (float*)(lds + GI_BYTES);
    const int lane = tid & 63, w = tid >> 6, c16 = lane & 15, quad = lane >> 4;
    const size_t row0 = (size_t)(b * SEQ + ch * 64);
    unsigned short gtv[4][4][2];
#pragma unroll
    for (int mt = 0; mt < 4; ++mt)
#pragma unroll
        for (int jj = 0; jj < 4; ++jj)
#pragma unroll
            for (int n = 0; n < 2; ++n) gtv[mt][jj][n] = H[(row0 + mt * 16 + quad * 4 + jj) * NP + C_GG + h * 256 + (2 * w + n) * 16 + c16];
    u32x4 vpre[4];
#pragma unroll
    for (int i = 0; i < 4; ++i) vpre[i] = *(const u32x4*)(H + (row0 + lane) * NP + C_GV + h * 256 + w * 32 + i * 8);
    __syncthreads();
    { const u32x4* src = (const u32x4*)(IMG + (size_t)u * GI_IMG); u32x4* dstl = (u32x4*)lds;
      for (int i = tid; i < GI_IMG / 16; i += 512) dstl[i] = src[i]; }
    { bf16_t* Vw = (bf16_t*)(lds + GI_VT);
#pragma unroll
      for (int i = 0; i < 4; ++i)
#pragma unroll
          for (int e = 0; e < 4; ++e) {
              Vw[(w * 32 + i * 8 + 2 * e) * 72 + lane] = (bf16_t)(vpre[i][e] & 0xffffu);
              Vw[(w * 32 + i * 8 + 2 * e + 1) * 72 + lane] = (bf16_t)(vpre[i][e] >> 16);
          } }
    bf16x8 sb[4][2];
#pragma unroll
    for (int ks = 0; ks < 4; ++ks)
#pragma unroll
        for (int n = 0; n < 2; ++n) sb[ks][n] = ch == 0 ? (bf16x8){0, 0, 0, 0, 0, 0, 0, 0} : __builtin_bit_cast(bf16x8, SF[(((size_t)u * 4 + ks) * 16 + 2 * w + n) * 64 + lane]);
    __syncthreads();
    f32x4 o[4][2];
#pragma unroll
    for (int mt = 0; mt < 4; ++mt) {
        o[mt][0] = (f32x4){0.f, 0.f, 0.f, 0.f}; o[mt][1] = (f32x4){0.f, 0.f, 0.f, 0.f};
#pragma unroll
        for (int ks = 0; ks < 4; ++ks) {
            const bf16_t* qp = Qs + (mt * 16 + c16) * 136 + (2 * ks) * 16 + quad * 4;
            const bf16x8 a = cat4(*(const s16x4*)qp, *(const s16x4*)(qp + 16));
            o[mt][0] = mfma16(a, sb[ks][0], o[mt][0]); o[mt][1] = mfma16(a, sb[ks][1], o[mt][1]);
        }
#pragma unroll
        for (int ks = 0; ks < 2; ++ks) {
            const bf16x8 a = *(const bf16x8*)(As + (mt * 16 + c16) * 72 + ks * 32 + quad * 8);
#pragma unroll
            for (int n = 0; n < 2; ++n) o[mt][n] = mfma16(a, *(const bf16x8*)(Vt + ((2 * w + n) * 16 + c16) * 72 + ks * 32 + quad * 8), o[mt][n]);
        }
    }
#pragma unroll
    for (int mt = 0; mt < 4; ++mt)
#pragma unroll
        for (int jj = 0; jj < 4; ++jj) {
            float q = o[mt][0][jj] * o[mt][0][jj] + o[mt][1][jj] * o[mt][1][jj];
            q += __shfl_xor(q, 1); q += __shfl_xor(q, 2); q += __shfl_xor(q, 4); q += __shfl_xor(q, 8);
            if (c16 == 0) SSw[w * 64 + mt * 16 + quad * 4 + jj] = q;
        }
    __syncthreads();
    const float gn0 = gng[h * 256 + (2 * w) * 16 + c16], gn1 = gng[h * 256 + (2 * w + 1) * 16 + c16];
#pragma unroll
    for (int mt = 0; mt < 4; ++mt)
#pragma unroll
        for (int jj = 0; jj < 4; ++jj) {
            const int i = mt * 16 + quad * 4 + jj;
            float tot = 0.f;
#pragma unroll
            for (int ww = 0; ww < 8; ++ww) tot += SSw[ww * 64 + i];
            const float rs = __builtin_amdgcn_rsqf(tot * (1.f / 256.f) + EPS);
#pragma unroll
            for (int n = 0; n < 2; ++n) {
                const int dv = (2 * w + n) * 16 + c16;
                const float gate = bf2f(gtv[mt][jj][n]);
                Gt[(row0 + i) * DM + 2048 + h * 256 + dv] = f2bf(o[mt][n][jj] * rs * (n ? gn1 : gn0) * silu(gate));
            }
        }
}

DI void s_swa_unit(unsigned char* lds, const bf16_t* H, bf16_t* Gt, const float* ck, const float* cv, const float* sinks, float* kout, float* vout, int u, int tid) {
    const int kvh = u & 3, b = u >> 2;
    float* Kl = (float*)lds;
    float* Vl = Kl + 128 * 65;
    float* Ql = Vl + 128 * 64;
    float* Pl = Ql + 512;
    const int lane = tid & 63, w = tid >> 6;
    const bf16_t* hrow = H + (size_t)(TP + b) * NP;
    __syncthreads();
    {
        float kr[16], vr[16];
#pragma unroll
        for (int i = 0; i < 16; ++i) {
            const int kk = w + 8 * i;
            if (kk < 127) { const size_t o = ((size_t)(b * 128 + kk + 1) * 4 + kvh) * 64 + lane; kr[i] = ck[o]; vr[i] = cv[o]; }
            else { const int p = 2 * (lane & 31) + (lane >> 5); kr[i] = bf2f(hrow[C_SK + kvh * 64 + p]); vr[i] = bf2f(hrow[C_SV + kvh * 64 + lane]); }
        }
#pragma unroll
        for (int i = 0; i < 16; ++i) {
            const int kk = w + 8 * i;
            if (kk < 127) { const size_t oo = ((size_t)(b * 128 + kk) * 4 + kvh) * 64 + lane; kout[oo] = kr[i]; vout[oo] = vr[i]; }
            Kl[kk * 65 + lane] = kr[i]; Vl[kk * 64 + lane] = vr[i];
        }
    }
    { const int p = 2 * (lane & 31) + (lane >> 5); Ql[w * 64 + lane] = bf2f(hrow[C_SQ + (kvh * 8 + w) * 64 + p]); }
    __syncthreads();
    float s0 = 0.f, s1 = 0.f;
    for (int d = 0; d < 64; ++d) { const float qd = Ql[w * 64 + d]; s0 += qd * Kl[lane * 65 + d]; s1 += qd * Kl[(lane + 64) * 65 + d]; }
    const float sink = sinks[kvh * 8 + w];
    const float mx = fmaxf(wave_max(fmaxf(s0, s1)), sink);
    const float p0 = __expf(s0 - mx), p1 = __expf(s1 - mx);
    const float inv = __builtin_amdgcn_rcpf(wave_sum(p0 + p1) + __expf(sink - mx));
    Pl[w * 128 + lane] = p0 * inv; Pl[w * 128 + lane + 64] = p1 * inv;
    __syncthreads();
    float o = 0.f;
    for (int kk = 0; kk < 128; ++kk) o += Pl[w * 128 + kk] * Vl[kk * 64 + lane];
    const float gate = bf2f(hrow[C_SG + (kvh * 8 + w) * 64 + lane]);
    Gt[(size_t)(TP + b) * DM + (kvh * 8 + w) * 64 + lane] = f2bf(o * silu(gate));
}
DI void s_gla_unit(unsigned char* lds, const bf16_t* H, bf16_t* Gt, const float* wg, const float* bg, const float* gng, const float* sin_, float* sout, int u, int tid) {
    const int h = u & 3, b = u >> 2;
    float* gE = (float*)lds; float* qv = gE + 128; float* kv = qv + 128; float* vv = kv + 128; float* Osum = vv + 256; float* red = Osum + 2048;
    const int lane = tid & 63, w = tid >> 6;
    const bf16_t* hrow = H + (size_t)(TP + b) * NP;
    __syncthreads();
    if (tid < 128) {
        float z = bg[h * 128 + tid];
#pragma unroll
        for (int r = 0; r < 16; ++r) z += bf2f(hrow[C_LR + r]) * wg[r * 512 + h * 128 + tid];
        gE[tid] = __expf(logsig16(z)); qv[tid] = bf2f(hrow[C_GQ + h * 128 + tid]); kv[tid] = bf2f(hrow[C_GK + h * 128 + tid]);
    }
    if (tid < 256) vv[tid] = bf2f(hrow[C_GV + h * 256 + tid]);
    __syncthreads();
    const float* S0 = sin_ + (size_t)(b * 4 + h) * 128 * 256;
    float* S1 = sout + (size_t)(b * 4 + h) * 128 * 256;
    const f32x4 v4 = *(const f32x4*)(vv + lane * 4);
    f32x4 oacc = {0.f, 0.f, 0.f, 0.f};
    f32x4 srow[16];
#pragma unroll
    for (int r = 0; r < 16; ++r) srow[r] = *(const f32x4*)(S0 + (16 * w + r) * 256 + lane * 4);
#pragma unroll
    for (int r = 0; r < 16; ++r) {
        const int dk = 16 * w + r;
        const f32x4 sv = srow[r] * gE[dk] + v4 * kv[dk];
        *(f32x4*)(S1 + dk * 256 + lane * 4) = sv;
        oacc += sv * qv[dk];
    }
    *(f32x4*)(Osum + w * 256 + lane * 4) = oacc;
    __syncthreads();
    float o = 0.f;
    if (tid < 256) {
#pragma unroll
        for (int ww = 0; ww < 8; ++ww) o += Osum[ww * 256 + tid];
        const float q = wave_sum(o * o);
        if (lane == 0) red[w] = q;
    }
    __syncthreads();
    if (tid < 256) {
        const float rs = __builtin_amdgcn_rsqf((red[0] + red[1] + red[2] + red[3]) * (1.f / 256.f) + EPS);
        const float gate = bf2f(hrow[C_GG + h * 256 + tid]);
        Gt[(size_t)(TP + b) * DM + 2048 + h * 256 + tid] = f2bf(o * rs * gng[h * 256 + tid] * silu(gate));
    }
}
DI void s_mem_unit(unsigned char* lds, const bf16_t* H, bf16_t* Gt, const float* mk, const float* mv, int u, int tid) {
    const int h = u & 3, b = u >> 2;
    float* Sc = (float*)lds; float* Osum = Sc + 256;
    const int lane = tid & 63, w = tid >> 6;
    const bf16_t* hrow = H + (size_t)(TP + b) * NP;
    __syncthreads();
    const u32x2 qw = *(const u32x2*)(hrow + C_MQ + h * 256 + lane * 4);
    const f32x4 q4 = {bflo(qw.x), bfhi(qw.x), bflo(qw.y), bfhi(qw.y)};
    const float* kbase = mk + ((size_t)(b * 256 + w * 32) * 4 + h) * 256 + lane * 4;
    const float* vbase = mv + ((size_t)(b * 256 + w * 32) * 4 + h) * 256 + lane * 4;
    float vals[32];
    {
        f32x4 kr[32];
#pragma unroll
        for (int r = 0; r < 32; ++r) kr[r] = *(const f32x4*)(kbase + (size_t)r * 1024);
#pragma unroll
        for (int r = 0; r < 32; ++r) vals[r] = (q4[0] * kr[r][0] + q4[1] * kr[r][1]) + (q4[2] * kr[r][2] + q4[3] * kr[r][3]);
    }
#pragma unroll
    for (int i = 0; i < 16; ++i) { const bool hi = lane & 32; const float send = hi ? vals[i] : vals[i + 16], keep = hi ? vals[i + 16] : vals[i]; vals[i] = keep + __shfl_xor(send, 32); }
#pragma unroll
    for (int i = 0; i < 8; ++i) { const bool hi = lane & 16; const float send = hi ? vals[i] : vals[i + 8], keep = hi ? vals[i + 8] : vals[i]; vals[i] = keep + __shfl_xor(send, 16); }
#pragma unroll
    for (int i = 0; i < 4; ++i) { const bool hi = lane & 8; const float send = hi ? vals[i] : vals[i + 4], keep = hi ? vals[i + 4] : vals[i]; vals[i] = keep + __shfl_xor(send, 8); }
#pragma unroll
    for (int i = 0; i < 2; ++i) { const bool hi = lane & 4; const float send = hi ? vals[i] : vals[i + 2], keep = hi ? vals[i + 2] : vals[i]; vals[i] = keep + __shfl_xor(send, 4); }
    { const bool hi = lane & 2; const float send = hi ? vals[0] : vals[1], keep = hi ? vals[1] : vals[0]; vals[0] = keep + __shfl_xor(send, 2); }
    vals[0] += __shfl_xor(vals[0], 1);
    if ((lane & 1) == 0) Sc[w * 32 + (lane >> 1)] = vals[0];
    f32x4 vr[32];
#pragma unroll
    for (int r = 0; r < 32; ++r) vr[r] = *(const f32x4*)(vbase + (size_t)r * 1024);
    __syncthreads();
    const f32x4 sv = *(const f32x4*)(Sc + lane * 4);
    const float mx = wave_max(fmaxf(fmaxf(sv[0], sv[1]), fmaxf(sv[2], sv[3])));
    const float inv = __builtin_amdgcn_rcpf(wave_sum((__expf(sv[0] - mx) + __expf(sv[1] - mx)) + (__expf(sv[2] - mx) + __expf(sv[3] - mx))));
    f32x4 oacc = {0.f, 0.f, 0.f, 0.f};
#pragma unroll
    for (int r = 0; r < 32; ++r) oacc += vr[r] * (__expf(Sc[w * 32 + r] - mx) * inv);
    *(f32x4*)(Osum + w * 256 + lane * 4) = oacc;
    __syncthreads();
    if (tid < 256) {
        float o = 0.f;
#pragma unroll
        for (int ww = 0; ww < 8; ++ww) o += Osum[ww * 256 + tid];
        const float gate = bf2f(hrow[C_MG + h * 256 + tid]);
        Gt[(size_t)(TP + b) * DM + 3072 + h * 256 + tid] = f2bf(o * silu(gate));
    }
}

#ifndef MK_ONE_LAUNCH
#define MK_ONE_LAUNCH 1
#endif
constexpr int N_PHASES = 12;
#ifndef PH_MASK
#define PH_MASK 0xFFFF
#endif
#define PHM(b) ((PH_MASK >> (b)) & 1)
#ifndef DUP_PH
#define DUP_PH 0
#endif
#ifndef DUP_SEL
#define DUP_SEL 0
#endif
#ifndef DUP_SYNC
#define DUP_SYNC 0
#endif
#ifndef DUP_P0
#define DUP_P0 0
#endif

__global__ void __launch_bounds__(512, 2) mk_fwd(Args a) {
    extern __shared__ __attribute__((aligned(16))) unsigned char lds[];
    const int G = gridDim.x, bid = blockIdx.x;
    unsigned char* ws = a.ws;
    bf16_t* XN = (bf16_t*)(ws + WS_XN);
    bf16_t* Hb = (bf16_t*)(ws + WS_H);
    bf16_t* Gt = (bf16_t*)(ws + WS_G);
    float* X1 = (float*)(ws + WS_X1);
    float* rope = (float*)(ws + WS_ROPE);
    float* RSq = (float*)(ws + WS_RS);
    const float* x_prompt = a.in[0]; const float* mem_prompt = a.in[1]; const float* x_sample = a.in[2];
    volatile LAS unsigned* bst = (volatile LAS unsigned*)((LAS unsigned char*)lds + (LDS_BYTES - 16));
    if (threadIdx.x < 4) bst[threadIdx.x] = 0u;
    __syncthreads();
    XcdBarrier xbar = xcd_barrier_post((unsigned*)(ws + WS_CTL), bst);
#define GRID_SYNC() xcd_barrier(xbar)

    if (a.ph_lo == 0) {
        int tidp = threadIdx.x; asm volatile("" : "+v"(tidp));
        const int tid = tidp, lane = tid & 63, wave = __builtin_amdgcn_readfirstlane(tid >> 6);
        for (int rep0 = 0; rep0 <= DUP_P0; ++rep0) if (PHM(0)) {
            float* scr = (float*)(lds + wave * 16640);
            const int gw = bid * 8 + wave, NGW = G * 8;
            constexpr int I_IN = 64 * 153, I_OUT = 64 * 64, I_MEM = 64 * 32, I_L = I_IN + I_OUT + I_MEM;
            auto mk_item = [&](int it) {
                TrItem t; const int l = it / I_L; int r = it - l * I_L;
                if (r < I_IN) { t.W = a.in[9] + (size_t)l * DM * NIN; t.WT = (bf16_t*)(ws + WS_WIN + l * SZ_WIN); t.N = NIN; t.item = r; t.inmap = 1; return t; }
                r -= I_IN;
                if (r < I_OUT) { t.W = a.in[16] + (size_t)l * DM * DM; t.WT = (bf16_t*)(ws + WS_WOUT + l * SZ_WOUT); t.N = DM; t.item = r; t.inmap = 0; return t; }
                r -= I_OUT;
                t.W = a.in[15] + (size_t)l * DM * 2048; t.WT = (bf16_t*)(ws + WS_WMEM + l * SZ_WMEM); t.N = 2048; t.item = r; t.inmap = 0; return t;
            };
            {
                int it = gw;
                f32x4 tv[16];
                TrItem cur = mk_item(it < 2 * I_L ? it : 0);
                if (it < 2 * I_L) tr_load(cur, tv, lane);
                while (it < 2 * I_L) {
                    const int nx = it + NGW;
                    f32x4 tn[16]; TrItem nxt = cur;
                    if (nx < 2 * I_L) { nxt = mk_item(nx); tr_load(nxt, tn, lane); }
                    tr_store(cur, tv, scr, lane);
#pragma unroll
                    for (int i = 0; i < 16; ++i) tv[i] = tn[i];
                    cur = nxt; it = nx;
                }
            }
            for (int i = bid * 512 + tid; i < 2 * 240 * 512; i += G * 512) {
                const int l = i / (240 * 512), r = i - l * 240 * 512;
                ((u32x4*)(ws + WS_WIN + l * SZ_WIN + (size_t)NIN * DM * 2))[r] = (u32x4){0u, 0u, 0u, 0u};
            }
            for (int i = bid * 512 + tid; i < 2049 * 32; i += G * 512) rope_entry(rope, i);
            for (int i = bid * 512 + tid; i < 2 * MR; i += G * 512) RSq[i] = 0.f;
            for (int m = gw; m < MREAL + 2048; m += NGW) {
                if (m < TP) norm_row(x_prompt + (size_t)m * DM, a.in[8], XN + (size_t)m * DM, nullptr, lane);
                else if (m < MREAL) norm_row(x_sample + (size_t)(m - TP) * DM, a.in[8], XN + (size_t)m * DM, nullptr, lane);
                else { const int mm = m - MREAL, l = mm >> 10, r = mm & 1023;
                       norm_row(mem_prompt + (size_t)r * DM, a.in[14] + l * DM, (bf16_t*)(ws + WS_MN + l * SZ_MN) + (size_t)r * DM, nullptr, lane); }
            }
        }
        if (a.ph_hi > 1) GRID_SYNC();
        if (a.ph_hi > 1000) cg::this_grid().sync();
    }
    for (int ph = a.ph_lo < 1 ? 1 : a.ph_lo, rep = 0; ph < a.ph_hi; ) {
        int tidp = threadIdx.x; asm volatile("" : "+v"(tidp));
        const int tid = tidp, lane = tid & 63, wave = __builtin_amdgcn_readfirstlane(tid >> 6);
        {
            const int l = (ph - 1) / 6, k = (ph - 1) % 6;
            if (k == 5 && l == 0) { ++ph; continue; }
            if (k == 0) {
                if (PHM(1)) {
                    pg8::Gemm g{XN, (const bf16_t*)(ws + WS_WIN + l * SZ_WIN), TP, NP, DM, (const bf16_t*)(ws + WS_MN + l * SZ_MN), (const bf16_t*)(ws + WS_WMEM + l * SZ_WMEM)};
                    InMemOrder S; S.init(G, bid);
                    EpiInMem E{EpiIn{Hb, rope, a.out + O_KP + (size_t)l * 131072, a.out + O_VP + (size_t)l * 131072, l == 0 ? nullptr : RSq},
                               EpiMem{(bf16_t*)(ws + WS_MKV + l * SZ_MKV), a.out + O_MKP + (size_t)l * 1048576, a.out + O_MVP + (size_t)l * 1048576}};
                    pg8::gemm_phase<EpiInMem, InMemOrder, true, true>((PG8_LAS unsigned char*)lds, g, S, E);
                }
            } else if (k >= 1 && k <= 3) {
                const float* sinks = a.in[10] + l * 32;
                const float* wg = a.in[11] + l * 16 * 512; const float* bg = a.in[12] + l * 512; const float* gng = a.in[13] + l * 1024;
                const bf16_t* MKV = (const bf16_t*)(ws + WS_MKV + l * SZ_MKV);
                u32x2* Ug = (u32x2*)(ws + WS_U); u32x4* SF = (u32x4*)(ws + WS_SF); unsigned char* IMG = ws + WS_IMG; float* EBLg = (float*)(ws + WS_EBL);
                unsigned* qctr = (unsigned*)(ws + WS_CTL) + 8192 + (ph * 2 + rep) * 64;
#define QUEUE_LOOP_BEGIN(NTOT) { int u = bid; while (u < (NTOT)) { unsigned nxt_ = 0u; if (threadIdx.x == 0) nxt_ = atomicAdd(qctr, 1u) + (unsigned)G;
#define QUEUE_LOOP_END() __syncthreads(); if (threadIdx.x == 0) bst[2] = nxt_; __syncthreads(); u = (int)bst[2]; } }
                if (k == 1) {
                    EpiInS ES{Hb, rope, a.out + O_KS + (size_t)l * 1048576, a.out + O_VS + (size_t)l * 1048576, l == 0 ? nullptr : RSq};
                    QUEUE_LOOP_BEGIN(256 + 512 + NP / 32)
                        int tid = tidp; asm volatile("" : "+v"(tid));
                        if (u < 256) { if (PHM(4)) mem_unit(lds, Hb, MKV, Gt, u, tid); }
                        else if (u < 768) { if (PHM(3)) gla_prep_unit(lds, Hb, wg, bg, Ug, EBLg, IMG, u - 256, tid); }
                        else skinny_task<EpiInS>(lds, XN + (size_t)TP * DM, (const bf16_t*)(ws + WS_WIN + l * SZ_WIN), u - 768, tid, ES);
                    QUEUE_LOOP_END()
                } else if (k == 2) {
                    const bool dsel = (DUP_SEL != 0 && rep == 1 && ph == DUP_PH);
                    if (PHM(3) && (!dsel || DUP_SEL == 5)) { for (int tt = bid * 8 + wave; tt < 2048; tt += G * 8) gla_scan_task(Ug, EBLg, (u32x2*)SF, a.out + O_SP + (size_t)l * 524288, tt, lane); }
                    QUEUE_LOOP_BEGIN(256 + 384)
                        int tid = tidp; asm volatile("" : "+v"(tid));
                        const int utype = u < 256 ? 1 : (u < 384 ? 2 : (u < 512 ? 3 : 4));
                        if (dsel && utype != DUP_SEL) {}
                        else if (u < 256) { if (PHM(5)) swa_unit(lds, Hb, Gt, sinks, u, tid); }
                        else if (!PHM(6)) {}
                        else if (u < 384) s_mem_unit(lds, Hb, Gt, a.in[6] + (size_t)l * 8388608, a.in[7] + (size_t)l * 8388608, u - 256, tid);
                        else if (u < 512) s_gla_unit(lds, Hb, Gt, wg, bg, gng, a.in[5] + (size_t)l * 4194304, a.out + O_SS + (size_t)l * 4194304, u - 384, tid);
                        else s_swa_unit(lds, Hb, Gt, a.in[3] + (size_t)l * 1048576, a.in[4] + (size_t)l * 1048576, sinks, a.out + O_KS + (size_t)l * 1048576, a.out + O_VS + (size_t)l * 1048576, u - 512, tid);
                    QUEUE_LOOP_END()
                } else {
                    EpiResS ES{l == 0 ? x_sample : X1 + (size_t)TP * DM, (l == 0 ? X1 : a.out) + (size_t)TP * DM, l == 0 ? a.in[8] + DM : a.in[17], XN, RSq + l * MR, l};
                    QUEUE_LOOP_BEGIN(512 + DM / 32)
                        int tid = tidp; asm volatile("" : "+v"(tid));
                        if (u < 512) { if (PHM(3)) gla_out_unit(lds, Hb, Gt, gng, SF, IMG, u, tid); }
                        else skinny_task<EpiResS>(lds, Gt + (size_t)TP * DM, (const bf16_t*)(ws + WS_WOUT + l * SZ_WOUT), u - 512, tid, ES);
                    QUEUE_LOOP_END()
                }
                __syncthreads();
            } else if (k == 4) { if (PHM(7)) {
                pg8::Gemm g{Gt, (const bf16_t*)(ws + WS_WOUT + l * SZ_WOUT), TP, DM, DM, nullptr, nullptr};
                PanelOrder S; S.init(G, bid);
                if (l == 0) {
                    EpiRes E{x_prompt, nullptr, a.in[8] + DM, XN, RSq, 0};
                    pg8::gemm_phase<EpiRes, PanelOrder, true, true>((PG8_LAS unsigned char*)lds, g, S, E);
                } else {
                    if (bid < TS) {
                        const int row = TP + bid;
                        const float rs = __builtin_amdgcn_rsqf(RSq[MR + row] * (1.f / DM) + EPS);
                        f32x4* yr = (f32x4*)(a.out + (size_t)row * DM);
                        const f32x4 y0 = yr[tid], y1 = yr[tid + 512];
                        yr[tid] = y0 * rs; yr[tid + 512] = y1 * rs;
                    }
                    EpiFin E{XN, a.in[8] + DM, a.out, a.in[17], RSq + MR, (unsigned*)(ws + WS_CTL) + 4096};
                    pg8::gemm_phase<EpiFin, PanelOrder, true, true>((PG8_LAS unsigned char*)lds, g, S, E);
                }
            } } else if (PHM(8)) {
                const int gw = bid * 8 + wave, NGW = G * 8;
                for (int m = gw; m < MREAL; m += NGW) {
                    if (l == 0) norm_row(X1 + (size_t)m * DM, a.in[8] + DM, XN + (size_t)m * DM, nullptr, lane);
                    else {
                        const float rs = __builtin_amdgcn_rsqf(RSq[MR + m] * (1.f / DM) + EPS);
                        f32x4* yr = (f32x4*)(a.out + (size_t)m * DM) + lane;
                        f32x4 yv[16];
#pragma unroll
                        for (int j = 0; j < 16; ++j) yv[j] = yr[64 * j];
#pragma unroll
                        for (int j = 0; j < 16; ++j) yr[64 * j] = yv[j] * rs;
                    }
                }
            }
        }
        if (ph + 1 < a.ph_hi) { GRID_SYNC(); if (DUP_SYNC) { GRID_SYNC(); } }
        if (DUP_PH != 0 && ph == DUP_PH && rep == 0) rep = 1; else ++ph;
    }
}

extern "C" void kernel_launch(void* const* d_in, const int* in_sizes, int n_in, void* d_out, int out_size, void* d_ws, size_t ws_size, hipStream_t stream) {
    static int grid = 0;
    if (grid == 0) {
        if (n_in != 18 || (size_t)out_size != O_END || ws_size < WS_END) { fprintf(stderr, "kernel_launch: unexpected shapes (n_in %d, out %d, ws %zu); nothing launched\n", n_in, out_size, ws_size); grid = -1; return; }
        int dev = 0, cus = 0, per_cu = 0;
        if (hipGetDevice(&dev) != hipSuccess || hipDeviceGetAttribute(&cus, hipDeviceAttributeMultiprocessorCount, dev) != hipSuccess) { grid = -1; return; }
        if (hipFuncSetAttribute((const void*)mk_fwd, hipFuncAttributeMaxDynamicSharedMemorySize, LDS_BYTES) != hipSuccess) { fprintf(stderr, "kernel_launch: hipFuncSetAttribute failed\n"); grid = -1; return; }
        if (hipOccupancyMaxActiveBlocksPerMultiprocessor(&per_cu, (const void*)mk_fwd, 512, LDS_BYTES) != hipSuccess || per_cu < 1) { fprintf(stderr, "kernel_launch: occupancy query says %d\n", per_cu); per_cu = 1; }
        (void)hipGetLastError();
        grid = cus * per_cu;
    }
    if (grid < 0) return;
    if (hipMemsetAsync((char*)d_ws + WS_CTL, 0, CTL_BYTES, stream) != hipSuccess) { fprintf(stderr, "kernel_launch: memset failed\n"); return; }
    Args a{};
    for (int i = 0; i < 18; ++i) a.in[i] = (const float*)d_in[i];
    a.out = (float*)d_out; a.ws = (unsigned char*)d_ws;
#if MK_ONE_LAUNCH
    a.ph_lo = 0; a.ph_hi = N_PHASES;
    void* args[] = {&a};
    hipError_t e = hipLaunchCooperativeKernel((const void*)mk_fwd, dim3(grid), dim3(512), args, LDS_BYTES, stream);
    if (e != hipSuccess) fprintf(stderr, "kernel_launch: cooperative launch failed: %s (grid %d)\n", hipGetErrorString(e), grid);
#else
    for (int ph = 0; ph < N_PHASES; ++ph) {
        a.ph_lo = ph; a.ph_hi = ph + 1;
        hipLaunchKernelGGL(mk_fwd, dim3(grid), dim3(512), LDS_BYTES, stream, a);
    }
#endif
}
```

```cpp
#include <hip/hip_runtime.h>
#include <hip/hip_cooperative_groups.h>
#include <cstdio>
#include <cstdint>
namespace cg = cooperative_groups;
#define MK_ONE_LAUNCH 1
namespace pg8 {
#define PG8_LAS __attribute__((address_space(3)))
typedef unsigned short bf16_t;
typedef short bf16x8 __attribute__((ext_vector_type(8)));
typedef float f32x4 __attribute__((ext_vector_type(4)));
typedef unsigned u32x4 __attribute__((ext_vector_type(4)));
constexpr int BM = 256, BK = 64, HALF = 128, HTB = HALF * BK * 2  , STAGE_BYTES = 8 * HTB, NXCD = 8, WGM = 8;

__host__ __device__ __forceinline__ int lds_byte(int r, int c) { const int st = (r >> 4) * 2 + (c >> 5), rr = r & 15, cc = c & 31, ob = rr * 64 + cc * 2; return st * 1024 + (ob ^ (((ob >> 9) & 1) << 5)); }
__host__ __device__ __forceinline__ void stage_rc(int b, int& R, int& C) { const int st = b / 1024, sb = b % 1024, swz = sb ^ (((sb >> 9) & 1) << 5); R = (st >> 1) * 16 + swz / 64; C = (st & 1) * 32 + (swz % 64) / 2; }
__host__ __device__ __forceinline__ int perm32(int rho) { const int n = rho >> 4, i = rho & 15; return 8 * (i >> 2) + 4 * n + (i & 3); }

struct Unit { int pm, pn, sel; };
struct Gemm { const bf16_t* A; const bf16_t* Bt; int M, N, K; const bf16_t* A2; const bf16_t* Bt2; };

struct StaticOrder {
    int nM, nN, nwg, G, c;
    __host__ __device__ void init(int M, int N, int G_, int c_) { nM = M / BM; nN = N / BM; nwg = nM * nN; G = G_; c = c_; }
    __host__ __device__ bool next(int i, Unit& u) const {
        const long L = (long)i * G + c; if (L >= nwg) return false;
        int wgid = (int)L; { const int q = nwg / NXCD, r = nwg % NXCD, xcd = wgid % NXCD, off = wgid / NXCD; wgid = (xcd < r ? xcd * (q + 1) : r * (q + 1) + (xcd - r) * q) + off; }
        const int nig = WGM * nN, gid = wgid / nig, fm = gid * WGM, gsz = (nM - fm) < WGM ? (nM - fm) : WGM;
        u.pm = fm + ((wgid % nig) % gsz); u.pn = (wgid % nig) / gsz; u.sel = 0; return true;
    }
    __device__ __forceinline__ void a_ready(const Unit&) const {}
    __device__ __forceinline__ void done(const Unit&) const {}
};

__device__ __forceinline__ unsigned cvt_pk_bf16(float lo, float hi) { unsigned r; asm volatile("v_cvt_pk_bf16_f32 %0, %1, %2" : "=v"(r) : "v"(lo), "v"(hi)); return r; }
typedef float f32x2 __attribute__((ext_vector_type(2)));
template <class Epi, class Sched, bool ALIGN_EPI = false, bool SP2 = false>
__device__ __forceinline__ void gemm_phase(PG8_LAS unsigned char* lds, const Gemm g, const Sched& S, const Epi& E) {
    int tid_ = threadIdx.x; asm volatile("" : "+v"(tid_));
    const int tid = tid_, wid = __builtin_amdgcn_readfirstlane(tid >> 6), lane = tid & 63, wr = wid >> 2, wc = wid & 3, fr = lane & 15, fq = lane >> 4;
    const int K = g.K, nt = K / BK;
    unsigned voffA[2], voffB[2];
#pragma unroll
    for (int i = 0; i < 2; ++i) { int R, C; stage_rc(tid * 16 + i * 8192, R, C); const int Rb = Epi::PERM ? ((R & ~31) + perm32(R & 31)) : R;
        voffA[i] = (unsigned)(R * K + C) * 2u; voffB[i] = (unsigned)(Rb * K + C) * 2u; }
    const size_t kstep = (size_t)(BK * 2);
    const size_t hstep = (size_t)HALF * K * 2;
    const size_t tstep = 2 * hstep;
    const unsigned ldsw = (unsigned)wid * 1024u;
    const int aoff = lds_byte(wr * 64 + fr, fq * 8), boff = lds_byte(wc * 32 + fr, fq * 8);
#define PG8_SA(b, h) (((b) * 2 + (h)) * HTB)
#define PG8_SB(b, h) ((4 + (b) * 2 + (h)) * HTB)
#define PG8_STAGE(bufoff, gbase, voff) do { _Pragma("unroll") for (int _i = 0; _i < 2; ++_i) \
        __builtin_amdgcn_global_load_lds((const unsigned*)((const char*)(gbase) + (voff)[_i]), (PG8_LAS unsigned*)(lds + (bufoff) + ldsw + _i * 8192), 16, 0, 0); } while (0)
#define PG8_LDA(dst, b, h) do { _Pragma("unroll") for (int m = 0; m < 4; ++m) _Pragma("unroll") for (int k = 0; k < 2; ++k) dst[m][k] = *(const PG8_LAS bf16x8*)(lds + PG8_SA(b, h) + aoff + m * 2048 + k * 1024); } while (0)
#define PG8_LDB(dst, b, h) do { _Pragma("unroll") for (int n = 0; n < 2; ++n) _Pragma("unroll") for (int k = 0; k < 2; ++k) dst[n][k] = *(const PG8_LAS bf16x8*)(lds + PG8_SB(b, h) + boff + n * 2048 + k * 1024); } while (0)
#define PG8_MMA(ai, bj, At, Bt) do { __builtin_amdgcn_s_setprio(1); _Pragma("unroll") for (int m = 0; m < 4; ++m) _Pragma("unroll") for (int n = 0; n < 2; ++n) _Pragma("unroll") for (int k = 0; k < 2; ++k) \
        acc[ai][bj][m][n] = __builtin_amdgcn_mfma_f32_16x16x32_bf16(Bt[n][k], At[m][k], acc[ai][bj][m][n], 0, 0, 0); __builtin_amdgcn_s_setprio(0); } while (0)
#define PG8_WAIT_V(n) asm volatile("s_waitcnt vmcnt(" #n ")" ::: "memory")
#define PG8_WAIT_L(n) asm volatile("s_waitcnt lgkmcnt(" #n ")" ::: "memory")
#define PG8_BAR __builtin_amdgcn_s_barrier()
#define PG8_SCHED __builtin_amdgcn_sched_barrier(0)
    Unit cur, nxt; int ui = 0;
    if (!S.next(0, cur)) return;
    f32x4 acc[2][2][4][2];
#pragma unroll
    for (int a = 0; a < 2; ++a)
#pragma unroll
        for (int b = 0; b < 2; ++b)
#pragma unroll
            for (int m = 0; m < 4; ++m)
#pragma unroll
                for (int n = 0; n < 2; ++n) acc[a][b][m][n] = (f32x4){0.f, 0.f, 0.f, 0.f};
    bf16x8 At[4][2], B0[2][2], B1[2][2];
    const char* cA = (const char*)(cur.sel ? g.A2 : g.A) + (size_t)cur.pm * tstep; const char* cB = (const char*)(cur.sel ? g.Bt2 : g.Bt) + (size_t)cur.pn * tstep;
    S.a_ready(cur);
    if constexpr (SP2) {
        PG8_STAGE(PG8_SB(0, 0), cB, voffB); PG8_STAGE(PG8_SB(0, 1), cB + hstep, voffB); PG8_STAGE(PG8_SA(0, 0), cA, voffA); PG8_STAGE(PG8_SA(0, 1), cA + hstep, voffA);
        if (wr == 1) PG8_BAR;
        PG8_WAIT_V(2); PG8_BAR;
        PG8_STAGE(PG8_SB(1, 0), cB + kstep, voffB); PG8_STAGE(PG8_SA(1, 0), cA + kstep, voffA); PG8_STAGE(PG8_SB(1, 1), cB + hstep + kstep, voffB);
        PG8_WAIT_V(6); PG8_BAR;
    } else {
        PG8_STAGE(PG8_SB(0, 0), cB, voffB); PG8_STAGE(PG8_SA(0, 0), cA, voffA); PG8_STAGE(PG8_SB(0, 1), cB + hstep, voffB); PG8_STAGE(PG8_SA(0, 1), cA + hstep, voffA);
        if (wr == 1) PG8_BAR;
        PG8_WAIT_V(4); PG8_BAR;
        PG8_STAGE(PG8_SB(1, 0), cB + kstep, voffB); PG8_STAGE(PG8_SA(1, 0), cA + kstep, voffA); PG8_STAGE(PG8_SB(1, 1), cB + hstep + kstep, voffB);
        PG8_WAIT_V(6); PG8_BAR;
    }
    for (;;) {
        const bool has_next = S.next(ui + 1, nxt);
        const char* nA = has_next ? (const char*)(nxt.sel ? g.A2 : g.A) + (size_t)nxt.pm * tstep : cA; const char* nB = has_next ? (const char*)(nxt.sel ? g.Bt2 : g.Bt) + (size_t)nxt.pn * tstep : cB;
        for (int t = 0; t < nt; t += 2) {
            const bool last = (t == nt - 2);
            const char* a1 = cA + (size_t)(t + 1) * kstep;
            const char* a2 = last ? nA : cA + (size_t)(t + 2) * kstep; const char* b2 = last ? nB : cB + (size_t)(t + 2) * kstep;
            const char* a3 = a2 + kstep; const char* b3 = b2 + kstep;
            if (last && has_next) S.a_ready(nxt);
            if constexpr (SP2) {
            PG8_LDB(B0, 0, 0); PG8_LDB(B1, 0, 1); PG8_SCHED; PG8_LDA(At, 0, 0); PG8_STAGE(PG8_SA(1, 1), a1 + hstep, voffA);
            PG8_WAIT_V(8); PG8_WAIT_L(0); PG8_BAR; PG8_MMA(0, 0, At, B0); PG8_MMA(0, 1, At, B1); PG8_BAR; PG8_SCHED;
            PG8_LDA(At, 0, 1); PG8_STAGE(PG8_SB(0, 0), b2, voffB); PG8_STAGE(PG8_SB(0, 1), b2 + hstep, voffB); PG8_STAGE(PG8_SA(0, 0), a2, voffA);
            PG8_WAIT_V(8); PG8_WAIT_L(0); PG8_BAR; PG8_MMA(1, 0, At, B0); PG8_MMA(1, 1, At, B1); PG8_BAR; PG8_SCHED;
            PG8_LDB(B0, 1, 0); PG8_LDB(B1, 1, 1); PG8_SCHED; PG8_LDA(At, 1, 0); PG8_STAGE(PG8_SA(0, 1), a2 + hstep, voffA);
            PG8_WAIT_V(8); PG8_WAIT_L(0); PG8_BAR; PG8_MMA(0, 0, At, B0); PG8_MMA(0, 1, At, B1); PG8_BAR; PG8_SCHED;
            PG8_LDA(At, 1, 1); PG8_STAGE(PG8_SB(1, 0), b3, voffB); PG8_STAGE(PG8_SB(1, 1), b3 + hstep, voffB); PG8_STAGE(PG8_SA(1, 0), a3, voffA);
            PG8_WAIT_V(8); PG8_WAIT_L(0); PG8_BAR; PG8_MMA(1, 0, At, B0); PG8_MMA(1, 1, At, B1); PG8_BAR; PG8_SCHED;
            } else {
            PG8_LDB(B0, 0, 0); PG8_SCHED; PG8_LDA(At, 0, 0); PG8_STAGE(PG8_SA(1, 1), a1 + hstep, voffA);
            PG8_WAIT_L(8); PG8_BAR; PG8_WAIT_L(0); PG8_MMA(0, 0, At, B0); PG8_BAR; PG8_SCHED;
            PG8_LDB(B1, 0, 1); PG8_STAGE(PG8_SB(0, 0), b2, voffB);
            PG8_BAR; PG8_WAIT_L(0); PG8_MMA(0, 1, At, B1); PG8_BAR;
            PG8_LDA(At, 0, 1); PG8_STAGE(PG8_SA(0, 0), a2, voffA);
            PG8_BAR; PG8_WAIT_L(0); PG8_MMA(1, 0, At, B0); PG8_BAR; PG8_SCHED;
            PG8_STAGE(PG8_SB(0, 1), b2 + hstep, voffB);
            PG8_WAIT_V(6); PG8_BAR; PG8_MMA(1, 1, At, B1); PG8_BAR;
            PG8_LDB(B0, 1, 0); PG8_SCHED; PG8_LDA(At, 1, 0); PG8_STAGE(PG8_SA(0, 1), a2 + hstep, voffA);
            PG8_WAIT_L(8); PG8_BAR; PG8_WAIT_L(0); PG8_MMA(0, 0, At, B0); PG8_BAR; PG8_SCHED;
            PG8_LDB(B1, 1, 1); PG8_STAGE(PG8_SB(1, 0), b3, voffB);
            PG8_BAR; PG8_WAIT_L(0); PG8_MMA(0, 1, At, B1); PG8_BAR;
            PG8_LDA(At, 1, 1); PG8_STAGE(PG8_SA(1, 0), a3, voffA);
            PG8_BAR; PG8_WAIT_L(0); PG8_MMA(1, 0, At, B0); PG8_BAR; PG8_SCHED;
            PG8_STAGE(PG8_SB(1, 1), b3 + hstep, voffB);
            PG8_WAIT_V(6); PG8_BAR; PG8_MMA(1, 1, At, B1); PG8_BAR;
            }
        }
        if constexpr (ALIGN_EPI) { if (wr == 0) PG8_BAR; }
        if constexpr (!Epi::AFTER_DRAIN) { E(acc, cur, wr, wc, fr, fq); S.done(cur); }
        if (!has_next) break;
#pragma unroll
        for (int a = 0; a < 2; ++a)
#pragma unroll
            for (int b = 0; b < 2; ++b)
#pragma unroll
                for (int m = 0; m < 4; ++m)
#pragma unroll
                    for (int n = 0; n < 2; ++n) acc[a][b][m][n] = (f32x4){0.f, 0.f, 0.f, 0.f};
        cur = nxt; cA = nA; cB = nB; ++ui;
        if constexpr (ALIGN_EPI) { if (wr == 1) PG8_BAR; }
    }
    PG8_WAIT_V(0);
    if constexpr (!ALIGN_EPI) { if (wr == 0) PG8_BAR; }
    PG8_BAR;
    if constexpr (Epi::AFTER_DRAIN) { E.fused(acc, cur, wr, wc, fr, fq, lds, wid, lane); S.done(cur); }
#undef PG8_SA
#undef PG8_SB
#undef PG8_STAGE
#undef PG8_LDA
#undef PG8_LDB
#undef PG8_MMA
#undef PG8_WAIT_V
#undef PG8_WAIT_L
#undef PG8_BAR
#undef PG8_SCHED
}
}
#define LAS __attribute__((address_space(3)))
#define XB_TMO      128
#define XB_XCNT(j)  (256  + 64 * (j))
#define XB_XSUB(j)  (1280 + 64 * (j))
#define XB_XGEN(j)  (2304 + 64 * (j))
#define XB_TOP      3328
#define XB_TOPGEN   3392
#define XCD_BAR_WORDS 3456
#define XB_SPIN_CAP (1u << 18)

__device__ __forceinline__ unsigned xb_ld(unsigned* p)              { return __hip_atomic_load(p, __ATOMIC_RELAXED, __HIP_MEMORY_SCOPE_AGENT); }
__device__ __forceinline__ unsigned xb_add(unsigned* p, unsigned v) { return __hip_atomic_fetch_add(p, v, __ATOMIC_RELAXED, __HIP_MEMORY_SCOPE_AGENT); }
__device__ __forceinline__ unsigned xb_xcc_id() { return (unsigned)__builtin_amdgcn_s_getreg((3 << 11) | 20) & 0xFu; }
#define XB_SPIN(cond, bar) do { unsigned _sp = 0; while (cond) { __builtin_amdgcn_s_sleep(1); \
    if ((++_sp & 255u) == 0u) { if (xb_ld(&(bar)[XB_TMO])) break; if (_sp > XB_SPIN_CAP) { atomicAdd(&(bar)[XB_TMO], 1u); break; } } } } while (0)

struct XcdBarrier {
    unsigned* bar; unsigned x;
    volatile LAS unsigned* st;
};

__device__ __forceinline__ XcdBarrier xcd_barrier_post(unsigned* bar, volatile LAS unsigned* st) {
    XcdBarrier b; b.bar = bar; b.x = xb_xcc_id(); b.st = st;
    if (threadIdx.x == 0) (void)xb_add(&bar[XB_XCNT(b.x)], 1u);
    return b;
}
__device__ __forceinline__ void xcd_barrier_complete(unsigned* bar, unsigned x, unsigned& nloc, unsigned& nx) {
    const unsigned G = gridDim.x * gridDim.y * gridDim.z;
    unsigned sum, cnt, mine, sp = 0u;
    for (;;) {
        sum = 0u; cnt = 0u; mine = 0u;
#pragma unroll
        for (unsigned j = 0; j < 16; ++j) { const unsigned c = xb_ld(&bar[XB_XCNT(j)]); sum += c; cnt += (c > 0u) ? 1u : 0u; mine = (j == x) ? c : mine; }
        if (sum == G) break;
        __builtin_amdgcn_s_sleep(1);
        if ((++sp & 255u) == 0u) { if (xb_ld(&bar[XB_TMO])) break; if (sp > XB_SPIN_CAP) { atomicAdd(&bar[XB_TMO], 1u); break; } }
    }
    nloc = mine > 0u ? mine : 1u; nx = cnt > 0u ? cnt : 1u;
}

__device__ __forceinline__ void xcd_barrier(const XcdBarrier& b) {
    asm volatile("s_waitcnt vmcnt(0)" ::: "memory");
    __syncthreads();
    if (threadIdx.x == 0) {
        unsigned* bar = b.bar;
        __builtin_amdgcn_s_waitcnt(0);
        unsigned nloc = b.st[0], nx = b.st[1];
        if (nloc == 0u) { xcd_barrier_complete(bar, b.x, nloc, nx); b.st[0] = nloc; b.st[1] = nx; }
        const unsigned old = xb_add(&bar[XB_XSUB(b.x)], 1u);
        const unsigned gen = old / nloc;
        if (old + 1u == (gen + 1u) * nloc) {
            __builtin_amdgcn_fence(__ATOMIC_RELEASE, "agent");
            asm volatile("s_waitcnt vmcnt(0)" ::: "memory");
            const unsigned og = xb_add(&bar[XB_TOP], 1u);
            const unsigned tg = og / nx;
            if (og + 1u == (tg + 1u) * nx) xb_add(&bar[XB_TOPGEN], 1u);
            else XB_SPIN(xb_ld(&bar[XB_TOPGEN]) == tg, bar);
            __builtin_amdgcn_fence(__ATOMIC_ACQUIRE, "agent");
            xb_add(&bar[XB_XGEN(b.x)], 1u);
            asm volatile("s_waitcnt vmcnt(0)" ::: "memory");
        } else {
            XB_SPIN(xb_ld(&bar[XB_XGEN(b.x)]) == gen, bar);
            __builtin_amdgcn_fence(__ATOMIC_ACQUIRE, "agent");
            asm volatile("s_waitcnt vmcnt(0)" ::: "memory");
        }
    }
    __syncthreads();
}

#define DI __device__ __forceinline__
typedef unsigned short bf16_t;
typedef short bf16x8 __attribute__((ext_vector_type(8)));
typedef short s16x4 __attribute__((ext_vector_type(4)));
typedef float f32x4 __attribute__((ext_vector_type(4)));
typedef unsigned u32x4 __attribute__((ext_vector_type(4)));
typedef unsigned u32x2 __attribute__((ext_vector_type(2)));
typedef float f32x2_t __attribute__((ext_vector_type(2)));
typedef __bf16 bf16x2_t __attribute__((ext_vector_type(2)));

constexpr int DM = 4096, TP = 8192, SEQ = 2048, NBATCH = 4, TS = 32, MR = 8448, MREAL = 8224, NP = 9984, NIN = 9744;
constexpr int C_SQ = 0, C_SK = 2048, C_SV = 2304, C_SG = 2560, C_GQ = 4608, C_GK = 5120, C_GV = 5632, C_GG = 6656, C_MQ = 7680, C_MG = 8704, C_LR = 9728;
constexpr float EPS = 1e-6f;
constexpr size_t O_YP = 0, O_YS = 33554432, O_KP = 33685504, O_VP = 33947648, O_SP = 34209792, O_MKP = 35258368, O_MVP = 37355520, O_KS = 39452672, O_VS = 41549824, O_SS = 43646976, O_END = 52035584;
constexpr size_t MiB = 1u << 20;
constexpr size_t WS_WIN = 0;
constexpr size_t SZ_WIN = (size_t)NP * DM * 2;
constexpr size_t WS_WOUT = 160 * MiB;
constexpr size_t SZ_WOUT = (size_t)DM * DM * 2;
constexpr size_t WS_WMEM = 224 * MiB;
constexpr size_t SZ_WMEM = (size_t)2048 * DM * 2;
constexpr size_t WS_XN = 256 * MiB;
constexpr size_t WS_MN = 324 * MiB;
constexpr size_t SZ_MN = (size_t)1024 * DM * 2;
constexpr size_t WS_H = 340 * MiB;
constexpr size_t WS_MKV = 502 * MiB;
constexpr size_t SZ_MKV = (size_t)1024 * 2048 * 2;
constexpr size_t WS_G = 510 * MiB;
constexpr size_t WS_X1 = 576 * MiB;
constexpr size_t WS_ROPE = 708 * MiB;
constexpr size_t WS_U = 710 * MiB;
constexpr size_t WS_SF = 774 * MiB;
constexpr size_t WS_IMG = 806 * MiB;
constexpr size_t WS_EBL = 838 * MiB;
constexpr size_t WS_RS = 838 * MiB + 524288;
constexpr size_t WS_CTL = 839 * MiB;
constexpr size_t CTL_BYTES = 65536;
constexpr size_t WS_END = 840 * MiB;
static_assert(WS_WIN + 2 * SZ_WIN <= WS_WOUT && WS_XN + (size_t)MR * DM * 2 <= WS_MN && WS_H + (size_t)MR * NP * 2 <= WS_MKV && WS_G + (size_t)MR * DM * 2 <= WS_X1 && WS_X1 + (size_t)MR * DM * 4 <= WS_ROPE, "ws map");

constexpr int LDS_BYTES = 147456;

DI float bf2f(unsigned short u) { return __uint_as_float((unsigned)u << 16); }
DI float bflo(unsigned w) { return __uint_as_float(w << 16); }
DI float bfhi(unsigned w) { return __uint_as_float(w & 0xffff0000u); }
DI unsigned pk2(float lo, float hi) { f32x2_t v = {lo, hi}; bf16x2_t b = __builtin_convertvector(v, bf16x2_t); return __builtin_bit_cast(unsigned, b); }
DI unsigned short f2bf(float f) { return (unsigned short)(pk2(f, 0.f) & 0xffffu); }
DI float silu(float x) { return x * __builtin_amdgcn_rcpf(1.f + __expf(-x)); }
DI float wave_sum(float v) {
#pragma unroll
    for (int o = 1; o < 64; o <<= 1) v += __shfl_xor(v, o);
    return v;
}
DI float wave_max(float v) {
#pragma unroll
    for (int o = 1; o < 64; o <<= 1) v = fmaxf(v, __shfl_xor(v, o));
    return v;
}
DI f32x4 mfma16(bf16x8 a, bf16x8 b, f32x4 c) { return __builtin_amdgcn_mfma_f32_16x16x32_bf16(a, b, c, 0, 0, 0); }
DI bf16x8 pack8(f32x4 a, f32x4 b) { u32x4 p; p.x = pk2(a[0], a[1]); p.y = pk2(a[2], a[3]); p.z = pk2(b[0], b[1]); p.w = pk2(b[2], b[3]); return __builtin_bit_cast(bf16x8, p); }
DI bf16x8 cat4(s16x4 lo, s16x4 hi) { return __builtin_shufflevector(lo, hi, 0, 1, 2, 3, 4, 5, 6, 7); }

struct Args {
    const float* in[18]; float* out; unsigned char* ws; int ph_lo, ph_hi;
};

struct EpiIn {
    static constexpr bool PERM = true, AFTER_DRAIN = false;
    bf16_t* H; const float* rope; float* kp; float* vp; const float* RSin;
    DI void operator()(const f32x4 (&acc)[2][2][4][2], const pg8::Unit& u, int wr, int wc, int fr, int fq) const {
        const int pn = u.pn;
        const bool do_rope = pn < 9;
        float sc = 1.f;
        if (pn < 8) sc = 0.125f; else if (pn == 18 || pn == 19) sc = 0.08838834764831845f; else if (pn >= 30 && pn < 34) sc = 0.0625f;
        const int row0 = u.pm * 256 + wr * 64 + fr;
        const int colt = wc * 32 + 8 * fq;
#pragma unroll
        for (int ai = 0; ai < 2; ++ai) {
            f32x4 tr[4][2];
#pragma unroll
            for (int m = 0; m < 4; ++m) {
                tr[m][0] = (f32x4){1.f, 0.f, 1.f, 0.f}; tr[m][1] = (f32x4){1.f, 0.f, 1.f, 0.f};
                if (do_rope) {
                    const f32x4* rp = (const f32x4*)(rope + ((size_t)((row0 + ai * 128 + m * 16) & (SEQ - 1)) * 32 + 16 * (wc & 1) + 4 * fq) * 2);
                    tr[m][0] = rp[0]; tr[m][1] = rp[1];
                }
            }
            float rsv[4];
#pragma unroll
            for (int m = 0; m < 4; ++m) { rsv[m] = sc; if (RSin) rsv[m] = sc * __builtin_amdgcn_rsqf(RSin[row0 + ai * 128 + m * 16] * (1.f / DM) + EPS); }
#pragma unroll
            for (int m = 0; m < 4; ++m) {
                const int row = row0 + ai * 128 + m * 16;
                const f32x4 t0 = tr[m][0], t1 = tr[m][1];
#pragma unroll
                for (int bj = 0; bj < 2; ++bj) {
                    f32x4 v0 = acc[ai][bj][m][0], v1 = acc[ai][bj][m][1];
                    if (do_rope) {
                        float a, b;
                        a = v0[0]; b = v0[1]; v0[0] = a * t0[0] - b * t0[1]; v0[1] = b * t0[0] + a * t0[1];
                        a = v0[2]; b = v0[3]; v0[2] = a * t0[2] - b * t0[3]; v0[3] = b * t0[2] + a * t0[3];
                        a = v1[0]; b = v1[1]; v1[0] = a * t1[0] - b * t1[1]; v1[1] = b * t1[0] + a * t1[1];
                        a = v1[2]; b = v1[3]; v1[2] = a * t1[2] - b * t1[3]; v1[3] = b * t1[2] + a * t1[3];
                    }
                    v0 = v0 * rsv[m]; v1 = v1 * rsv[m];
                    u32x4 w4; w4.x = pk2(v0[0], v0[1]); w4.y = pk2(v0[2], v0[3]); w4.z = pk2(v1[0], v1[1]); w4.w = pk2(v1[2], v1[3]);
                    if (pn * 256 + bj * 128 + colt < NIN) *(u32x4*)(H + (size_t)row * NP + pn * 256 + bj * 128 + colt) = w4;
                    if (pn == 8 || pn == 9) {
                        const int t = row & (SEQ - 1);
                        if (t >= SEQ - 128) {
                            const int kvh = bj * 2 + (wc >> 1);
                            float* dst = (pn == 8 ? kp : vp) + ((size_t)((row >> 11) * 128 + (t - (SEQ - 128))) * 4 + kvh) * 64;
                            if (pn == 8) {
                                const int d0 = 16 * (wc & 1) + 4 * fq;
                                *(f32x4*)(dst + d0) = (f32x4){v0[0], v0[2], v1[0], v1[2]};
                                *(f32x4*)(dst + d0 + 32) = (f32x4){v0[1], v0[3], v1[1], v1[3]};
                            } else {
                                const int p0 = 32 * (wc & 1) + 8 * fq;
                                *(f32x4*)(dst + p0) = v0; *(f32x4*)(dst + p0 + 4) = v1;
                            }
                        }
                    }
                }
            }
        }
    }
};
struct EpiInS {
    bf16_t* H; const float* rope; float* ks; float* vs; const float* RSin;
    DI void operator()(f32x4 v, int m, int n) const {
        const int pn = n >> 8;
        if (pn < 9) {
            const f32x4 t = *(const f32x4*)(rope + ((size_t)SEQ * 32 + ((n & 63) >> 1)) * 2);
            float a, b;
            a = v[0]; b = v[1]; v[0] = a * t[0] - b * t[1]; v[1] = b * t[0] + a * t[1];
            a = v[2]; b = v[3]; v[2] = a * t[2] - b * t[3]; v[3] = b * t[2] + a * t[3];
        }
        float sc = 1.f;
        if (pn < 8) sc = 0.125f; else if (pn == 18 || pn == 19) sc = 0.08838834764831845f; else if (pn >= 30 && pn < 34) sc = 0.0625f;
        if (RSin) sc *= __builtin_amdgcn_rsqf(RSin[TP + m] * (1.f / DM) + EPS);
        v = v * sc;
        u32x2 w2; w2.x = pk2(v[0], v[1]); w2.y = pk2(v[2], v[3]);
        *(u32x2*)(H + (size_t)(TP + m) * NP + n) = w2;
        if (pn == 8) {
            float* dst = ks + ((size_t)(m * 128 + 127) * 4 + ((n - C_SK) >> 6)) * 64; const int d0 = (n & 63) >> 1;
            dst[d0] = v[0]; dst[d0 + 32] = v[1]; dst[d0 + 1] = v[2]; dst[d0 + 33] = v[3];
        } else if (pn == 9) {
            float* dst = vs + ((size_t)(m * 128 + 127) * 4 + ((n - C_SV) >> 6)) * 64 + (n & 63);
            *(f32x4*)dst = v;
        }
    }
};
struct EpiResS {
    const float* base; float* X; const float* gnext; bf16_t* XNo; float* RS; int fin;
    DI void operator()(f32x4 v, int m, int n) const {
        const f32x4 x = *(const f32x4*)(base + (size_t)m * DM + n) + v;
        if (!fin) *(f32x4*)(X + (size_t)m * DM + n) = x;
        if (gnext) {
            const f32x4 y = x * *(const f32x4*)(gnext + n);
            if (fin) *(f32x4*)(X + (size_t)m * DM + n) = y;
            else { u32x2 w2; w2.x = pk2(y[0], y[1]); w2.y = pk2(y[2], y[3]); *(u32x2*)(XNo + (size_t)(TP + m) * DM + n) = w2; }
            float q = (x[0] * x[0] + x[1] * x[1]) + (x[2] * x[2] + x[3] * x[3]);
            q += __shfl_xor(q, 16); q += __shfl_xor(q, 32);
            if (((n >> 2) & 3) == 0) atomicAdd(RS + TP + m, q);
        }
    }
};
template <class EpiS>
DI void skinny_task(unsigned char* lds, const bf16_t* X, const bf16_t* Wt, int task, int tid, const EpiS& E) {
    const int lane = tid & 63, w = tid >> 6, c16 = lane & 15, quad = lane >> 4;
    const int ntl = w & 1, ksp = w >> 1;
    const int n0 = task * 32 + ntl * 16;
    f32x4 acc0 = {0.f, 0.f, 0.f, 0.f}, acc1 = {0.f, 0.f, 0.f, 0.f};
    const bf16_t* wp = Wt + (size_t)(n0 + c16) * DM + ksp * 1024 + quad * 8;
    const bf16_t* xp0 = X + (size_t)c16 * DM + ksp * 1024 + quad * 8;
    const bf16_t* xp1 = xp0 + 16 * DM;
    for (int k0 = 0; k0 < 32; k0 += 16) {
        bf16x8 av[16], b0v[16], b1v[16];
#pragma unroll
        for (int j = 0; j < 16; ++j) { av[j] = *(const bf16x8*)(wp + (k0 + j) * 32); b0v[j] = *(const bf16x8*)(xp0 + (k0 + j) * 32); b1v[j] = *(const bf16x8*)(xp1 + (k0 + j) * 32); }
#pragma unroll
        for (int j = 0; j < 16; ++j) { acc0 = mfma16(av[j], b0v[j], acc0); acc1 = mfma16(av[j], b1v[j], acc1); }
    }
    f32x4* red = (f32x4*)lds;
    __syncthreads();
    red[(w * 2 + 0) * 64 + lane] = acc0; red[(w * 2 + 1) * 64 + lane] = acc1;
    __syncthreads();
    if (w < 2) {
#pragma unroll
        for (int mt = 0; mt < 2; ++mt) {
            f32x4 v = red[((0 * 2 + w) * 2 + mt) * 64 + lane];
#pragma unroll
            for (int kp = 1; kp < 4; ++kp) v += red[((kp * 2 + w) * 2 + mt) * 64 + lane];
            E(v, mt * 16 + c16, n0 + quad * 4);
        }
    }
}
struct EpiMem {
    static constexpr bool PERM = true, AFTER_DRAIN = false;
    bf16_t* MKV; float* outk; float* outv;
    DI void operator()(const f32x4 (&acc)[2][2][4][2], const pg8::Unit& u, int wr, int wc, int fr, int fq) const {
        const int row0 = u.pm * 256 + wr * 64 + fr;
#pragma unroll
        for (int ai = 0; ai < 2; ++ai)
#pragma unroll
            for (int m = 0; m < 4; ++m) {
                const int row = row0 + ai * 128 + m * 16;
#pragma unroll
                for (int bj = 0; bj < 2; ++bj) {
                    const int col = u.pn * 256 + bj * 128 + wc * 32 + 8 * fq;
                    const f32x4 v0 = acc[ai][bj][m][0], v1 = acc[ai][bj][m][1];
                    u32x4 w4; w4.x = pk2(v0[0], v0[1]); w4.y = pk2(v0[2], v0[3]); w4.z = pk2(v1[0], v1[1]); w4.w = pk2(v1[2], v1[3]);
                    *(u32x4*)(MKV + (size_t)row * 2048 + col) = w4;
                    float* dst = (col < 1024) ? (outk + (size_t)row * 1024 + col) : (outv + (size_t)row * 1024 + (col - 1024));
                    *(f32x4*)dst = v0; *(f32x4*)(dst + 4) = v1;
                }
            }
    }
};
struct EpiRes {
    static constexpr bool PERM = true, AFTER_DRAIN = false;
    const float* baseP; float* X; const float* gnext; bf16_t* XNo; float* RS; int fin;
    DI void operator()(const f32x4 (&acc)[2][2][4][2], const pg8::Unit& u, int wr, int wc, int fr, int fq) const {
        const int row0 = u.pm * 256 + wr * 64 + fr;
        const int col0 = u.pn * 256 + wc * 32 + 8 * fq;
        f32x4 gv[2][2];
#pragma unroll
        for (int bj = 0; bj < 2; ++bj) { gv[bj][0] = (f32x4){0.f, 0.f, 0.f, 0.f}; gv[bj][1] = gv[bj][0];
            if (gnext) { gv[bj][0] = *(const f32x4*)(gnext + col0 + bj * 128); gv[bj][1] = *(const f32x4*)(gnext + col0 + bj * 128 + 4); } }
#pragma unroll
        for (int am = 0; am < 4; ++am) {
            const int ai = am >> 1, mb = (am & 1) * 2;
            f32x4 bv[2][2][2];
#pragma unroll
            for (int mm = 0; mm < 2; ++mm)
#pragma unroll
                for (int bj = 0; bj < 2; ++bj) {
                    const float* bp = baseP + (size_t)(row0 + ai * 128 + (mb + mm) * 16) * DM + col0 + bj * 128;
                    bv[mm][bj][0] = *(const f32x4*)bp; bv[mm][bj][1] = *(const f32x4*)(bp + 4);
                }
#pragma unroll
            for (int mm = 0; mm < 2; ++mm) {
                const int m = mb + mm;
                const int row = row0 + ai * 128 + m * 16;
                float q = 0.f;
#pragma unroll
                for (int bj = 0; bj < 2; ++bj) {
                    float* xp = X + (size_t)row * DM + col0 + bj * 128;
                    const f32x4 x0 = bv[mm][bj][0] + acc[ai][bj][m][0], x1 = bv[mm][bj][1] + acc[ai][bj][m][1];
                    if (!fin && X) { *(f32x4*)xp = x0; *(f32x4*)(xp + 4) = x1; }
                    if (gnext) {
                        const f32x4 y0 = x0 * gv[bj][0], y1 = x1 * gv[bj][1];
                        if (fin) { *(f32x4*)xp = y0; *(f32x4*)(xp + 4) = y1; }
                        else { u32x4 w4; w4.x = pk2(y0[0], y0[1]); w4.y = pk2(y0[2], y0[3]); w4.z = pk2(y1[0], y1[1]); w4.w = pk2(y1[2], y1[3]);
                               *(u32x4*)(XNo + (size_t)row * DM + col0 + bj * 128) = w4; }
                        q += ((x0[0] * x0[0] + x0[1] * x0[1]) + (x0[2] * x0[2] + x0[3] * x0[3])) + ((x1[0] * x1[0] + x1[1] * x1[1]) + (x1[2] * x1[2] + x1[3] * x1[3]));
                    }
                }
                if (gnext) { q += __shfl_xor(q, 16); q += __shfl_xor(q, 32); if (fq == 0) atomicAdd(RS + row, q); }
            }
        }
    }
};

struct EpiFin {
    static constexpr bool PERM = true, AFTER_DRAIN = false;
    const bf16_t* XNb; const float* g1; float* Y; const float* g; float* RS; unsigned* pcnt;
    DI void operator()(const f32x4 (&acc_)[2][2][4][2], const pg8::Unit& u, int wr, int wc, int fr, int fq) const {
        f32x4 (&acc)[2][2][4][2] = const_cast<f32x4 (&)[2][2][4][2]>(acc_);
        const int row0 = u.pm * 256 + wr * 64 + fr;
        const int col0 = u.pn * 256 + wc * 32 + 8 * fq;
        f32x4 gv[2][2];
#pragma unroll
        for (int bj = 0; bj < 2; ++bj) { gv[bj][0] = *(const f32x4*)(g + col0 + bj * 128); gv[bj][1] = *(const f32x4*)(g + col0 + bj * 128 + 4); }
        f32x4 rg[2][2];
#pragma unroll
        for (int bj = 0; bj < 2; ++bj)
#pragma unroll
            for (int hh = 0; hh < 2; ++hh) { const f32x4 t = *(const f32x4*)(g1 + col0 + bj * 128 + 4 * hh);
                rg[bj][hh] = (f32x4){__builtin_amdgcn_rcpf(t[0]), __builtin_amdgcn_rcpf(t[1]), __builtin_amdgcn_rcpf(t[2]), __builtin_amdgcn_rcpf(t[3])}; }
#pragma unroll
        for (int am = 0; am < 4; ++am) {
            const int ai = am >> 1, mb = (am & 1) * 2;
            u32x4 bw[2][2];
#pragma unroll
            for (int mm = 0; mm < 2; ++mm)
#pragma unroll
                for (int bj = 0; bj < 2; ++bj) bw[mm][bj] = *(const u32x4*)(XNb + (size_t)(row0 + ai * 128 + (mb + mm) * 16) * DM + col0 + bj * 128);
#pragma unroll
            for (int mm = 0; mm < 2; ++mm) {
                const int m = mb + mm;
                float q = 0.f;
#pragma unroll
                for (int bj = 0; bj < 2; ++bj) {
                    const u32x4 wv = bw[mm][bj];
                    const f32x4 x0 = (f32x4){bflo(wv.x), bfhi(wv.x), bflo(wv.y), bfhi(wv.y)} * rg[bj][0] + acc[ai][bj][m][0];
                    const f32x4 x1 = (f32x4){bflo(wv.z), bfhi(wv.z), bflo(wv.w), bfhi(wv.w)} * rg[bj][1] + acc[ai][bj][m][1];
                    q += ((x0[0] * x0[0] + x0[1] * x0[1]) + (x0[2] * x0[2] + x0[3] * x0[3])) + ((x1[0] * x1[0] + x1[1] * x1[1]) + (x1[2] * x1[2] + x1[3] * x1[3]));
                    acc[ai][bj][m][0] = x0 * gv[bj][0]; acc[ai][bj][m][1] = x1 * gv[bj][1];
                }
                q += __shfl_xor(q, 16); q += __shfl_xor(q, 32);
                if (fq == 0) atomicAdd(RS + row0 + ai * 128 + m * 16, q);
            }
        }
        asm volatile("s_waitcnt vmcnt(0)" ::: "memory");
        unsigned* pc = pcnt + 64 * u.pm;
        if (fr == 0 && fq == 0) __hip_atomic_fetch_add(pc, 1u, __ATOMIC_RELAXED, __HIP_MEMORY_SCOPE_AGENT);
        { unsigned sp = 0; while (__hip_atomic_load(pc, __ATOMIC_RELAXED, __HIP_MEMORY_SCOPE_AGENT) < 128u) { __builtin_amdgcn_s_sleep(2); if (++sp > (1u << 21)) break; } }
        asm volatile("" ::: "memory");
#pragma unroll
        for (int ai = 0; ai < 2; ++ai)
#pragma unroll
            for (int m = 0; m < 4; ++m) {
                const int row = row0 + ai * 128 + m * 16;
                const float rs = __builtin_amdgcn_rsqf(__hip_atomic_load(RS + row, __ATOMIC_RELAXED, __HIP_MEMORY_SCOPE_AGENT) * (1.f / DM) + EPS);
#pragma unroll
                for (int bj = 0; bj < 2; ++bj) {
                    float* yp = Y + (size_t)row * DM + col0 + bj * 128;
                    *(f32x4*)yp = acc[ai][bj][m][0] * rs; *(f32x4*)(yp + 4) = acc[ai][bj][m][1] * rs;
                }
            }
    }
};
struct EpiInMem {
    static constexpr bool PERM = true, AFTER_DRAIN = false;
    EpiIn ein; EpiMem emem;
    DI void operator()(const f32x4 (&acc)[2][2][4][2], const pg8::Unit& u, int wr, int wc, int fr, int fq) const { if (u.sel) emem(acc, u, wr, wc, fr, fq); else ein(acc, u, wr, wc, fr, fq); }
};
struct InMemOrder {
    pg8::StaticOrder so; int nin;
    DI void init(int G_, int c_) { so.init(TP, NP, G_, c_); nin = (TP / 256) * (NP / 256); }
    DI bool next(int i, pg8::Unit& u) const {
        const long L = (long)i * so.G + so.c;
        if (L < nin) return so.next(i, u);
        const int idx = (int)(L - nin); if (idx >= 32) return false;
        u.pm = idx & 3; u.pn = idx >> 2; u.sel = 1; return true;
    }
    DI void a_ready(const pg8::Unit&) const {}
    DI void done(const pg8::Unit&) const {}
};
struct PanelOrder {
    int G, c;
    DI void init(int G_, int c_) { G = G_; c = c_; }
    DI bool next(int i, pg8::Unit& u) const {
        if (G == 256) { if (i >= 2) return false; const int xcd = c & 7, r = c >> 3, j = xcd >> 1, hx = xcd & 1; u.pm = 16 * i + 4 * j + (r & 3); u.pn = 8 * hx + (r >> 2); u.sel = 0; return true; }
        const long L = (long)i * G + c; if (L >= 512) return false; u.pm = (int)(L >> 4); u.pn = (int)(L & 15); u.sel = 0; return true;
    }
    DI void a_ready(const pg8::Unit&) const {}
    DI void done(const pg8::Unit&) const {}
};

DI int dst_row_in(int s) {
    if (s < 2304) { const int d = s & 63; return (s & ~63) + 2 * (d & 31) + (d >> 5); }
    if (s < 6656) return s;
    if (s < 6672) return 9728 + (s - 6656);
    return s - 16;
}
struct TrItem { const float* W; bf16_t* WT; int N, item, inmap; };
DI void tr_load(const TrItem& t, f32x4 (&tv)[16], int lane) {
    const int nblk = (t.N + 63) >> 6, kb = t.item / nblk, nb = t.item - kb * nblk, k0 = 64 * kb, n0 = 64 * nb;
    const int cl = (lane & 15) * 4, rl = lane >> 4;
    const bool okc = (n0 + cl) < t.N;
#pragma unroll
    for (int i = 0; i < 16; ++i) { tv[i] = (f32x4){0.f, 0.f, 0.f, 0.f}; if (okc) tv[i] = *(const f32x4*)(t.W + (size_t)(k0 + 4 * i + rl) * t.N + n0 + cl); }
}
DI void tr_store(const TrItem& t, const f32x4 (&tv)[16], float* scr, int lane) {
    const int nblk = (t.N + 63) >> 6, kb = t.item / nblk, nb = t.item - kb * nblk, k0 = 64 * kb, n0 = 64 * nb;
    const int cl = (lane & 15) * 4, rl = lane >> 4;
#pragma unroll
    for (int i = 0; i < 16; ++i) { float* s = scr + (4 * i + rl) * 65 + cl; s[0] = tv[i][0]; s[1] = tv[i][1]; s[2] = tv[i][2]; s[3] = tv[i][3]; }
    asm volatile("s_waitcnt lgkmcnt(0)" ::: "memory");
    const int c = lane & 7;
#pragma unroll
    for (int j = 0; j < 8; ++j) {
        const int n = (lane >> 3) + 8 * j;
        if (n0 + n < t.N) {
            const float* s = scr + (8 * c) * 65 + n;
            u32x4 o; o.x = pk2(s[0], s[65]); o.y = pk2(s[2 * 65], s[3 * 65]); o.z = pk2(s[4 * 65], s[5 * 65]); o.w = pk2(s[6 * 65], s[7 * 65]);
            const int row = t.inmap ? dst_row_in(n0 + n) : (n0 + n);
            *(u32x4*)(t.WT + (size_t)row * DM + k0 + 8 * c) = o;
        }
    }
    asm volatile("s_waitcnt lgkmcnt(0)" ::: "memory");
}
DI void norm_row(const float* src, const float* g, bf16_t* dstb, float* dstf, int lane) {
    const f32x4* xr = (const f32x4*)src + lane;
    f32x4 v[16]; float s = 0.f;
#pragma unroll
    for (int j = 0; j < 16; ++j) { v[j] = xr[64 * j]; s += (v[j][0] * v[j][0] + v[j][1] * v[j][1]) + (v[j][2] * v[j][2] + v[j][3] * v[j][3]); }
    const f32x4* gr = (const f32x4*)g + lane;
    f32x4 gv[16];
#pragma unroll
    for (int j = 0; j < 16; ++j) gv[j] = gr[64 * j];
    const float rs = __builtin_amdgcn_rsqf(wave_sum(s) * (1.f / DM) + EPS);
#pragma unroll
    for (int j = 0; j < 16; ++j) {
        const f32x4 o = v[j] * rs * gv[j];
        if (dstb) { u32x2 w2; w2.x = pk2(o[0], o[1]); w2.y = pk2(o[2], o[3]); *((u32x2*)dstb + lane + 64 * j) = w2; }
        else *((f32x4*)dstf + lane + 64 * j) = o;
    }
}
DI void norm_row2(const float* src, const float* g0, const float* g1, bf16_t* d0, bf16_t* d1, int lane) {
    const f32x4* xr = (const f32x4*)src + lane;
    f32x4 v[16]; float s = 0.f;
#pragma unroll
    for (int j = 0; j < 16; ++j) { v[j] = xr[64 * j]; s += (v[j][0] * v[j][0] + v[j][1] * v[j][1]) + (v[j][2] * v[j][2] + v[j][3] * v[j][3]); }
    const float rs = __builtin_amdgcn_rsqf(wave_sum(s) * (1.f / DM) + EPS);
#pragma unroll
    for (int h = 0; h < 2; ++h) {
        const f32x4* gr = (const f32x4*)(h ? g1 : g0) + lane;
        f32x4 gv[16];
#pragma unroll
        for (int j = 0; j < 16; ++j) gv[j] = gr[64 * j];
#pragma unroll
        for (int j = 0; j < 16; ++j) { const f32x4 o = v[j] * rs * gv[j]; u32x2 w2; w2.x = pk2(o[0], o[1]); w2.y = pk2(o[2], o[3]); *((u32x2*)(h ? d1 : d0) + lane + 64 * j) = w2; }
    }
}
DI void rope_entry(float* tab, int idx) {
    const int pi = idx >> 5, i = idx & 31;
    const double pos = pi < SEQ ? (double)pi : 16384.0;
    double inv = 1.0; for (int k = 0; k < i; ++k) inv *= 0.7498942093324559;
    const double a = pos * inv;
    const double q = __builtin_rint(a * 0.6366197723675814);
    const double r = (a - q * 1.5707963267948966) - q * 6.123233995736766e-17;
    const int qi = ((int)q) & 3;
    const double r2 = r * r;
    const double sn = r * (1.0 + r2 * (-1.0 / 6 + r2 * (1.0 / 120 + r2 * (-1.0 / 5040 + r2 * (1.0 / 362880 + r2 * (-1.0 / 39916800 + r2 * (1.0 / 6227020800.0)))))));
    const double cs = 1.0 + r2 * (-0.5 + r2 * (1.0 / 24 + r2 * (-1.0 / 720 + r2 * (1.0 / 40320 + r2 * (-1.0 / 3628800 + r2 * (1.0 / 479001600 + r2 * (-1.0 / 87178291200.0)))))));
    double c, s;
    if (qi == 0) { c = cs; s = sn; } else if (qi == 1) { c = -sn; s = cs; } else if (qi == 2) { c = -cs; s = -sn; } else { c = sn; s = -cs; }
    tab[2 * idx] = (float)c; tab[2 * idx + 1] = (float)s;
}

DI void swa_unit(unsigned char* lds, const bf16_t* H, bf16_t* Gt, const float* sinks, int u, int tid) {
    const int kvh = u & 3, blk = (u >> 2) & 15, b = u >> 6;
    bf16_t* Ks = (bf16_t*)lds;
    bf16_t* Vt = (bf16_t*)(lds + 39168);
    const int lane = tid & 63, w = tid >> 6, c16 = lane & 15, quad = lane >> 4;
    const int qi = w * 16 + c16;
    const size_t qrow = (size_t)(b * SEQ + blk * 128 + qi);
    bf16x8 qc0 = *(const bf16x8*)(H + qrow * NP + C_SQ + kvh * 512 + quad * 8), qc1 = *(const bf16x8*)(H + qrow * NP + C_SQ + kvh * 512 + 32 + quad * 8);
    __syncthreads();
    {
        const int r = tid >> 1, half = tid & 1;
        const int tok = blk * 128 - 128 + r;
        u32x4 kv[4], vv[4];
#pragma unroll
        for (int i = 0; i < 4; ++i) { kv[i] = (u32x4){0u, 0u, 0u, 0u}; vv[i] = (u32x4){0u, 0u, 0u, 0u}; }
        if (tok >= 0) {
            const bf16_t* src = H + (size_t)(b * SEQ + tok) * NP + kvh * 64 + half * 32;
#pragma unroll
            for (int i = 0; i < 4; ++i) { kv[i] = *(const u32x4*)(src + C_SK + i * 8); vv[i] = *(const u32x4*)(src + C_SV + i * 8); }
        }
#pragma unroll
        for (int i = 0; i < 4; ++i) *(u32x4*)(Ks + r * 72 + half * 32 + i * 8) = kv[i];
#pragma unroll
        for (int i = 0; i < 4; ++i)
#pragma unroll
            for (int e = 0; e < 4; ++e) {
                const unsigned wv = vv[i][e];
                Vt[(half * 32 + i * 8 + 2 * e) * 280 + r] = (bf16_t)(wv & 0xffffu);
                Vt[(half * 32 + i * 8 + 2 * e + 1) * 280 + r] = (bf16_t)(wv >> 16);
            }
        for (int i = tid; i < 576; i += 512) ((unsigned*)(Ks + 256 * 72))[i] = 0u;
        { const int d = tid >> 3, cc = 256 + (tid & 7) * 2; *(unsigned*)(Vt + d * 280 + cc) = 0u; }
    }
    __syncthreads();
    for (int g = 0; g < 8; ++g) {
        const int head = kvh * 8 + g;
        bf16x8 qf[2]; qf[0] = qc0; qf[1] = qc1;
        { const int hn = kvh * 8 + (g < 7 ? g + 1 : g);
          qc0 = *(const bf16x8*)(H + qrow * NP + C_SQ + hn * 64 + quad * 8); qc1 = *(const bf16x8*)(H + qrow * NP + C_SQ + hn * 64 + 32 + quad * 8); }
        u32x2 gwv[4];
#pragma unroll
        for (int mt = 0; mt < 4; ++mt) gwv[mt] = *(const u32x2*)(H + qrow * NP + C_SG + head * 64 + mt * 16 + quad * 4);
        f32x4 s[10];
#pragma unroll
        for (int i = 0; i < 10; ++i) {
            s[i] = (f32x4){0.f, 0.f, 0.f, 0.f};
            const bf16_t* kp = Ks + ((w + i) * 16 + c16) * 72 + quad * 8;
#pragma unroll
            for (int ks = 0; ks < 2; ++ks) s[i] = mfma16(*(const bf16x8*)(kp + ks * 32), qf[ks], s[i]);
        }
        const float sink = sinks[head];
        float mx = sink;
        int qiv = qi + 128 - (w * 16 + quad * 4); asm volatile("" : "+v"(qiv));
        const int lowlim = blk > 0 ? 0 : 128;
#pragma unroll
        for (int i = 0; i < 10; ++i)
#pragma unroll
            for (int j = 0; j < 4; ++j) {
                const int sj = (w + i) * 16 + quad * 4 + j, diff = qiv - (i * 16 + j);
                const bool valid = (unsigned)diff < 128u && sj >= lowlim;
                s[i][j] = valid ? s[i][j] : -INFINITY;
                mx = fmaxf(mx, s[i][j]);
            }
        mx = fmaxf(mx, __shfl_xor(mx, 16)); mx = fmaxf(mx, __shfl_xor(mx, 32));
        float sum = 0.f;
#pragma unroll
        for (int i = 0; i < 10; ++i)
#pragma unroll
            for (int j = 0; j < 4; ++j) { const float p = __expf(s[i][j] - mx); s[i][j] = p; sum += p; }
        sum += __shfl_xor(sum, 16); sum += __shfl_xor(sum, 32);
        sum += __expf(sink - mx);
        const float inv = __builtin_amdgcn_rcpf(sum);
        f32x4 o[4];
#pragma unroll
        for (int mt = 0; mt < 4; ++mt) o[mt] = (f32x4){0.f, 0.f, 0.f, 0.f};
#pragma unroll
        for (int st = 0; st < 5; ++st) {
            const bf16x8 pb = pack8(s[2 * st], s[2 * st + 1]);
#pragma unroll
            for (int mt = 0; mt < 4; ++mt) {
                const bf16_t* vp = Vt + (mt * 16 + c16) * 280 + (w + 2 * st) * 16 + quad * 4;
                o[mt] = mfma16(cat4(*(const s16x4*)vp, *(const s16x4*)(vp + 16)), pb, o[mt]);
            }
        }
#pragma unroll
        for (int mt = 0; mt < 4; ++mt) {
            const int d = mt * 16 + quad * 4;
            const u32x2 gw = gwv[mt];
            u32x2 ow;
            ow.x = pk2(o[mt][0] * inv * silu(bflo(gw.x)), o[mt][1] * inv * silu(bfhi(gw.x)));
            ow.y = pk2(o[mt][2] * inv * silu(bflo(gw.y)), o[mt][3] * inv * silu(bfhi(gw.y)));
            *(u32x2*)(Gt + qrow * DM + head * 64 + d) = ow;
        }
    }
}

DI void mem_unit(unsigned char* lds, const bf16_t* H, const bf16_t* MKV, bf16_t* Gt, int u, int tid) {
    const int qt = u & 15, h = (u >> 4) & 3, b = u >> 6;
    bf16_t* Kc = (bf16_t*)lds;
    bf16_t* Vc = (bf16_t*)(lds + 33792);
    const int lane = tid & 63, w = tid >> 6, c16 = lane & 15, quad = lane >> 4;
    const size_t qrow = (size_t)(b * SEQ + qt * 128 + w * 16 + c16);
    const int srow = tid >> 3, seg = tid & 7;
    const bf16_t* ksrc = MKV + (size_t)(b * 256 + srow) * 2048 + h * 256 + seg * 32;
    const bf16_t* vsrc = MKV + (size_t)(b * 256 + lane) * 2048 + 1024 + h * 256 + w * 32;
    u32x4 pre[4];
#pragma unroll
    for (int i = 0; i < 4; ++i) pre[i] = *(const u32x4*)(ksrc + i * 8);
    bf16x8 qf[8];
#pragma unroll
    for (int ks = 0; ks < 8; ++ks) qf[ks] = *(const bf16x8*)(H + qrow * NP + C_MQ + h * 256 + ks * 32 + quad * 8);
    f32x4 s[16];
#pragma unroll
    for (int c = 0; c < 4; ++c) {
        __syncthreads();
#pragma unroll
        for (int i = 0; i < 4; ++i) *(u32x4*)(Kc + srow * 264 + seg * 32 + i * 8) = pre[i];
        if (c < 3) {
#pragma unroll
            for (int i = 0; i < 4; ++i) pre[i] = *(const u32x4*)(ksrc + (size_t)(c + 1) * 64 * 2048 + i * 8);
        } else {
#pragma unroll
            for (int i = 0; i < 4; ++i) pre[i] = *(const u32x4*)(vsrc + i * 8);
        }
        __syncthreads();
#pragma unroll
        for (int kt = 0; kt < 4; ++kt) {
            f32x4 a = {0.f, 0.f, 0.f, 0.f};
            const bf16_t* kp = Kc + (kt * 16 + c16) * 264 + quad * 8;
#pragma unroll
            for (int ks = 0; ks < 8; ++ks) a = mfma16(*(const bf16x8*)(kp + ks * 32), qf[ks], a);
            s[c * 4 + kt] = a;
        }
    }
    u32x2 gwv[16];
#pragma unroll
    for (int mt = 0; mt < 16; ++mt) gwv[mt] = *(const u32x2*)(H + qrow * NP + C_MG + h * 256 + mt * 16 + quad * 4);
    float mx = -INFINITY;
#pragma unroll
    for (int i = 0; i < 16; ++i)
#pragma unroll
        for (int j = 0; j < 4; ++j) mx = fmaxf(mx, s[i][j]);
    mx = fmaxf(mx, __shfl_xor(mx, 16)); mx = fmaxf(mx, __shfl_xor(mx, 32));
    float sum = 0.f;
#pragma unroll
    for (int i = 0; i < 16; ++i)
#pragma unroll
        for (int j = 0; j < 4; ++j) { const float p = __expf(s[i][j] - mx); s[i][j] = p; sum += p; }
    sum += __shfl_xor(sum, 16); sum += __shfl_xor(sum, 32);
    const float inv = __builtin_amdgcn_rcpf(sum);
    bf16x8 pbv[8];
#pragma unroll
    for (int i = 0; i < 8; ++i) pbv[i] = pack8(s[2 * i], s[2 * i + 1]);
    f32x4 o[16];
#pragma unroll
    for (int mt = 0; mt < 16; ++mt) o[mt] = (f32x4){0.f, 0.f, 0.f, 0.f};
#pragma unroll
    for (int c = 0; c < 4; ++c) {
        __syncthreads();
#pragma unroll
        for (int i = 0; i < 4; ++i)
#pragma unroll
            for (int e = 0; e < 4; ++e) {
                Vc[(w * 32 + i * 8 + 2 * e) * 72 + lane] = (bf16_t)(pre[i][e] & 0xffffu);
                Vc[(w * 32 + i * 8 + 2 * e + 1) * 72 + lane] = (bf16_t)(pre[i][e] >> 16);
            }
        if (c < 3) {
#pragma unroll
            for (int i = 0; i < 4; ++i) pre[i] = *(const u32x4*)(vsrc + (size_t)(c + 1) * 64 * 2048 + i * 8);
        }
        __syncthreads();
#pragma unroll
        for (int st = 0; st < 2; ++st) {
            const bf16x8 pb = pbv[c * 2 + st];
#pragma unroll
            for (int mt = 0; mt < 16; ++mt) {
                const bf16_t* vp = Vc + (mt * 16 + c16) * 72 + (2 * st) * 16 + quad * 4;
                o[mt] = mfma16(cat4(*(const s16x4*)vp, *(const s16x4*)(vp + 16)), pb, o[mt]);
            }
        }
    }
#pragma unroll
    for (int mt = 0; mt < 16; ++mt) {
        const int d = mt * 16 + quad * 4;
        const u32x2 gw = gwv[mt];
        u32x2 ow;
        ow.x = pk2(o[mt][0] * inv * silu(bflo(gw.x)), o[mt][1] * inv * silu(bfhi(gw.x)));
        ow.y = pk2(o[mt][2] * inv * silu(bflo(gw.y)), o[mt][3] * inv * silu(bfhi(gw.y)));
        *(u32x2*)(Gt + qrow * DM + 3072 + h * 256 + d) = ow;
    }
}

DI float logsig16(float z) { return (fminf(z, 0.f) - __logf(1.f + __expf(-fabsf(z)))) * 0.0625f; }

constexpr int GI_QS = 0, GI_AS = 17408, GI_VT = 26624, GI_BYTES = 63488, GI_IMG = 26624;
DI void gla_prep_unit(unsigned char* lds, const bf16_t* H, const float* wg, const float* bg, u32x2* Ug, float* EBLg, unsigned char* IMG, int u, int tid) {
    const int ch = u & 31, h = (u >> 5) & 3, b = u >> 7;
    bf16_t* Qs = (bf16_t*)(lds + GI_QS);
    bf16_t* As = (bf16_t*)(lds + GI_AS);
    bf16_t* Vt = (bf16_t*)(lds + GI_VT);
    bf16_t* Ks = (bf16_t*)(lds + 63488);
    bf16_t* Kt = (bf16_t*)(lds + 80896);
    float* LR = (float*)(lds + 99328);
    float* WgL = (float*)(lds + 103424);
    float* GT = (float*)(lds + 111616);
    const int lane = tid & 63, w = tid >> 6, c16 = lane & 15, quad = lane >> 4;
    const size_t row0 = (size_t)(b * SEQ + ch * 64);
    __syncthreads();
    { const int i = tid >> 3, r2 = (tid & 7) * 2; const unsigned wv = *(const unsigned*)(H + (row0 + i) * NP + C_LR + r2); LR[i * 16 + r2] = bflo(wv); LR[i * 16 + r2 + 1] = bfhi(wv); }
#pragma unroll
    for (int r = 0; r < 4; ++r) { const int idx = tid + 512 * r; WgL[idx] = wg[(idx >> 7) * 512 + h * 128 + (idx & 127)]; }
    const int dk = tid & 127, ig = tid >> 7;
    const float bgc = bg[h * 128 + dk];
    unsigned short qr[16], kr[16];
#pragma unroll
    for (int ii = 0; ii < 16; ++ii) { const bf16_t* src = H + (row0 + ig * 16 + ii) * NP + h * 128 + dk; qr[ii] = src[C_GQ]; kr[ii] = src[C_GK]; }
    u32x4 vpre[4];
#pragma unroll
    for (int i = 0; i < 4; ++i) vpre[i] = *(const u32x4*)(H + (row0 + lane) * NP + C_GV + h * 256 + w * 32 + i * 8);
    __syncthreads();
    float bb[16];
    {
        float wgc[16];
#pragma unroll
        for (int r = 0; r < 16; ++r) wgc[r] = WgL[r * 128 + dk];
        float run = 0.f;
#pragma unroll
        for (int ii = 0; ii < 16; ++ii) {
            const int i = ig * 16 + ii;
            float z = bgc;
#pragma unroll
            for (int r = 0; r < 16; ++r) z += LR[i * 16 + r] * wgc[r];
            run += logsig16(z); bb[ii] = run;
        }
        GT[ig * 128 + dk] = run;
    }
#pragma unroll
    for (int i = 0; i < 4; ++i)
#pragma unroll
        for (int e = 0; e < 4; ++e) {
            Vt[(w * 32 + i * 8 + 2 * e) * 72 + lane] = (bf16_t)(vpre[i][e] & 0xffffu);
            Vt[(w * 32 + i * 8 + 2 * e + 1) * 72 + lane] = (bf16_t)(vpre[i][e] >> 16);
        }
    __syncthreads();
    {
        const float t0 = GT[dk], t1 = GT[128 + dk], t2 = GT[256 + dk], t3 = GT[384 + dk];
        const float bl = (t0 + t1) + (t2 + t3);
        const float off = (ig > 0 ? t0 : 0.f) + (ig > 1 ? t1 : 0.f) + (ig > 2 ? t2 : 0.f);
#pragma unroll
        for (int ii = 0; ii < 16; ++ii) {
            const int i = ig * 16 + ii;
            const float bv = off + bb[ii], q = bf2f(qr[ii]), k = bf2f(kr[ii]);
            Qs[i * 136 + dk] = f2bf(q * __expf(bv));
            Ks[i * 136 + dk] = f2bf(k * __expf(-bv));
            Kt[dk * 72 + i] = f2bf(k * __expf(bl - bv));
        }
        if (ig == 0) EBLg[(size_t)u * 128 + dk] = __expf(bl);
    }
    __syncthreads();
#pragma unroll
    for (int tt = 0; tt < 2; ++tt) {
        const int t = 2 * w + tt, mt = t >> 2, nt = t & 3;
        f32x4 a = {0.f, 0.f, 0.f, 0.f};
        if (nt <= mt) {
#pragma unroll
            for (int ks = 0; ks < 4; ++ks)
                a = mfma16(*(const bf16x8*)(Qs + (mt * 16 + c16) * 136 + ks * 32 + quad * 8), *(const bf16x8*)(Ks + (nt * 16 + c16) * 136 + ks * 32 + quad * 8), a);
        }
#pragma unroll
        for (int jj = 0; jj < 4; ++jj) { const int i = mt * 16 + quad * 4 + jj, j = nt * 16 + c16; As[i * 72 + j] = f2bf(j <= i ? a[jj] : 0.f); }
    }
#pragma unroll
    for (int kt = 0; kt < 8; ++kt) {
        f32x4 s0 = {0.f, 0.f, 0.f, 0.f}, s1 = {0.f, 0.f, 0.f, 0.f};
#pragma unroll
        for (int ks = 0; ks < 2; ++ks) {
            const bf16x8 a = *(const bf16x8*)(Kt + (kt * 16 + c16) * 72 + ks * 32 + quad * 8);
            s0 = mfma16(a, *(const bf16x8*)(Vt + ((2 * w) * 16 + c16) * 72 + ks * 32 + quad * 8), s0);
            s1 = mfma16(a, *(const bf16x8*)(Vt + ((2 * w + 1) * 16 + c16) * 72 + ks * 32 + quad * 8), s1);
        }
        { u32x2 p0, p1; p0.x = pk2(s0[0], s0[1]); p0.y = pk2(s0[2], s0[3]); p1.x = pk2(s1[0], s1[1]); p1.y = pk2(s1[2], s1[3]);
          Ug[((size_t)(u * 8 + kt) * 16 + 2 * w) * 64 + lane] = p0; Ug[((size_t)(u * 8 + kt) * 16 + 2 * w + 1) * 64 + lane] = p1; }
    }
    __syncthreads();
    { u32x4* dst = (u32x4*)(IMG + (size_t)u * GI_IMG); const u32x4* srcl = (const u32x4*)lds;
      for (int i = tid; i < GI_IMG / 16; i += 512) dst[i] = srcl[i]; }
}
DI void gla_scan_task(const u32x2* Ug, const float* EBLg, u32x2* SF2, float* state_out, int t, int lane) {
    const int nt = t & 15, kt = (t >> 4) & 7, bh = t >> 7;
    const int c16 = lane & 15, quad = lane >> 4;
    f32x4 s0 = {0.f, 0.f, 0.f, 0.f};
    for (int n0 = 0; n0 < 32; n0 += 16) {
        f32x4 ev[16], uv[16];
#pragma unroll
        for (int j = 0; j < 16; ++j) {
            const size_t u = (size_t)bh * 32 + n0 + j;
            ev[j] = *(const f32x4*)(EBLg + u * 128 + kt * 16 + quad * 4);
            { const u32x2 p = Ug[((u * 8 + kt) * 16 + nt) * 64 + lane]; uv[j] = (f32x4){bflo(p.x), bfhi(p.x), bflo(p.y), bfhi(p.y)}; }
        }
#pragma unroll
        for (int j = 0; j < 16; ++j) {
            const size_t u = (size_t)bh * 32 + n0 + j;
            u32x2 pk; pk.x = pk2(s0[0], s0[1]); pk.y = pk2(s0[2], s0[3]);
            if (n0 + j > 0) SF2[(((u * 4 + (kt >> 1)) * 16 + nt) * 64 + lane) * 2 + (kt & 1)] = pk;
            s0 = s0 * ev[j] + uv[j];
        }
    }
#pragma unroll
    for (int jj = 0; jj < 4; ++jj) state_out[((size_t)bh * 128 + kt * 16 + quad * 4 + jj) * 256 + nt * 16 + c16] = s0[jj];
}
DI void gla_out_unit(unsigned char* lds, const bf16_t* H, bf16_t* Gt, const float* gng, const u32x4* SF, const unsigned char* IMG, int u, int tid) {
    const int ch = u & 31, h = (u >> 5) & 3, b = u >> 7;
    const bf16_t* Qs = (const bf16_t*)(lds + GI_QS);
    const bf16_t* As = (const bf16_t*)(lds + GI_AS);
    const bf16_t* Vt = (const bf16_t*)(lds + GI_VT);
    float* SSw = (float*)(lds + GI_BYTES);
    const int lane = tid & 63, w = tid >> 6, c16 = lane & 15, quad = lane >> 4;
    const size_t row0 = (size_t)(b * SEQ + ch * 64);
    unsigned short gtv[4][4][2];
#pragma unroll
    for (int mt = 0; mt < 4; ++mt)
#pragma unroll
        for (int jj = 0; jj < 4; ++jj)
#pragma unroll
            for (int n = 0; n < 2; ++n) gtv[mt][jj][n] = H[(row0 + mt * 16 + quad * 4 + jj) * NP + C_GG + h * 256 + (2 * w + n) * 16 + c16];
    u32x4 vpre[4];
#pragma unroll
    for (int i = 0; i < 4; ++i) vpre[i] = *(const u32x4*)(H + (row0 + lane) * NP + C_GV + h * 256 + w * 32 + i * 8);
    __syncthreads();
    { const u32x4* src = (const u32x4*)(IMG + (size_t)u * GI_IMG); u32x4* dstl = (u32x4*)lds;
      for (int i = tid; i < GI_IMG / 16; i += 512) dstl[i] = src[i]; }
    { bf16_t* Vw = (bf16_t*)(lds + GI_VT);
#pragma unroll
      for (int i = 0; i < 4; ++i)
#pragma unroll
          for (int e = 0; e < 4; ++e) {
              Vw[(w * 32 + i * 8 + 2 * e) * 72 + lane] = (bf16_t)(vpre[i][e] & 0xffffu);
              Vw[(w * 32 + i * 8 + 2 * e + 1) * 72 + lane] = (bf16_t)(vpre[i][e] >> 16);
          } }
    bf16x8 sb[4][2];
#pragma unroll
    for (int ks = 0; ks < 4; ++ks)
#pragma unroll
        for (int n = 0; n < 2; ++n) sb[ks][n] = ch == 0 ? (bf16x8){0, 0, 0, 0, 0, 0, 0, 0} : __builtin_bit_cast(bf16x8, SF[(((size_t)u * 4 + ks) * 16 + 2 * w + n) * 64 + lane]);
    __syncthreads();
    f32x4 o[4][2];
#pragma unroll
    for (int mt = 0; mt < 4; ++mt) {
        o[mt][0] = (f32x4){0.f, 0.f, 0.f, 0.f}; o[mt][1] = (f32x4){0.f, 0.f, 0.f, 0.f};
#pragma unroll
        for (int ks = 0; ks < 4; ++ks) {
            const bf16_t* qp = Qs + (mt * 16 + c16) * 136 + (2 * ks) * 16 + quad * 4;
            const bf16x8 a = cat4(*(const s16x4*)qp, *(const s16x4*)(qp + 16));
            o[mt][0] = mfma16(a, sb[ks][0], o[mt][0]); o[mt][1] = mfma16(a, sb[ks][1], o[mt][1]);
        }
#pragma unroll
        for (int ks = 0; ks < 2; ++ks) {
            const bf16x8 a = *(const bf16x8*)(As + (mt * 16 + c16) * 72 + ks * 32 + quad * 8);
#pragma unroll
            for (int n = 0; n < 2; ++n) o[mt][n] = mfma16(a, *(const bf16x8*)(Vt + ((2 * w + n) * 16 + c16) * 72 + ks * 32 + quad * 8), o[mt][n]);
        }
    }
#pragma unroll
    for (int mt = 0; mt < 4; ++mt)
#pragma unroll
        for (int jj = 0; jj < 4; ++jj) {
            float q = o[mt][0][jj] * o[mt][0][jj] + o[mt][1][jj] * o[mt][1][jj];
            q += __shfl_xor(q, 1); q += __shfl_xor(q, 2); q += __shfl_xor(q, 4); q += __shfl_xor(q, 8);
            if (c16 == 0) SSw[w * 64 + mt * 16 + quad * 4 + jj] = q;
        }
    __syncthreads();
    const float gn0 = gng[h * 256 + (2 * w) * 16 + c16], gn1 = gng[h * 256 + (2 * w + 1) * 16 + c16];
#pragma unroll
    for (int mt = 0; mt < 4; ++mt)
#pragma unroll
        for (int jj = 0; jj < 4; ++jj) {
            const int i = mt * 16 + quad * 4 + jj;
            float tot = 0.f;
#pragma unroll
            for (int ww = 0; ww < 8; ++ww) tot += SSw[ww * 64 + i];
            const float rs = __builtin_amdgcn_rsqf(tot * (1.f / 256.f) + EPS);
#pragma unroll
            for (int n = 0; n < 2; ++n) {
                const int dv = (2 * w + n) * 16 + c16;
                const float gate = bf2f(gtv[mt][jj][n]);
                Gt[(row0 + i) * DM + 2048 + h * 256 + dv] = f2bf(o[mt][n][jj] * rs * (n ? gn1 : gn0) * silu(gate));
            }
        }
}

DI void s_swa_unit(unsigned char* lds, const bf16_t* H, bf16_t* Gt, const float* ck, const float* cv, const float* sinks, float* kout, float* vout, int u, int tid) {
    const int kvh = u & 3, b = u >> 2;
    float* Kl = (float*)lds;
    float* Vl = Kl + 128 * 65;
    float* Ql = Vl + 128 * 64;
    float* Pl = Ql + 512;
    const int lane = tid & 63, w = tid >> 6;
    const bf16_t* hrow = H + (size_t)(TP + b) * NP;
    __syncthreads();
    {
        float kr[16], vr[16];
#pragma unroll
        for (int i = 0; i < 16; ++i) {
            const int kk = w + 8 * i;
            if (kk < 127) { const size_t o = ((size_t)(b * 128 + kk + 1) * 4 + kvh) * 64 + lane; kr[i] = ck[o]; vr[i] = cv[o]; }
            else { const int p = 2 * (lane & 31) + (lane >> 5); kr[i] = bf2f(hrow[C_SK + kvh * 64 + p]); vr[i] = bf2f(hrow[C_SV + kvh * 64 + lane]); }
        }
#pragma unroll
        for (int i = 0; i < 16; ++i) {
            const int kk = w + 8 * i;
            if (kk < 127) { const size_t oo = ((size_t)(b * 128 + kk) * 4 + kvh) * 64 + lane; kout[oo] = kr[i]; vout[oo] = vr[i]; }
            Kl[kk * 65 + lane] = kr[i]; Vl[kk * 64 + lane] = vr[i];
        }
    }
    { const int p = 2 * (lane & 31) + (lane >> 5); Ql[w * 64 + lane] = bf2f(hrow[C_SQ + (kvh * 8 + w) * 64 + p]); }
    __syncthreads();
    float s0 = 0.f, s1 = 0.f;
    for (int d = 0; d < 64; ++d) { const float qd = Ql[w * 64 + d]; s0 += qd * Kl[lane * 65 + d]; s1 += qd * Kl[(lane + 64) * 65 + d]; }
    const float sink = sinks[kvh * 8 + w];
    const float mx = fmaxf(wave_max(fmaxf(s0, s1)), sink);
    const float p0 = __expf(s0 - mx), p1 = __expf(s1 - mx);
    const float inv = __builtin_amdgcn_rcpf(wave_sum(p0 + p1) + __expf(sink - mx));
    Pl[w * 128 + lane] = p0 * inv; Pl[w * 128 + lane + 64] = p1 * inv;
    __syncthreads();
    float o = 0.f;
    for (int kk = 0; kk < 128; ++kk) o += Pl[w * 128 + kk] * Vl[kk * 64 + lane];
    const float gate = bf2f(hrow[C_SG + (kvh * 8 + w) * 64 + lane]);
    Gt[(size_t)(TP + b) * DM + (kvh * 8 + w) * 64 + lane] = f2bf(o * silu(gate));
}
DI void s_gla_unit(unsigned char* lds, const bf16_t* H, bf16_t* Gt, const float* wg, const float* bg, const float* gng, const float* sin_, float* sout, int u, int tid) {
    const int h = u & 3, b = u >> 2;
    float* gE = (float*)lds; float* qv = gE + 128; float* kv = qv + 128; float* vv = kv + 128; float* Osum = vv + 256; float* red = Osum + 2048;
    const int lane = tid & 63, w = tid >> 6;
    const bf16_t* hrow = H + (size_t)(TP + b) * NP;
    __syncthreads();
    if (tid < 128) {
        float z = bg[h * 128 + tid];
#pragma unroll
        for (int r = 0; r < 16; ++r) z += bf2f(hrow[C_LR + r]) * wg[r * 512 + h * 128 + tid];
        gE[tid] = __expf(logsig16(z)); qv[tid] = bf2f(hrow[C_GQ + h * 128 + tid]); kv[tid] = bf2f(hrow[C_GK + h * 128 + tid]);
    }
    if (tid < 256) vv[tid] = bf2f(hrow[C_GV + h * 256 + tid]);
    __syncthreads();
    const float* S0 = sin_ + (size_t)(b * 4 + h) * 128 * 256;
    float* S1 = sout + (size_t)(b * 4 + h) * 128 * 256;
    const f32x4 v4 = *(const f32x4*)(vv + lane * 4);
    f32x4 oacc = {0.f, 0.f, 0.f, 0.f};
    f32x4 srow[16];
#pragma unroll
    for (int r = 0; r < 16; ++r) srow[r] = *(const f32x4*)(S0 + (16 * w + r) * 256 + lane * 4);
#pragma unroll
    for (int r = 0; r < 16; ++r) {
        const int dk = 16 * w + r;
        const f32x4 sv = srow[r] * gE[dk] + v4 * kv[dk];
        *(f32x4*)(S1 + dk * 256 + lane * 4) = sv;
        oacc += sv * qv[dk];
    }
    *(f32x4*)(Osum + w * 256 + lane * 4) = oacc;
    __syncthreads();
    float o = 0.f;
    if (tid < 256) {
#pragma unroll
        for (int ww = 0; ww < 8; ++ww) o += Osum[ww * 256 + tid];
        const float q = wave_sum(o * o);
        if (lane == 0) red[w] = q;
    }
    __syncthreads();
    if (tid < 256) {
        const float rs = __builtin_amdgcn_rsqf((red[0] + red[1] + red[2] + red[3]) * (1.f / 256.f) + EPS);
        const float gate = bf2f(hrow[C_GG + h * 256 + tid]);
        Gt[(size_t)(TP + b) * DM + 2048 + h * 256 + tid] = f2bf(o * rs * gng[h * 256 + tid] * silu(gate));
    }
}
DI void s_mem_unit(unsigned char* lds, const bf16_t* H, bf16_t* Gt, const float* mk, const float* mv, int u, int tid) {
    const int h = u & 3, b = u >> 2;
    float* Sc = (float*)lds; float* Osum = Sc + 256;
    const int lane = tid & 63, w = tid >> 6;
    const bf16_t* hrow = H + (size_t)(TP + b) * NP;
    __syncthreads();
    const u32x2 qw = *(const u32x2*)(hrow + C_MQ + h * 256 + lane * 4);
    const f32x4 q4 = {bflo(qw.x), bfhi(qw.x), bflo(qw.y), bfhi(qw.y)};
    const float* kbase = mk + ((size_t)(b * 256 + w * 32) * 4 + h) * 256 + lane * 4;
    const float* vbase = mv + ((size_t)(b * 256 + w * 32) * 4 + h) * 256 + lane * 4;
    float vals[32];
    {
        f32x4 kr[32];
#pragma unroll
        for (int r = 0; r < 32; ++r) kr[r] = *(const f32x4*)(kbase + (size_t)r * 1024);
#pragma unroll
        for (int r = 0; r < 32; ++r) vals[r] = (q4[0] * kr[r][0] + q4[1] * kr[r][1]) + (q4[2] * kr[r][2] + q4[3] * kr[r][3]);
    }
#pragma unroll
    for (int i = 0; i < 16; ++i) { const bool hi = lane & 32; const float send = hi ? vals[i] : vals[i + 16], keep = hi ? vals[i + 16] : vals[i]; vals[i] = keep + __shfl_xor(send, 32); }
#pragma unroll
    for (int i = 0; i < 8; ++i) { const bool hi = lane & 16; const float send = hi ? vals[i] : vals[i + 8], keep = hi ? vals[i + 8] : vals[i]; vals[i] = keep + __shfl_xor(send, 16); }
#pragma unroll
    for (int i = 0; i < 4; ++i) { const bool hi = lane & 8; const float send = hi ? vals[i] : vals[i + 4], keep = hi ? vals[i + 4] : vals[i]; vals[i] = keep + __shfl_xor(send, 8); }
#pragma unroll
    for (int i = 0; i < 2; ++i) { const bool hi = lane & 4; const float send = hi ? vals[i] : vals[i + 2], keep = hi ? vals[i + 2] : vals[i]; vals[i] = keep + __shfl_xor(send, 4); }
    { const bool hi = lane & 2; const float send = hi ? vals[0] : vals[1], keep = hi ? vals[1] : vals[0]; vals[0] = keep + __shfl_xor(send, 2); }
    vals[0] += __shfl_xor(vals[0], 1);
    if ((lane & 1) == 0) Sc[w * 32 + (lane >> 1)] = vals[0];
    f32x4 vr[32];
#pragma unroll
    for (int r = 0; r < 32; ++r) vr[r] = *(const f32x4*)(vbase + (size_t)r * 1024);
    __syncthreads();
    const f32x4 sv = *(const f32x4*)(Sc + lane * 4);
    const float mx = wave_max(fmaxf(fmaxf(sv[0], sv[1]), fmaxf(sv[2], sv[3])));
    const float inv = __builtin_amdgcn_rcpf(wave_sum((__expf(sv[0] - mx) + __expf(sv[1] - mx)) + (__expf(sv[2] - mx) + __expf(sv[3] - mx))));
    f32x4 oacc = {0.f, 0.f, 0.f, 0.f};
#pragma unroll
    for (int r = 0; r < 32; ++r) oacc += vr[r] * (__expf(Sc[w * 32 + r] - mx) * inv);
    *(f32x4*)(Osum + w * 256 + lane * 4) = oacc;
    __syncthreads();
    if (tid < 256) {
        float o = 0.f;
#pragma unroll
        for (int ww = 0; ww < 8; ++ww) o += Osum[ww * 256 + tid];
        const float gate = bf2f(hrow[C_MG + h * 256 + tid]);
        Gt[(size_t)(TP + b) * DM + 3072 + h * 256 + tid] = f2bf(o * silu(gate));
    }
}

#ifndef MK_ONE_LAUNCH
#define MK_ONE_LAUNCH 1
#endif
constexpr int N_PHASES = 12;
#ifndef PH_MASK
#define PH_MASK 0xFFFF
#endif
#define PHM(b) ((PH_MASK >> (b)) & 1)
#ifndef DUP_PH
#define DUP_PH 0
#endif
#ifndef DUP_SEL
#define DUP_SEL 0
#endif
#ifndef DUP_SYNC
#define DUP_SYNC 0
#endif
#ifndef DUP_P0
#define DUP_P0 0
#endif

__global__ void __launch_bounds__(512, 2) mk_fwd(Args a) {
    extern __shared__ __attribute__((aligned(16))) unsigned char lds[];
    const int G = gridDim.x, bid = blockIdx.x;
    unsigned char* ws = a.ws;
    bf16_t* XN = (bf16_t*)(ws + WS_XN);
    bf16_t* Hb = (bf16_t*)(ws + WS_H);
    bf16_t* Gt = (bf16_t*)(ws + WS_G);
    float* X1 = (float*)(ws + WS_X1);
    float* rope = (float*)(ws + WS_ROPE);
    float* RSq = (float*)(ws + WS_RS);
    const float* x_prompt = a.in[0]; const float* mem_prompt = a.in[1]; const float* x_sample = a.in[2];
    volatile LAS unsigned* bst = (volatile LAS unsigned*)((LAS unsigned char*)lds + (LDS_BYTES - 16));
    if (threadIdx.x < 4) bst[threadIdx.x] = 0u;
    __syncthreads();
    XcdBarrier xbar = xcd_barrier_post((unsigned*)(ws + WS_CTL), bst);
#define GRID_SYNC() xcd_barrier(xbar)

    if (a.ph_lo == 0) {
        int tidp = threadIdx.x; asm volatile("" : "+v"(tidp));
        const int tid = tidp, lane = tid & 63, wave = __builtin_amdgcn_readfirstlane(tid >> 6);
        for (int rep0 = 0; rep0 <= DUP_P0; ++rep0) if (PHM(0)) {
            float* scr = (float*)(lds + wave * 16640);
            const int gw = bid * 8 + wave, NGW = G * 8;
            constexpr int I_IN = 64 * 153, I_OUT = 64 * 64, I_MEM = 64 * 32, I_L = I_IN + I_OUT + I_MEM;
            auto mk_item = [&](int it) {
                TrItem t; const int l = it / I_L; int r = it - l * I_L;
                if (r < I_IN) { t.W = a.in[9] + (size_t)l * DM * NIN; t.WT = (bf16_t*)(ws + WS_WIN + l * SZ_WIN); t.N = NIN; t.item = r; t.inmap = 1; return t; }
                r -= I_IN;
                if (r < I_OUT) { t.W = a.in[16] + (size_t)l * DM * DM; t.WT = (bf16_t*)(ws + WS_WOUT + l * SZ_WOUT); t.N = DM; t.item = r; t.inmap = 0; return t; }
                r -= I_OUT;
                t.W = a.in[15] + (size_t)l * DM * 2048; t.WT = (bf16_t*)(ws + WS_WMEM + l * SZ_WMEM); t.N = 2048; t.item = r; t.inmap = 0; return t;
            };
            {
                int it = gw;
                f32x4 tv[16];
                TrItem cur = mk_item(it < 2 * I_L ? it : 0);
                if (it < 2 * I_L) tr_load(cur, tv, lane);
                while (it < 2 * I_L) {
                    const int nx = it + NGW;
                    f32x4 tn[16]; TrItem nxt = cur;
                    if (nx < 2 * I_L) { nxt = mk_item(nx); tr_load(nxt, tn, lane); }
                    tr_store(cur, tv, scr, lane);
#pragma unroll
                    for (int i = 0; i < 16; ++i) tv[i] = tn[i];
                    cur = nxt; it = nx;
                }
            }
            for (int i = bid * 512 + tid; i < 2 * 240 * 512; i += G * 512) {
                const int l = i / (240 * 512), r = i - l * 240 * 512;
                ((u32x4*)(ws + WS_WIN + l * SZ_WIN + (size_t)NIN * DM * 2))[r] = (u32x4){0u, 0u, 0u, 0u};
            }
            for (int i = bid * 512 + tid; i < 2049 * 32; i += G * 512) rope_entry(rope, i);
            for (int i = bid * 512 + tid; i < 2 * MR; i += G * 512) RSq[i] = 0.f;
            for (int m = gw; m < MREAL + 1024; m += NGW) {
                if (m < TP) norm_row(x_prompt + (size_t)m * DM, a.in[8], XN + (size_t)m * DM, nullptr, lane);
                else if (m < MREAL) norm_row(x_sample + (size_t)(m - TP) * DM, a.in[8], XN + (size_t)m * DM, nullptr, lane);
                else { const int r = m - MREAL;
                       norm_row2(mem_prompt + (size_t)r * DM, a.in[14], a.in[14] + DM, (bf16_t*)(ws + WS_MN) + (size_t)r * DM, (bf16_t*)(ws + WS_MN + SZ_MN) + (size_t)r * DM, lane); }
            }
        }
        if (a.ph_hi > 1) GRID_SYNC();
        if (a.ph_hi > 1000) cg::this_grid().sync();
    }
    for (int ph = a.ph_lo < 1 ? 1 : a.ph_lo, rep = 0; ph < a.ph_hi; ) {
        int tidp = threadIdx.x; asm volatile("" : "+v"(tidp));
        const int tid = tidp, lane = tid & 63, wave = __builtin_amdgcn_readfirstlane(tid >> 6);
        {
            const int l = (ph - 1) / 6, k = (ph - 1) % 6;
            if (k == 5 && l == 0) { ++ph; continue; }
            if (k == 0) {
                if (PHM(1)) {
                    pg8::Gemm g{XN, (const bf16_t*)(ws + WS_WIN + l * SZ_WIN), TP, NP, DM, (const bf16_t*)(ws + WS_MN + l * SZ_MN), (const bf16_t*)(ws + WS_WMEM + l * SZ_WMEM)};
                    InMemOrder S; S.init(G, bid);
                    EpiInMem E{EpiIn{Hb, rope, a.out + O_KP + (size_t)l * 131072, a.out + O_VP + (size_t)l * 131072, l == 0 ? nullptr : RSq},
                               EpiMem{(bf16_t*)(ws + WS_MKV + l * SZ_MKV), a.out + O_MKP + (size_t)l * 1048576, a.out + O_MVP + (size_t)l * 1048576}};
                    pg8::gemm_phase<EpiInMem, InMemOrder, true, true>((PG8_LAS unsigned char*)lds, g, S, E);
                }
            } else if (k >= 1 && k <= 3) {
                const float* sinks = a.in[10] + l * 32;
                const float* wg = a.in[11] + l * 16 * 512; const float* bg = a.in[12] + l * 512; const float* gng = a.in[13] + l * 1024;
                const bf16_t* MKV = (const bf16_t*)(ws + WS_MKV + l * SZ_MKV);
                u32x2* Ug = (u32x2*)(ws + WS_U); u32x4* SF = (u32x4*)(ws + WS_SF); unsigned char* IMG = ws + WS_IMG; float* EBLg = (float*)(ws + WS_EBL);
                unsigned* qctr = (unsigned*)(ws + WS_CTL) + 8192 + (ph * 2 + rep) * 64;
#define QUEUE_LOOP_BEGIN(NTOT) { int u = bid; while (u < (NTOT)) { unsigned nxt_ = 0u; if (threadIdx.x == 0) nxt_ = atomicAdd(qctr, 1u) + (unsigned)G;
#define QUEUE_LOOP_END() __syncthreads(); if (threadIdx.x == 0) bst[2] = nxt_; __syncthreads(); u = (int)bst[2]; } }
                if (k == 1) {
                    EpiInS ES{Hb, rope, a.out + O_KS + (size_t)l * 1048576, a.out + O_VS + (size_t)l * 1048576, l == 0 ? nullptr : RSq};
                    QUEUE_LOOP_BEGIN(256 + 512 + (NIN + 31) / 32)
                        int tid = tidp; asm volatile("" : "+v"(tid));
                        if (u < 256) { if (PHM(4)) mem_unit(lds, Hb, MKV, Gt, u, tid); }
                        else if (u < 768) { if (PHM(3)) gla_prep_unit(lds, Hb, wg, bg, Ug, EBLg, IMG, u - 256, tid); }
                        else skinny_task<EpiInS>(lds, XN + (size_t)TP * DM, (const bf16_t*)(ws + WS_WIN + l * SZ_WIN), u - 768, tid, ES);
                    QUEUE_LOOP_END()
                } else if (k == 2) {
                    const bool dsel = (DUP_SEL != 0 && rep == 1 && ph == DUP_PH);
                    if (PHM(3) && (!dsel || DUP_SEL == 5)) { for (int tt = bid * 8 + wave; tt < 2048; tt += G * 8) gla_scan_task(Ug, EBLg, (u32x2*)SF, a.out + O_SP + (size_t)l * 524288, tt, lane); }
                    QUEUE_LOOP_BEGIN(256 + 384)
                        int tid = tidp; asm volatile("" : "+v"(tid));
                        const int utype = u < 256 ? 1 : (u < 384 ? 2 : (u < 512 ? 3 : 4));
                        if (dsel && utype != DUP_SEL) {}
                        else if (u < 256) { if (PHM(5)) swa_unit(lds, Hb, Gt, sinks, u, tid); }
                        else if (!PHM(6)) {}
                        else if (u < 384) s_mem_unit(lds, Hb, Gt, a.in[6] + (size_t)l * 8388608, a.in[7] + (size_t)l * 8388608, u - 256, tid);
                        else if (u < 512) s_gla_unit(lds, Hb, Gt, wg, bg, gng, a.in[5] + (size_t)l * 4194304, a.out + O_SS + (size_t)l * 4194304, u - 384, tid);
                        else s_swa_unit(lds, Hb, Gt, a.in[3] + (size_t)l * 1048576, a.in[4] + (size_t)l * 1048576, sinks, a.out + O_KS + (size_t)l * 1048576, a.out + O_VS + (size_t)l * 1048576, u - 512, tid);
                    QUEUE_LOOP_END()
                } else {
                    EpiResS ES{l == 0 ? x_sample : X1 + (size_t)TP * DM, (l == 0 ? X1 : a.out) + (size_t)TP * DM, l == 0 ? a.in[8] + DM : a.in[17], XN, RSq + l * MR, l};
                    QUEUE_LOOP_BEGIN(512 + DM / 32)
                        int tid = tidp; asm volatile("" : "+v"(tid));
                        if (u < 512) { if (PHM(3)) gla_out_unit(lds, Hb, Gt, gng, SF, IMG, u, tid); }
                        else skinny_task<EpiResS>(lds, Gt + (size_t)TP * DM, (const bf16_t*)(ws + WS_WOUT + l * SZ_WOUT), u - 512, tid, ES);
                    QUEUE_LOOP_END()
                }
                __syncthreads();
            } else if (k == 4) { if (PHM(7)) {
                pg8::Gemm g{Gt, (const bf16_t*)(ws + WS_WOUT + l * SZ_WOUT), TP, DM, DM, nullptr, nullptr};
                PanelOrder S; S.init(G, bid);
                if (l == 0) {
                    EpiRes E{x_prompt, nullptr, a.in[8] + DM, XN, RSq, 0};
                    pg8::gemm_phase<EpiRes, PanelOrder, true, true>((PG8_LAS unsigned char*)lds, g, S, E);
                } else {
                    if (bid < TS) {
                        const int row = TP + bid;
                        const float rs = __builtin_amdgcn_rsqf(RSq[MR + row] * (1.f / DM) + EPS);
                        f32x4* yr = (f32x4*)(a.out + (size_t)row * DM);
                        const f32x4 y0 = yr[tid], y1 = yr[tid + 512];
                        yr[tid] = y0 * rs; yr[tid + 512] = y1 * rs;
                    }
                    EpiFin E{XN, a.in[8] + DM, a.out, a.in[17], RSq + MR, (unsigned*)(ws + WS_CTL) + 4096};
                    pg8::gemm_phase<EpiFin, PanelOrder, true, true>((PG8_LAS unsigned char*)lds, g, S, E);
                }
            } } else if (PHM(8)) {
                const int gw = bid * 8 + wave, NGW = G * 8;
                for (int m = gw; m < MREAL; m += NGW) {
                    if (l == 0) norm_row(X1 + (size_t)m * DM, a.in[8] + DM, XN + (size_t)m * DM, nullptr, lane);
                    else {
                        const float rs = __builtin_amdgcn_rsqf(RSq[MR + m] * (1.f / DM) + EPS);
                        f32x4* yr = (f32x4*)(a.out + (size_t)m * DM) + lane;
                        f32x4 yv[16];
#pragma unroll
                        for (int j = 0; j < 16; ++j) yv[j] = yr[64 * j];
#pragma unroll
                        for (int j = 0; j < 16; ++j) yr[64 * j] = yv[j] * rs;
                    }
                }
            }
        }
        if (ph + 1 < a.ph_hi) { GRID_SYNC(); if (DUP_SYNC) { GRID_SYNC(); } }
        if (DUP_PH != 0 && ph == DUP_PH && rep == 0) rep = 1; else ++ph;
    }
}

extern "C" void kernel_launch(void* const* d_in, const int* in_sizes, int n_in, void* d_out, int out_size, void* d_ws, size_t ws_size, hipStream_t stream) {
    static int grid = 0;
    if (grid == 0) {
        if (n_in != 18 || (size_t)out_size != O_END || ws_size < WS_END) { fprintf(stderr, "kernel_launch: unexpected shapes (n_in %d, out %d, ws %zu); nothing launched\n", n_in, out_size, ws_size); grid = -1; return; }
        int dev = 0, cus = 0, per_cu = 0;
        if (hipGetDevice(&dev) != hipSuccess || hipDeviceGetAttribute(&cus, hipDeviceAttributeMultiprocessorCount, dev) != hipSuccess) { grid = -1; return; }
        if (hipFuncSetAttribute((const void*)mk_fwd, hipFuncAttributeMaxDynamicSharedMemorySize, LDS_BYTES) != hipSuccess) { fprintf(stderr, "kernel_launch: hipFuncSetAttribute failed\n"); grid = -1; return; }
        if (hipOccupancyMaxActiveBlocksPerMultiprocessor(&per_cu, (const void*)mk_fwd, 512, LDS_BYTES) != hipSuccess || per_cu < 1) { fprintf(stderr, "kernel_launch: occupancy query says %d\n", per_cu); per_cu = 1; }
        (void)hipGetLastError();
        grid = cus * per_cu;
    }
    if (grid < 0) return;
    if (hipMemsetAsync((char*)d_ws + WS_CTL, 0, CTL_BYTES, stream) != hipSuccess) { fprintf(stderr, "kernel_launch: memset failed\n"); return; }
    Args a{};
    for (int i = 0; i < 18; ++i) a.in[i] = (const float*)d_in[i];
    a.out = (float*)d_out; a.ws = (unsigned char*)d_ws;
#if MK_ONE_LAUNCH
    a.ph_lo = 0; a.ph_hi = N_PHASES;
    void* args[] = {&a};
    hipError_t e = hipLaunchCooperativeKernel((const void*)mk_fwd, dim3(grid), dim3(512), args, LDS_BYTES, stream);
    if (e != hipSuccess) fprintf(stderr, "kernel_launch: cooperative launch failed: %s (grid %d)\n", hipGetErrorString(e), grid);
#else
    for (int ph = 0; ph < N_PHASES; ++ph) {
        a.ph_lo = ph; a.ph_hi = ph + 1;
        hipLaunchKernelGGL(mk_fwd, dim3(grid), dim3(512), LDS_BYTES, stream, a);
    }
#endif
}
```

```cpp
#include <hip/hip_runtime.h>
#include <hip/hip_cooperative_groups.h>
#include <cstdio>
#include <cstdint>
namespace cg = cooperative_groups;
#define MK_ONE_LAUNCH 1
namespace pg8 {
#define PG8_LAS __attribute__((address_space(3)))
typedef unsigned short bf16_t;
typedef short bf16x8 __attribute__((ext_vector_type(8)));
typedef float f32x4 __attribute__((ext_vector_type(4)));
typedef unsigned u32x4 __attribute__((ext_vector_type(4)));
constexpr int BM = 256, BK = 64, HALF = 128, HTB = HALF * BK * 2  , STAGE_BYTES = 8 * HTB, NXCD = 8, WGM = 8;

__host__ __device__ __forceinline__ int lds_byte(int r, int c) { const int st = (r >> 4) * 2 + (c >> 5), rr = r & 15, cc = c & 31, ob = rr * 64 + cc * 2; return st * 1024 + (ob ^ (((ob >> 9) & 1) << 5)); }
__host__ __device__ __forceinline__ void stage_rc(int b, int& R, int& C) { const int st = b / 1024, sb = b % 1024, swz = sb ^ (((sb >> 9) & 1) << 5); R = (st >> 1) * 16 + swz / 64; C = (st & 1) * 32 + (swz % 64) / 2; }
__host__ __device__ __forceinline__ int perm32(int rho) { const int n = rho >> 4, i = rho & 15; return 8 * (i >> 2) + 4 * n + (i & 3); }

struct Unit { int pm, pn, sel; };
struct Gemm { const bf16_t* A; const bf16_t* Bt; int M, N, K; const bf16_t* A2; const bf16_t* Bt2; };

struct StaticOrder {
    int nM, nN, nwg, G, c;
    __host__ __device__ void init(int M, int N, int G_, int c_) { nM = M / BM; nN = N / BM; nwg = nM * nN; G = G_; c = c_; }
    __host__ __device__ bool next(int i, Unit& u) const {
        const long L = (long)i * G + c; if (L >= nwg) return false;
        int wgid = (int)L; { const int q = nwg / NXCD, r = nwg % NXCD, xcd = wgid % NXCD, off = wgid / NXCD; wgid = (xcd < r ? xcd * (q + 1) : r * (q + 1) + (xcd - r) * q) + off; }
        const int nig = WGM * nN, gid = wgid / nig, fm = gid * WGM, gsz = (nM - fm) < WGM ? (nM - fm) : WGM;
        u.pm = fm + ((wgid % nig) % gsz); u.pn = (wgid % nig) / gsz; u.sel = 0; return true;
    }
    __device__ __forceinline__ void a_ready(const Unit&) const {}
    __device__ __forceinline__ void done(const Unit&) const {}
};

__device__ __forceinline__ unsigned cvt_pk_bf16(float lo, float hi) { unsigned r; asm volatile("v_cvt_pk_bf16_f32 %0, %1, %2" : "=v"(r) : "v"(lo), "v"(hi)); return r; }
typedef float f32x2 __attribute__((ext_vector_type(2)));
template <class Epi, class Sched, bool ALIGN_EPI = false, bool SP2 = false>
__device__ __forceinline__ void gemm_phase(PG8_LAS unsigned char* lds, const Gemm g, const Sched& S, const Epi& E) {
    int tid_ = threadIdx.x; asm volatile("" : "+v"(tid_));
    const int tid = tid_, wid = __builtin_amdgcn_readfirstlane(tid >> 6), lane = tid & 63, wr = wid >> 2, wc = wid & 3, fr = lane & 15, fq = lane >> 4;
    const int K = g.K, nt = K / BK;
    unsigned voffA[2], voffB[2];
#pragma unroll
    for (int i = 0; i < 2; ++i) { int R, C; stage_rc(tid * 16 + i * 8192, R, C); const int Rb = Epi::PERM ? ((R & ~31) + perm32(R & 31)) : R;
        voffA[i] = (unsigned)(R * K + C) * 2u; voffB[i] = (unsigned)(Rb * K + C) * 2u; }
    const size_t kstep = (size_t)(BK * 2);
    const size_t hstep = (size_t)HALF * K * 2;
    const size_t tstep = 2 * hstep;
    const unsigned ldsw = (unsigned)wid * 1024u;
    const int aoff = lds_byte(wr * 64 + fr, fq * 8), boff = lds_byte(wc * 32 + fr, fq * 8);
#define PG8_SA(b, h) (((b) * 2 + (h)) * HTB)
#define PG8_SB(b, h) ((4 + (b) * 2 + (h)) * HTB)
#define PG8_STAGE(bufoff, gbase, voff) do { _Pragma("unroll") for (int _i = 0; _i < 2; ++_i) \
        __builtin_amdgcn_global_load_lds((const unsigned*)((const char*)(gbase) + (voff)[_i]), (PG8_LAS unsigned*)(lds + (bufoff) + ldsw + _i * 8192), 16, 0, 0); } while (0)
#define PG8_LDA(dst, b, h) do { _Pragma("unroll") for (int m = 0; m < 4; ++m) _Pragma("unroll") for (int k = 0; k < 2; ++k) dst[m][k] = *(const PG8_LAS bf16x8*)(lds + PG8_SA(b, h) + aoff + m * 2048 + k * 1024); } while (0)
#define PG8_LDB(dst, b, h) do { _Pragma("unroll") for (int n = 0; n < 2; ++n) _Pragma("unroll") for (int k = 0; k < 2; ++k) dst[n][k] = *(const PG8_LAS bf16x8*)(lds + PG8_SB(b, h) + boff + n * 2048 + k * 1024); } while (0)
#define PG8_MMA(ai, bj, At, Bt) do { __builtin_amdgcn_s_setprio(1); _Pragma("unroll") for (int m = 0; m < 4; ++m) _Pragma("unroll") for (int n = 0; n < 2; ++n) _Pragma("unroll") for (int k = 0; k < 2; ++k) \
        acc[ai][bj][m][n] = __builtin_amdgcn_mfma_f32_16x16x32_bf16(Bt[n][k], At[m][k], acc[ai][bj][m][n], 0, 0, 0); __builtin_amdgcn_s_setprio(0); } while (0)
#define PG8_WAIT_V(n) asm volatile("s_waitcnt vmcnt(" #n ")" ::: "memory")
#define PG8_WAIT_L(n) asm volatile("s_waitcnt lgkmcnt(" #n ")" ::: "memory")
#define PG8_BAR __builtin_amdgcn_s_barrier()
#define PG8_SCHED __builtin_amdgcn_sched_barrier(0)
    Unit cur, nxt; int ui = 0;
    if (!S.next(0, cur)) return;
    f32x4 acc[2][2][4][2];
#pragma unroll
    for (int a = 0; a < 2; ++a)
#pragma unroll
        for (int b = 0; b < 2; ++b)
#pragma unroll
            for (int m = 0; m < 4; ++m)
#pragma unroll
                for (int n = 0; n < 2; ++n) acc[a][b][m][n] = (f32x4){0.f, 0.f, 0.f, 0.f};
    bf16x8 At[4][2], B0[2][2], B1[2][2];
    const char* cA = (const char*)(cur.sel ? g.A2 : g.A) + (size_t)cur.pm * tstep; const char* cB = (const char*)(cur.sel ? g.Bt2 : g.Bt) + (size_t)cur.pn * tstep;
    S.a_ready(cur);
    if constexpr (SP2) {
        PG8_STAGE(PG8_SB(0, 0), cB, voffB); PG8_STAGE(PG8_SB(0, 1), cB + hstep, voffB); PG8_STAGE(PG8_SA(0, 0), cA, voffA); PG8_STAGE(PG8_SA(0, 1), cA + hstep, voffA);
        if (wr == 1) PG8_BAR;
        PG8_WAIT_V(2); PG8_BAR;
        PG8_STAGE(PG8_SB(1, 0), cB + kstep, voffB); PG8_STAGE(PG8_SA(1, 0), cA + kstep, voffA); PG8_STAGE(PG8_SB(1, 1), cB + hstep + kstep, voffB);
        PG8_WAIT_V(6); PG8_BAR;
    } else {
        PG8_STAGE(PG8_SB(0, 0), cB, voffB); PG8_STAGE(PG8_SA(0, 0), cA, voffA); PG8_STAGE(PG8_SB(0, 1), cB + hstep, voffB); PG8_STAGE(PG8_SA(0, 1), cA + hstep, voffA);
        if (wr == 1) PG8_BAR;
        PG8_WAIT_V(4); PG8_BAR;
        PG8_STAGE(PG8_SB(1, 0), cB + kstep, voffB); PG8_STAGE(PG8_SA(1, 0), cA + kstep, voffA); PG8_STAGE(PG8_SB(1, 1), cB + hstep + kstep, voffB);
        PG8_WAIT_V(6); PG8_BAR;
    }
    for (;;) {
        const bool has_next = S.next(ui + 1, nxt);
        const char* nA = has_next ? (const char*)(nxt.sel ? g.A2 : g.A) + (size_t)nxt.pm * tstep : cA; const char* nB = has_next ? (const char*)(nxt.sel ? g.Bt2 : g.Bt) + (size_t)nxt.pn * tstep : cB;
        for (int t = 0; t < nt; t += 2) {
            const bool last = (t == nt - 2);
            const char* a1 = cA + (size_t)(t + 1) * kstep;
            const char* a2 = last ? nA : cA + (size_t)(t + 2) * kstep; const char* b2 = last ? nB : cB + (size_t)(t + 2) * kstep;
            const char* a3 = a2 + kstep; const char* b3 = b2 + kstep;
            if (last && has_next) S.a_ready(nxt);
            if constexpr (SP2) {
            PG8_LDB(B0, 0, 0); PG8_LDB(B1, 0, 1); PG8_SCHED; PG8_LDA(At, 0, 0); PG8_STAGE(PG8_SA(1, 1), a1 + hstep, voffA);
            PG8_WAIT_V(8); PG8_WAIT_L(0); PG8_BAR; PG8_MMA(0, 0, At, B0); PG8_MMA(0, 1, At, B1); PG8_BAR; PG8_SCHED;
            PG8_LDA(At, 0, 1); PG8_STAGE(PG8_SB(0, 0), b2, voffB); PG8_STAGE(PG8_SB(0, 1), b2 + hstep, voffB); PG8_STAGE(PG8_SA(0, 0), a2, voffA);
            PG8_WAIT_V(8); PG8_WAIT_L(0); PG8_BAR; PG8_MMA(1, 0, At, B0); PG8_MMA(1, 1, At, B1); PG8_BAR; PG8_SCHED;
            PG8_LDB(B0, 1, 0); PG8_LDB(B1, 1, 1); PG8_SCHED; PG8_LDA(At, 1, 0); PG8_STAGE(PG8_SA(0, 1), a2 + hstep, voffA);
            PG8_WAIT_V(8); PG8_WAIT_L(0); PG8_BAR; PG8_MMA(0, 0, At, B0); PG8_MMA(0, 1, At, B1); PG8_BAR; PG8_SCHED;
            PG8_LDA(At, 1, 1); PG8_STAGE(PG8_SB(1, 0), b3, voffB); PG8_STAGE(PG8_SB(1, 1), b3 + hstep, voffB); PG8_STAGE(PG8_SA(1, 0), a3, voffA);
            PG8_WAIT_V(8); PG8_WAIT_L(0); PG8_BAR; PG8_MMA(1, 0, At, B0); PG8_MMA(1, 1, At, B1); PG8_BAR; PG8_SCHED;
            } else {
            PG8_LDB(B0, 0, 0); PG8_SCHED; PG8_LDA(At, 0, 0); PG8_STAGE(PG8_SA(1, 1), a1 + hstep, voffA);
            PG8_WAIT_L(8); PG8_BAR; PG8_WAIT_L(0); PG8_MMA(0, 0, At, B0); PG8_BAR; PG8_SCHED;
            PG8_LDB(B1, 0, 1); PG8_STAGE(PG8_SB(0, 0), b2, voffB);
            PG8_BAR; PG8_WAIT_L(0); PG8_MMA(0, 1, At, B1); PG8_BAR;
            PG8_LDA(At, 0, 1); PG8_STAGE(PG8_SA(0, 0), a2, voffA);
            PG8_BAR; PG8_WAIT_L(0); PG8_MMA(1, 0, At, B0); PG8_BAR; PG8_SCHED;
            PG8_STAGE(PG8_SB(0, 1), b2 + hstep, voffB);
            PG8_WAIT_V(6); PG8_BAR; PG8_MMA(1, 1, At, B1); PG8_BAR;
            PG8_LDB(B0, 1, 0); PG8_SCHED; PG8_LDA(At, 1, 0); PG8_STAGE(PG8_SA(0, 1), a2 + hstep, voffA);
            PG8_WAIT_L(8); PG8_BAR; PG8_WAIT_L(0); PG8_MMA(0, 0, At, B0); PG8_BAR; PG8_SCHED;
            PG8_LDB(B1, 1, 1); PG8_STAGE(PG8_SB(1, 0), b3, voffB);
            PG8_BAR; PG8_WAIT_L(0); PG8_MMA(0, 1, At, B1); PG8_BAR;
            PG8_LDA(At, 1, 1); PG8_STAGE(PG8_SA(1, 0), a3, voffA);
            PG8_BAR; PG8_WAIT_L(0); PG8_MMA(1, 0, At, B0); PG8_BAR; PG8_SCHED;
            PG8_STAGE(PG8_SB(1, 1), b3 + hstep, voffB);
            PG8_WAIT_V(6); PG8_BAR; PG8_MMA(1, 1, At, B1); PG8_BAR;
            }
        }
        if constexpr (ALIGN_EPI) { if (wr == 0) PG8_BAR; }
        if constexpr (!Epi::AFTER_DRAIN) { E(acc, cur, wr, wc, fr, fq); S.done(cur); }
        if (!has_next) break;
#pragma unroll
        for (int a = 0; a < 2; ++a)
#pragma unroll
            for (int b = 0; b < 2; ++b)
#pragma unroll
                for (int m = 0; m < 4; ++m)
#pragma unroll
                    for (int n = 0; n < 2; ++n) acc[a][b][m][n] = (f32x4){0.f, 0.f, 0.f, 0.f};
        cur = nxt; cA = nA; cB = nB; ++ui;
        if constexpr (ALIGN_EPI) { if (wr == 1) PG8_BAR; }
    }
    PG8_WAIT_V(0);
    if constexpr (!ALIGN_EPI) { if (wr == 0) PG8_BAR; }
    PG8_BAR;
    if constexpr (Epi::AFTER_DRAIN) { E.fused(acc, cur, wr, wc, fr, fq, lds, wid, lane); S.done(cur); }
#undef PG8_SA
#undef PG8_SB
#undef PG8_STAGE
#undef PG8_LDA
#undef PG8_LDB
#undef PG8_MMA
#undef PG8_WAIT_V
#undef PG8_WAIT_L
#undef PG8_BAR
#undef PG8_SCHED
}
}
#define LAS __attribute__((address_space(3)))
#define XB_TMO      128
#define XB_XCNT(j)  (256  + 64 * (j))
#define XB_XSUB(j)  (1280 + 64 * (j))
#define XB_XGEN(j)  (2304 + 64 * (j))
#define XB_TOP      3328
#define XB_TOPGEN   3392
#define XCD_BAR_WORDS 3456
#define XB_SPIN_CAP (1u << 18)

__device__ __forceinline__ unsigned xb_ld(unsigned* p)              { return __hip_atomic_load(p, __ATOMIC_RELAXED, __HIP_MEMORY_SCOPE_AGENT); }
__device__ __forceinline__ unsigned xb_add(unsigned* p, unsigned v) { return __hip_atomic_fetch_add(p, v, __ATOMIC_RELAXED, __HIP_MEMORY_SCOPE_AGENT); }
__device__ __forceinline__ unsigned xb_xcc_id() { return (unsigned)__builtin_amdgcn_s_getreg((3 << 11) | 20) & 0xFu; }
#define XB_SPIN(cond, bar) do { unsigned _sp = 0; while (cond) { __builtin_amdgcn_s_sleep(1); \
    if ((++_sp & 255u) == 0u) { if (xb_ld(&(bar)[XB_TMO])) break; if (_sp > XB_SPIN_CAP) { atomicAdd(&(bar)[XB_TMO], 1u); break; } } } } while (0)

struct XcdBarrier {
    unsigned* bar; unsigned x;
    volatile LAS unsigned* st;
};

__device__ __forceinline__ XcdBarrier xcd_barrier_post(unsigned* bar, volatile LAS unsigned* st) {
    XcdBarrier b; b.bar = bar; b.x = xb_xcc_id(); b.st = st;
    if (threadIdx.x == 0) (void)xb_add(&bar[XB_XCNT(b.x)], 1u);
    return b;
}
__device__ __forceinline__ void xcd_barrier_complete(unsigned* bar, unsigned x, unsigned& nloc, unsigned& nx) {
    const unsigned G = gridDim.x * gridDim.y * gridDim.z;
    unsigned sum, cnt, mine, sp = 0u;
    for (;;) {
        sum = 0u; cnt = 0u; mine = 0u;
#pragma unroll
        for (unsigned j = 0; j < 16; ++j) { const unsigned c = xb_ld(&bar[XB_XCNT(j)]); sum += c; cnt += (c > 0u) ? 1u : 0u; mine = (j == x) ? c : mine; }
        if (sum == G) break;
        __builtin_amdgcn_s_sleep(1);
        if ((++sp & 255u) == 0u) { if (xb_ld(&bar[XB_TMO])) break; if (sp > XB_SPIN_CAP) { atomicAdd(&bar[XB_TMO], 1u); break; } }
    }
    nloc = mine > 0u ? mine : 1u; nx = cnt > 0u ? cnt : 1u;
}

__device__ __forceinline__ void xcd_barrier(const XcdBarrier& b) {
    asm volatile("s_waitcnt vmcnt(0)" ::: "memory");
    __syncthreads();
    if (threadIdx.x == 0) {
        unsigned* bar = b.bar;
        __builtin_amdgcn_s_waitcnt(0);
        unsigned nloc = b.st[0], nx = b.st[1];
        if (nloc == 0u) { xcd_barrier_complete(bar, b.x, nloc, nx); b.st[0] = nloc; b.st[1] = nx; }
        const unsigned old = xb_add(&bar[XB_XSUB(b.x)], 1u);
        const unsigned gen = old / nloc;
        if (old + 1u == (gen + 1u) * nloc) {
            __builtin_amdgcn_fence(__ATOMIC_RELEASE, "agent");
            asm volatile("s_waitcnt vmcnt(0)" ::: "memory");
            const unsigned og = xb_add(&bar[XB_TOP], 1u);
            const unsigned tg = og / nx;
            if (og + 1u == (tg + 1u) * nx) xb_add(&bar[XB_TOPGEN], 1u);
            else XB_SPIN(xb_ld(&bar[XB_TOPGEN]) == tg, bar);
            __builtin_amdgcn_fence(__ATOMIC_ACQUIRE, "agent");
            xb_add(&bar[XB_XGEN(b.x)], 1u);
            asm volatile("s_waitcnt vmcnt(0)" ::: "memory");
        } else {
            XB_SPIN(xb_ld(&bar[XB_XGEN(b.x)]) == gen, bar);
            __builtin_amdgcn_fence(__ATOMIC_ACQUIRE, "agent");
            asm volatile("s_waitcnt vmcnt(0)" ::: "memory");
        }
    }
    __syncthreads();
}

#define DI __device__ __forceinline__
typedef unsigned short bf16_t;
typedef short bf16x8 __attribute__((ext_vector_type(8)));
typedef short s16x4 __attribute__((ext_vector_type(4)));
typedef float f32x4 __attribute__((ext_vector_type(4)));
typedef unsigned u32x4 __attribute__((ext_vector_type(4)));
typedef unsigned u32x2 __attribute__((ext_vector_type(2)));
typedef float f32x2_t __attribute__((ext_vector_type(2)));
typedef __bf16 bf16x2_t __attribute__((ext_vector_type(2)));

constexpr int DM = 4096, TP = 8192, SEQ = 2048, NBATCH = 4, TS = 32, MR = 8448, MREAL = 8224, NP = 9984, NIN = 9744;
constexpr int C_SQ = 0, C_SK = 2048, C_SV = 2304, C_SG = 2560, C_GQ = 4608, C_GK = 5120, C_GV = 5632, C_GG = 6656, C_MQ = 7680, C_MG = 8704, C_LR = 9728;
constexpr float EPS = 1e-6f;
constexpr size_t O_YP = 0, O_YS = 33554432, O_KP = 33685504, O_VP = 33947648, O_SP = 34209792, O_MKP = 35258368, O_MVP = 37355520, O_KS = 39452672, O_VS = 41549824, O_SS = 43646976, O_END = 52035584;
constexpr size_t MiB = 1u << 20;
constexpr size_t WS_WIN = 0;
constexpr size_t SZ_WIN = (size_t)NP * DM * 2;
constexpr size_t WS_WOUT = 160 * MiB;
constexpr size_t SZ_WOUT = (size_t)DM * DM * 2;
constexpr size_t WS_WMEM = 224 * MiB;
constexpr size_t SZ_WMEM = (size_t)2048 * DM * 2;
constexpr size_t WS_XN = 256 * MiB;
constexpr size_t WS_MN = 324 * MiB;
constexpr size_t SZ_MN = (size_t)1024 * DM * 2;
constexpr size_t WS_H = 340 * MiB;
constexpr size_t WS_MKV = 502 * MiB;
constexpr size_t SZ_MKV = (size_t)1024 * 2048 * 2;
constexpr size_t WS_G = 510 * MiB;
constexpr size_t WS_X1 = 576 * MiB;
constexpr size_t WS_ROPE = 708 * MiB;
constexpr size_t WS_U = 710 * MiB;
constexpr size_t WS_SF = 774 * MiB;
constexpr size_t WS_IMG = 806 * MiB;
constexpr size_t WS_EBL = 838 * MiB;
constexpr size_t WS_RS = 838 * MiB + 524288;
constexpr size_t WS_CTL = 839 * MiB;
constexpr size_t CTL_BYTES = 65536;
constexpr size_t WS_END = 840 * MiB;
static_assert(WS_WIN + 2 * SZ_WIN <= WS_WOUT && WS_XN + (size_t)MR * DM * 2 <= WS_MN && WS_H + (size_t)MR * NP * 2 <= WS_MKV && WS_G + (size_t)MR * DM * 2 <= WS_X1 && WS_X1 + (size_t)MR * DM * 4 <= WS_ROPE, "ws map");

constexpr int LDS_BYTES = 147456;

DI float bf2f(unsigned short u) { return __uint_as_float((unsigned)u << 16); }
DI float bflo(unsigned w) { return __uint_as_float(w << 16); }
DI float bfhi(unsigned w) { return __uint_as_float(w & 0xffff0000u); }
DI unsigned pk2(float lo, float hi) { f32x2_t v = {lo, hi}; bf16x2_t b = __builtin_convertvector(v, bf16x2_t); return __builtin_bit_cast(unsigned, b); }
DI unsigned short f2bf(float f) { return (unsigned short)(pk2(f, 0.f) & 0xffffu); }
DI float silu(float x) { return x * __builtin_amdgcn_rcpf(1.f + __expf(-x)); }
DI float wave_sum(float v) {
#pragma unroll
    for (int o = 1; o < 64; o <<= 1) v += __shfl_xor(v, o);
    return v;
}
DI float wave_max(float v) {
#pragma unroll
    for (int o = 1; o < 64; o <<= 1) v = fmaxf(v, __shfl_xor(v, o));
    return v;
}
DI f32x4 mfma16(bf16x8 a, bf16x8 b, f32x4 c) { return __builtin_amdgcn_mfma_f32_16x16x32_bf16(a, b, c, 0, 0, 0); }
DI bf16x8 pack8(f32x4 a, f32x4 b) { u32x4 p; p.x = pk2(a[0], a[1]); p.y = pk2(a[2], a[3]); p.z = pk2(b[0], b[1]); p.w = pk2(b[2], b[3]); return __builtin_bit_cast(bf16x8, p); }
DI bf16x8 cat4(s16x4 lo, s16x4 hi) { return __builtin_shufflevector(lo, hi, 0, 1, 2, 3, 4, 5, 6, 7); }

struct Args {
    const float* in[18]; float* out; unsigned char* ws; int ph_lo, ph_hi;
};

struct EpiIn {
    static constexpr bool PERM = true, AFTER_DRAIN = false;
    bf16_t* H; const float* rope; float* kp; float* vp; const float* RSin;
    DI void operator()(const f32x4 (&acc)[2][2][4][2], const pg8::Unit& u, int wr, int wc, int fr, int fq) const {
        const int pn = u.pn;
        const bool do_rope = pn < 9;
        float sc = 1.f;
        if (pn < 8) sc = 0.125f; else if (pn == 18 || pn == 19) sc = 0.08838834764831845f; else if (pn >= 30 && pn < 34) sc = 0.0625f;
        const int row0 = u.pm * 256 + wr * 64 + fr;
        const int colt = wc * 32 + 8 * fq;
#pragma unroll
        for (int ai = 0; ai < 2; ++ai) {
            f32x4 tr[4][2];
#pragma unroll
            for (int m = 0; m < 4; ++m) {
                tr[m][0] = (f32x4){1.f, 0.f, 1.f, 0.f}; tr[m][1] = (f32x4){1.f, 0.f, 1.f, 0.f};
                if (do_rope) {
                    const f32x4* rp = (const f32x4*)(rope + ((size_t)((row0 + ai * 128 + m * 16) & (SEQ - 1)) * 32 + 16 * (wc & 1) + 4 * fq) * 2);
                    tr[m][0] = rp[0]; tr[m][1] = rp[1];
                }
            }
            float rsv[4];
#pragma unroll
            for (int m = 0; m < 4; ++m) { rsv[m] = sc; if (RSin) rsv[m] = sc * __builtin_amdgcn_rsqf(RSin[row0 + ai * 128 + m * 16] * (1.f / DM) + EPS); }
#pragma unroll
            for (int m = 0; m < 4; ++m) {
                const int row = row0 + ai * 128 + m * 16;
                const f32x4 t0 = tr[m][0], t1 = tr[m][1];
#pragma unroll
                for (int bj = 0; bj < 2; ++bj) {
                    f32x4 v0 = acc[ai][bj][m][0], v1 = acc[ai][bj][m][1];
                    if (do_rope) {
                        float a, b;
                        a = v0[0]; b = v0[1]; v0[0] = a * t0[0] - b * t0[1]; v0[1] = b * t0[0] + a * t0[1];
                        a = v0[2]; b = v0[3]; v0[2] = a * t0[2] - b * t0[3]; v0[3] = b * t0[2] + a * t0[3];
                        a = v1[0]; b = v1[1]; v1[0] = a * t1[0] - b * t1[1]; v1[1] = b * t1[0] + a * t1[1];
                        a = v1[2]; b = v1[3]; v1[2] = a * t1[2] - b * t1[3]; v1[3] = b * t1[2] + a * t1[3];
                    }
                    v0 = v0 * rsv[m]; v1 = v1 * rsv[m];
                    u32x4 w4; w4.x = pk2(v0[0], v0[1]); w4.y = pk2(v0[2], v0[3]); w4.z = pk2(v1[0], v1[1]); w4.w = pk2(v1[2], v1[3]);
                    if (pn * 256 + bj * 128 + colt < NIN) *(u32x4*)(H + (size_t)row * NP + pn * 256 + bj * 128 + colt) = w4;
                    if (pn == 8 || pn == 9) {
                        const int t = row & (SEQ - 1);
                        if (t >= SEQ - 128) {
                            const int kvh = bj * 2 + (wc >> 1);
                            float* dst = (pn == 8 ? kp : vp) + ((size_t)((row >> 11) * 128 + (t - (SEQ - 128))) * 4 + kvh) * 64;
                            if (pn == 8) {
                                const int d0 = 16 * (wc & 1) + 4 * fq;
                                *(f32x4*)(dst + d0) = (f32x4){v0[0], v0[2], v1[0], v1[2]};
                                *(f32x4*)(dst + d0 + 32) = (f32x4){v0[1], v0[3], v1[1], v1[3]};
                            } else {
                                const int p0 = 32 * (wc & 1) + 8 * fq;
                                *(f32x4*)(dst + p0) = v0; *(f32x4*)(dst + p0 + 4) = v1;
                            }
                        }
                    }
                }
            }
        }
    }
};
struct EpiInS {
    bf16_t* H; const float* rope; float* ks; float* vs; const float* RSin;
    DI void operator()(f32x4 v, int m, int n) const {
        const int pn = n >> 8;
        if (pn < 9) {
            const f32x4 t = *(const f32x4*)(rope + ((size_t)SEQ * 32 + ((n & 63) >> 1)) * 2);
            float a, b;
            a = v[0]; b = v[1]; v[0] = a * t[0] - b * t[1]; v[1] = b * t[0] + a * t[1];
            a = v[2]; b = v[3]; v[2] = a * t[2] - b * t[3]; v[3] = b * t[2] + a * t[3];
        }
        float sc = 1.f;
        if (pn < 8) sc = 0.125f; else if (pn == 18 || pn == 19) sc = 0.08838834764831845f; else if (pn >= 30 && pn < 34) sc = 0.0625f;
        if (RSin) sc *= __builtin_amdgcn_rsqf(RSin[TP + m] * (1.f / DM) + EPS);
        v = v * sc;
        u32x2 w2; w2.x = pk2(v[0], v[1]); w2.y = pk2(v[2], v[3]);
        *(u32x2*)(H + (size_t)(TP + m) * NP + n) = w2;
        if (pn == 8) {
            float* dst = ks + ((size_t)(m * 128 + 127) * 4 + ((n - C_SK) >> 6)) * 64; const int d0 = (n & 63) >> 1;
            dst[d0] = v[0]; dst[d0 + 32] = v[1]; dst[d0 + 1] = v[2]; dst[d0 + 33] = v[3];
        } else if (pn == 9) {
            float* dst = vs + ((size_t)(m * 128 + 127) * 4 + ((n - C_SV) >> 6)) * 64 + (n & 63);
            *(f32x4*)dst = v;
        }
    }
};
struct EpiResS {
    const float* base; float* X; const float* gnext; bf16_t* XNo; float* RS; int fin;
    DI void operator()(f32x4 v, int m, int n) const {
        const f32x4 x = *(const f32x4*)(base + (size_t)m * DM + n) + v;
        if (!fin) *(f32x4*)(X + (size_t)m * DM + n) = x;
        if (gnext) {
            const f32x4 y = x * *(const f32x4*)(gnext + n);
            if (fin) *(f32x4*)(X + (size_t)m * DM + n) = y;
            else { u32x2 w2; w2.x = pk2(y[0], y[1]); w2.y = pk2(y[2], y[3]); *(u32x2*)(XNo + (size_t)(TP + m) * DM + n) = w2; }
            float q = (x[0] * x[0] + x[1] * x[1]) + (x[2] * x[2] + x[3] * x[3]);
            q += __shfl_xor(q, 16); q += __shfl_xor(q, 32);
            if (((n >> 2) & 3) == 0) atomicAdd(RS + TP + m, q);
        }
    }
};
template <class EpiS>
DI void skinny_task(unsigned char* lds, const bf16_t* X, const bf16_t* Wt, int task, int tid, const EpiS& E) {
    const int lane = tid & 63, w = tid >> 6, c16 = lane & 15, quad = lane >> 4;
    const int ntl = w & 1, ksp = w >> 1;
    const int n0 = task * 32 + ntl * 16;
    f32x4 acc0 = {0.f, 0.f, 0.f, 0.f}, acc1 = {0.f, 0.f, 0.f, 0.f};
    const bf16_t* wp = Wt + (size_t)(n0 + c16) * DM + ksp * 1024 + quad * 8;
    const bf16_t* xp0 = X + (size_t)c16 * DM + ksp * 1024 + quad * 8;
    const bf16_t* xp1 = xp0 + 16 * DM;
    for (int k0 = 0; k0 < 32; k0 += 16) {
        bf16x8 av[16], b0v[16], b1v[16];
#pragma unroll
        for (int j = 0; j < 16; ++j) { av[j] = *(const bf16x8*)(wp + (k0 + j) * 32); b0v[j] = *(const bf16x8*)(xp0 + (k0 + j) * 32); b1v[j] = *(const bf16x8*)(xp1 + (k0 + j) * 32); }
#pragma unroll
        for (int j = 0; j < 16; ++j) { acc0 = mfma16(av[j], b0v[j], acc0); acc1 = mfma16(av[j], b1v[j], acc1); }
    }
    f32x4* red = (f32x4*)lds;
    __syncthreads();
    red[(w * 2 + 0) * 64 + lane] = acc0; red[(w * 2 + 1) * 64 + lane] = acc1;
    __syncthreads();
    if (w < 2) {
#pragma unroll
        for (int mt = 0; mt < 2; ++mt) {
            f32x4 v = red[((0 * 2 + w) * 2 + mt) * 64 + lane];
#pragma unroll
            for (int kp = 1; kp < 4; ++kp) v += red[((kp * 2 + w) * 2 + mt) * 64 + lane];
            E(v, mt * 16 + c16, n0 + quad * 4);
        }
    }
}
struct EpiMem {
    static constexpr bool PERM = true, AFTER_DRAIN = false;
    bf16_t* MKV; float* outk; float* outv;
    DI void operator()(const f32x4 (&acc)[2][2][4][2], const pg8::Unit& u, int wr, int wc, int fr, int fq) const {
        const int row0 = u.pm * 256 + wr * 64 + fr;
#pragma unroll
        for (int ai = 0; ai < 2; ++ai)
#pragma unroll
            for (int m = 0; m < 4; ++m) {
                const int row = row0 + ai * 128 + m * 16;
#pragma unroll
                for (int bj = 0; bj < 2; ++bj) {
                    const int col = u.pn * 256 + bj * 128 + wc * 32 + 8 * fq;
                    const f32x4 v0 = acc[ai][bj][m][0], v1 = acc[ai][bj][m][1];
                    u32x4 w4; w4.x = pk2(v0[0], v0[1]); w4.y = pk2(v0[2], v0[3]); w4.z = pk2(v1[0], v1[1]); w4.w = pk2(v1[2], v1[3]);
                    *(u32x4*)(MKV + (size_t)row * 2048 + col) = w4;
                    float* dst = (col < 1024) ? (outk + (size_t)row * 1024 + col) : (outv + (size_t)row * 1024 + (col - 1024));
                    *(f32x4*)dst = v0; *(f32x4*)(dst + 4) = v1;
                }
            }
    }
};
struct EpiRes {
    static constexpr bool PERM = true, AFTER_DRAIN = false;
    const float* baseP; float* X; const float* gnext; bf16_t* XNo; float* RS; int fin;
    DI void operator()(const f32x4 (&acc)[2][2][4][2], const pg8::Unit& u, int wr, int wc, int fr, int fq) const {
        const int row0 = u.pm * 256 + wr * 64 + fr;
        const int col0 = u.pn * 256 + wc * 32 + 8 * fq;
        f32x4 gv[2][2];
#pragma unroll
        for (int bj = 0; bj < 2; ++bj) { gv[bj][0] = (f32x4){0.f, 0.f, 0.f, 0.f}; gv[bj][1] = gv[bj][0];
            if (gnext) { gv[bj][0] = *(const f32x4*)(gnext + col0 + bj * 128); gv[bj][1] = *(const f32x4*)(gnext + col0 + bj * 128 + 4); } }
#pragma unroll
        for (int am = 0; am < 4; ++am) {
            const int ai = am >> 1, mb = (am & 1) * 2;
            f32x4 bv[2][2][2];
#pragma unroll
            for (int mm = 0; mm < 2; ++mm)
#pragma unroll
                for (int bj = 0; bj < 2; ++bj) {
                    const float* bp = baseP + (size_t)(row0 + ai * 128 + (mb + mm) * 16) * DM + col0 + bj * 128;
                    bv[mm][bj][0] = *(const f32x4*)bp; bv[mm][bj][1] = *(const f32x4*)(bp + 4);
                }
#pragma unroll
            for (int mm = 0; mm < 2; ++mm) {
                const int m = mb + mm;
                const int row = row0 + ai * 128 + m * 16;
                float q = 0.f;
#pragma unroll
                for (int bj = 0; bj < 2; ++bj) {
                    float* xp = X + (size_t)row * DM + col0 + bj * 128;
                    const f32x4 x0 = bv[mm][bj][0] + acc[ai][bj][m][0], x1 = bv[mm][bj][1] + acc[ai][bj][m][1];
                    if (!fin && X) { *(f32x4*)xp = x0; *(f32x4*)(xp + 4) = x1; }
                    if (gnext) {
                        const f32x4 y0 = x0 * gv[bj][0], y1 = x1 * gv[bj][1];
                        if (fin) { *(f32x4*)xp = y0; *(f32x4*)(xp + 4) = y1; }
                        else { u32x4 w4; w4.x = pk2(y0[0], y0[1]); w4.y = pk2(y0[2], y0[3]); w4.z = pk2(y1[0], y1[1]); w4.w = pk2(y1[2], y1[3]);
                               *(u32x4*)(XNo + (size_t)row * DM + col0 + bj * 128) = w4; }
                        q += ((x0[0] * x0[0] + x0[1] * x0[1]) + (x0[2] * x0[2] + x0[3] * x0[3])) + ((x1[0] * x1[0] + x1[1] * x1[1]) + (x1[2] * x1[2] + x1[3] * x1[3]));
                    }
                }
                if (gnext) { q += __shfl_xor(q, 16); q += __shfl_xor(q, 32); if (fq == 0) atomicAdd(RS + row, q); }
            }
        }
    }
};

struct EpiFin {
    static constexpr bool PERM = true, AFTER_DRAIN = false;
    const bf16_t* XNb; const float* g1; float* Y; const float* g; float* RS; unsigned* pcnt;
    DI void operator()(const f32x4 (&acc_)[2][2][4][2], const pg8::Unit& u, int wr, int wc, int fr, int fq) const {
        f32x4 (&acc)[2][2][4][2] = const_cast<f32x4 (&)[2][2][4][2]>(acc_);
        const int row0 = u.pm * 256 + wr * 64 + fr;
        const int col0 = u.pn * 256 + wc * 32 + 8 * fq;
        f32x4 gv[2][2];
#pragma unroll
        for (int bj = 0; bj < 2; ++bj) { gv[bj][0] = *(const f32x4*)(g + col0 + bj * 128); gv[bj][1] = *(const f32x4*)(g + col0 + bj * 128 + 4); }
        f32x4 rg[2][2];
#pragma unroll
        for (int bj = 0; bj < 2; ++bj)
#pragma unroll
            for (int hh = 0; hh < 2; ++hh) { const f32x4 t = *(const f32x4*)(g1 + col0 + bj * 128 + 4 * hh);
                rg[bj][hh] = (f32x4){__builtin_amdgcn_rcpf(t[0]), __builtin_amdgcn_rcpf(t[1]), __builtin_amdgcn_rcpf(t[2]), __builtin_amdgcn_rcpf(t[3])}; }
#pragma unroll
        for (int am = 0; am < 4; ++am) {
            const int ai = am >> 1, mb = (am & 1) * 2;
            u32x4 bw[2][2];
#pragma unroll
            for (int mm = 0; mm < 2; ++mm)
#pragma unroll
                for (int bj = 0; bj < 2; ++bj) bw[mm][bj] = *(const u32x4*)(XNb + (size_t)(row0 + ai * 128 + (mb + mm) * 16) * DM + col0 + bj * 128);
#pragma unroll
            for (int mm = 0; mm < 2; ++mm) {
                const int m = mb + mm;
                float q = 0.f;
#pragma unroll
                for (int bj = 0; bj < 2; ++bj) {
                    const u32x4 wv = bw[mm][bj];
                    const f32x4 x0 = (f32x4){bflo(wv.x), bfhi(wv.x), bflo(wv.y), bfhi(wv.y)} * rg[bj][0] + acc[ai][bj][m][0];
                    const f32x4 x1 = (f32x4){bflo(wv.z), bfhi(wv.z), bflo(wv.w), bfhi(wv.w)} * rg[bj][1] + acc[ai][bj][m][1];
                    q += ((x0[0] * x0[0] + x0[1] * x0[1]) + (x0[2] * x0[2] + x0[3] * x0[3])) + ((x1[0] * x1[0] + x1[1] * x1[1]) + (x1[2] * x1[2] + x1[3] * x1[3]));
                    acc[ai][bj][m][0] = x0 * gv[bj][0]; acc[ai][bj][m][1] = x1 * gv[bj][1];
                }
                q += __shfl_xor(q, 16); q += __shfl_xor(q, 32);
                if (fq == 0) atomicAdd(RS + row0 + ai * 128 + m * 16, q);
            }
        }
        asm volatile("s_waitcnt vmcnt(0)" ::: "memory");
        unsigned* pc = pcnt + 64 * u.pm;
        if (fr == 0 && fq == 0) __hip_atomic_fetch_add(pc, 1u, __ATOMIC_RELAXED, __HIP_MEMORY_SCOPE_AGENT);
        { unsigned sp = 0; while (__hip_atomic_load(pc, __ATOMIC_RELAXED, __HIP_MEMORY_SCOPE_AGENT) < 128u) { __builtin_amdgcn_s_sleep(2); if (++sp > (1u << 21)) break; } }
        asm volatile("" ::: "memory");
#pragma unroll
        for (int ai = 0; ai < 2; ++ai)
#pragma unroll
            for (int m = 0; m < 4; ++m) {
                const int row = row0 + ai * 128 + m * 16;
                const float rs = __builtin_amdgcn_rsqf(__hip_atomic_load(RS + row, __ATOMIC_RELAXED, __HIP_MEMORY_SCOPE_AGENT) * (1.f / DM) + EPS);
#pragma unroll
                for (int bj = 0; bj < 2; ++bj) {
                    float* yp = Y + (size_t)row * DM + col0 + bj * 128;
                    *(f32x4*)yp = acc[ai][bj][m][0] * rs; *(f32x4*)(yp + 4) = acc[ai][bj][m][1] * rs;
                }
            }
    }
};
struct EpiInMem {
    static constexpr bool PERM = true, AFTER_DRAIN = false;
    EpiIn ein; EpiMem emem;
    DI void operator()(const f32x4 (&acc)[2][2][4][2], const pg8::Unit& u, int wr, int wc, int fr, int fq) const { if (u.sel) emem(acc, u, wr, wc, fr, fq); else ein(acc, u, wr, wc, fr, fq); }
};
struct InMemOrder {
    pg8::StaticOrder so; int nin;
    DI void init(int G_, int c_) { so.init(TP, NP, G_, c_); nin = (TP / 256) * (NP / 256); }
    DI bool next(int i, pg8::Unit& u) const {
        const long L = (long)i * so.G + so.c;
        if (L < nin) return so.next(i, u);
        const int idx = (int)(L - nin); if (idx >= 32) return false;
        u.pm = idx & 3; u.pn = idx >> 2; u.sel = 1; return true;
    }
    DI void a_ready(const pg8::Unit&) const {}
    DI void done(const pg8::Unit&) const {}
};
struct PanelOrder {
    int G, c;
    DI void init(int G_, int c_) { G = G_; c = c_; }
    DI bool next(int i, pg8::Unit& u) const {
        if (G == 256) { if (i >= 2) return false; const int xcd = c & 7, r = c >> 3, j = xcd >> 1, hx = xcd & 1; u.pm = 16 * i + 4 * j + (r & 3); u.pn = 8 * hx + (r >> 2); u.sel = 0; return true; }
        const long L = (long)i * G + c; if (L >= 512) return false; u.pm = (int)(L >> 4); u.pn = (int)(L & 15); u.sel = 0; return true;
    }
    DI void a_ready(const pg8::Unit&) const {}
    DI void done(const pg8::Unit&) const {}
};

DI int dst_row_in(int s) {
    if (s < 2304) { const int d = s & 63; return (s & ~63) + 2 * (d & 31) + (d >> 5); }
    if (s < 6656) return s;
    if (s < 6672) return 9728 + (s - 6656);
    return s - 16;
}
struct TrItem { const float* W; bf16_t* WT; int N, item, inmap; };
DI void tr_load(const TrItem& t, f32x4 (&tv)[16], int lane) {
    const int nblk = (t.N + 63) >> 6, kb = t.item / nblk, nb = t.item - kb * nblk, k0 = 64 * kb, n0 = 64 * nb;
    const int cl = (lane & 15) * 4, rl = lane >> 4;
    const bool okc = (n0 + cl) < t.N;
#pragma unroll
    for (int i = 0; i < 16; ++i) { tv[i] = (f32x4){0.f, 0.f, 0.f, 0.f}; if (okc) tv[i] = *(const f32x4*)(t.W + (size_t)(k0 + 4 * i + rl) * t.N + n0 + cl); }
}
DI void tr_store(const TrItem& t, const f32x4 (&tv)[16], float* scr, int lane) {
    const int nblk = (t.N + 63) >> 6, kb = t.item / nblk, nb = t.item - kb * nblk, k0 = 64 * kb, n0 = 64 * nb;
    const int cl = (lane & 15) * 4, rl = lane >> 4;
#pragma unroll
    for (int i = 0; i < 16; ++i) { float* s = scr + (4 * i + rl) * 65 + cl; s[0] = tv[i][0]; s[1] = tv[i][1]; s[2] = tv[i][2]; s[3] = tv[i][3]; }
    asm volatile("s_waitcnt lgkmcnt(0)" ::: "memory");
    const int c = lane & 7;
#pragma unroll
    for (int j = 0; j < 8; ++j) {
        const int n = (lane >> 3) + 8 * j;
        if (n0 + n < t.N) {
            const float* s = scr + (8 * c) * 65 + n;
            u32x4 o; o.x = pk2(s[0], s[65]); o.y = pk2(s[2 * 65], s[3 * 65]); o.z = pk2(s[4 * 65], s[5 * 65]); o.w = pk2(s[6 * 65], s[7 * 65]);
            const int row = t.inmap ? dst_row_in(n0 + n) : (n0 + n);
            *(u32x4*)(t.WT + (size_t)row * DM + k0 + 8 * c) = o;
        }
    }
    asm volatile("s_waitcnt lgkmcnt(0)" ::: "memory");
}
DI void norm_row(const float* src, const float* g, bf16_t* dstb, float* dstf, int lane) {
    const f32x4* xr = (const f32x4*)src + lane;
    f32x4 v[16]; float s = 0.f;
#pragma unroll
    for (int j = 0; j < 16; ++j) { v[j] = xr[64 * j]; s += (v[j][0] * v[j][0] + v[j][1] * v[j][1]) + (v[j][2] * v[j][2] + v[j][3] * v[j][3]); }
    const f32x4* gr = (const f32x4*)g + lane;
    f32x4 gv[16];
#pragma unroll
    for (int j = 0; j < 16; ++j) gv[j] = gr[64 * j];
    const float rs = __builtin_amdgcn_rsqf(wave_sum(s) * (1.f / DM) + EPS);
#pragma unroll
    for (int j = 0; j < 16; ++j) {
        const f32x4 o = v[j] * rs * gv[j];
        if (dstb) { u32x2 w2; w2.x = pk2(o[0], o[1]); w2.y = pk2(o[2], o[3]); *((u32x2*)dstb + lane + 64 * j) = w2; }
        else *((f32x4*)dstf + lane + 64 * j) = o;
    }
}
DI void norm_row2(const float* src, const float* g0, const float* g1, bf16_t* d0, bf16_t* d1, int lane) {
    const f32x4* xr = (const f32x4*)src + lane;
    f32x4 v[16]; float s = 0.f;
#pragma unroll
    for (int j = 0; j < 16; ++j) { v[j] = xr[64 * j]; s += (v[j][0] * v[j][0] + v[j][1] * v[j][1]) + (v[j][2] * v[j][2] + v[j][3] * v[j][3]); }
    const float rs = __builtin_amdgcn_rsqf(wave_sum(s) * (1.f / DM) + EPS);
#pragma unroll
    for (int h = 0; h < 2; ++h) {
        const f32x4* gr = (const f32x4*)(h ? g1 : g0) + lane;
        f32x4 gv[16];
#pragma unroll
        for (int j = 0; j < 16; ++j) gv[j] = gr[64 * j];
#pragma unroll
        for (int j = 0; j < 16; ++j) { const f32x4 o = v[j] * rs * gv[j]; u32x2 w2; w2.x = pk2(o[0], o[1]); w2.y = pk2(o[2], o[3]); *((u32x2*)(h ? d1 : d0) + lane + 64 * j) = w2; }
    }
}
DI void rope_entry(float* tab, int idx) {
    const int pi = idx >> 5, i = idx & 31;
    const double pos = pi < SEQ ? (double)pi : 16384.0;
    double inv = 1.0; for (int k = 0; k < i; ++k) inv *= 0.7498942093324559;
    const double a = pos * inv;
    const double q = __builtin_rint(a * 0.6366197723675814);
    const double r = (a - q * 1.5707963267948966) - q * 6.123233995736766e-17;
    const int qi = ((int)q) & 3;
    const double r2 = r * r;
    const double sn = r * (1.0 + r2 * (-1.0 / 6 + r2 * (1.0 / 120 + r2 * (-1.0 / 5040 + r2 * (1.0 / 362880 + r2 * (-1.0 / 39916800 + r2 * (1.0 / 6227020800.0)))))));
    const double cs = 1.0 + r2 * (-0.5 + r2 * (1.0 / 24 + r2 * (-1.0 / 720 + r2 * (1.0 / 40320 + r2 * (-1.0 / 3628800 + r2 * (1.0 / 479001600 + r2 * (-1.0 / 87178291200.0)))))));
    double c, s;
    if (qi == 0) { c = cs; s = sn; } else if (qi == 1) { c = -sn; s = cs; } else if (qi == 2) { c = -cs; s = -sn; } else { c = sn; s = -cs; }
    tab[2 * idx] = (float)c; tab[2 * idx + 1] = (float)s;
}

DI void swa_unit(unsigned char* lds, const bf16_t* H, bf16_t* Gt, const float* sinks, int u, int tid) {
    const int kvh = u & 3, blk = (u >> 2) & 15, b = u >> 6;
    bf16_t* Ks = (bf16_t*)lds;
    bf16_t* Vt = (bf16_t*)(lds + 39168);
    const int lane = tid & 63, w = tid >> 6, c16 = lane & 15, quad = lane >> 4;
    const int qi = w * 16 + c16;
    const size_t qrow = (size_t)(b * SEQ + blk * 128 + qi);
    bf16x8 qc0 = *(const bf16x8*)(H + qrow * NP + C_SQ + kvh * 512 + quad * 8), qc1 = *(const bf16x8*)(H + qrow * NP + C_SQ + kvh * 512 + 32 + quad * 8);
    __syncthreads();
    {
        const int r = tid >> 1, half = tid & 1;
        const int tok = blk * 128 - 128 + r;
        u32x4 kv[4], vv[4];
#pragma unroll
        for (int i = 0; i < 4; ++i) { kv[i] = (u32x4){0u, 0u, 0u, 0u}; vv[i] = (u32x4){0u, 0u, 0u, 0u}; }
        if (tok >= 0) {
            const bf16_t* src = H + (size_t)(b * SEQ + tok) * NP + kvh * 64 + half * 32;
#pragma unroll
            for (int i = 0; i < 4; ++i) { kv[i] = *(const u32x4*)(src + C_SK + i * 8); vv[i] = *(const u32x4*)(src + C_SV + i * 8); }
        }
#pragma unroll
        for (int i = 0; i < 4; ++i) *(u32x4*)(Ks + r * 72 + half * 32 + i * 8) = kv[i];
#pragma unroll
        for (int i = 0; i < 4; ++i)
#pragma unroll
            for (int e = 0; e < 4; ++e) {
                const unsigned wv = vv[i][e];
                Vt[(half * 32 + i * 8 + 2 * e) * 280 + r] = (bf16_t)(wv & 0xffffu);
                Vt[(half * 32 + i * 8 + 2 * e + 1) * 280 + r] = (bf16_t)(wv >> 16);
            }
        for (int i = tid; i < 576; i += 512) ((unsigned*)(Ks + 256 * 72))[i] = 0u;
        { const int d = tid >> 3, cc = 256 + (tid & 7) * 2; *(unsigned*)(Vt + d * 280 + cc) = 0u; }
    }
    __syncthreads();
    for (int g = 0; g < 8; ++g) {
        const int head = kvh * 8 + g;
        bf16x8 qf[2]; qf[0] = qc0; qf[1] = qc1;
        { const int hn = kvh * 8 + (g < 7 ? g + 1 : g);
          qc0 = *(const bf16x8*)(H + qrow * NP + C_SQ + hn * 64 + quad * 8); qc1 = *(const bf16x8*)(H + qrow * NP + C_SQ + hn * 64 + 32 + quad * 8); }
        u32x2 gwv[4];
#pragma unroll
        for (int mt = 0; mt < 4; ++mt) gwv[mt] = *(const u32x2*)(H + qrow * NP + C_SG + head * 64 + mt * 16 + quad * 4);
        f32x4 s[10];
#pragma unroll
        for (int i = 0; i < 10; ++i) {
            s[i] = (f32x4){0.f, 0.f, 0.f, 0.f};
            const bf16_t* kp = Ks + ((w + i) * 16 + c16) * 72 + quad * 8;
#pragma unroll
            for (int ks = 0; ks < 2; ++ks) s[i] = mfma16(*(const bf16x8*)(kp + ks * 32), qf[ks], s[i]);
        }
        const float sink = sinks[head];
        float mx = sink;
        int qiv = qi + 128 - (w * 16 + quad * 4); asm volatile("" : "+v"(qiv));
        const int lowlim = blk > 0 ? 0 : 128;
#pragma unroll
        for (int i = 0; i < 10; ++i)
#pragma unroll
            for (int j = 0; j < 4; ++j) {
                const int sj = (w + i) * 16 + quad * 4 + j, diff = qiv - (i * 16 + j);
                const bool valid = (unsigned)diff < 128u && sj >= lowlim;
                s[i][j] = valid ? s[i][j] : -INFINITY;
                mx = fmaxf(mx, s[i][j]);
            }
        mx = fmaxf(mx, __shfl_xor(mx, 16)); mx = fmaxf(mx, __shfl_xor(mx, 32));
        float sum = 0.f;
#pragma unroll
        for (int i = 0; i < 10; ++i)
#pragma unroll
            for (int j = 0; j < 4; ++j) { const float p = __expf(s[i][j] - mx); s[i][j] = p; sum += p; }
        sum += __shfl_xor(sum, 16); sum += __shfl_xor(sum, 32);
        sum += __expf(sink - mx);
        const float inv = __builtin_amdgcn_rcpf(sum);
        f32x4 o[4];
#pragma unroll
        for (int mt = 0; mt < 4; ++mt) o[mt] = (f32x4){0.f, 0.f, 0.f, 0.f};
#pragma unroll
        for (int st = 0; st < 5; ++st) {
            const bf16x8 pb = pack8(s[2 * st], s[2 * st + 1]);
#pragma unroll
            for (int mt = 0; mt < 4; ++mt) {
                const bf16_t* vp = Vt + (mt * 16 + c16) * 280 + (w + 2 * st) * 16 + quad * 4;
                o[mt] = mfma16(cat4(*(const s16x4*)vp, *(const s16x4*)(vp + 16)), pb, o[mt]);
            }
        }
#pragma unroll
        for (int mt = 0; mt < 4; ++mt) {
            const int d = mt * 16 + quad * 4;
            const u32x2 gw = gwv[mt];
            u32x2 ow;
            ow.x = pk2(o[mt][0] * inv * silu(bflo(gw.x)), o[mt][1] * inv * silu(bfhi(gw.x)));
            ow.y = pk2(o[mt][2] * inv * silu(bflo(gw.y)), o[mt][3] * inv * silu(bfhi(gw.y)));
            *(u32x2*)(Gt + qrow * DM + head * 64 + d) = ow;
        }
    }
}

DI void mem_unit(unsigned char* lds, const bf16_t* H, const bf16_t* MKV, bf16_t* Gt, int u, int tid) {
    const int qt = u & 15, h = (u >> 4) & 3, b = u >> 6;
    bf16_t* Kc = (bf16_t*)lds;
    bf16_t* Vc = (bf16_t*)(lds + 33792);
    const int lane = tid & 63, w = tid >> 6, c16 = lane & 15, quad = lane >> 4;
    const size_t qrow = (size_t)(b * SEQ + qt * 128 + w * 16 + c16);
    const int srow = tid >> 3, seg = tid & 7;
    const bf16_t* ksrc = MKV + (size_t)(b * 256 + srow) * 2048 + h * 256 + seg * 32;
    const bf16_t* vsrc = MKV + (size_t)(b * 256 + lane) * 2048 + 1024 + h * 256 + w * 32;
    u32x4 pre[4];
#pragma unroll
    for (int i = 0; i < 4; ++i) pre[i] = *(const u32x4*)(ksrc + i * 8);
    bf16x8 qf[8];
#pragma unroll
    for (int ks = 0; ks < 8; ++ks) qf[ks] = *(const bf16x8*)(H + qrow * NP + C_MQ + h * 256 + ks * 32 + quad * 8);
    f32x4 s[16];
#pragma unroll
    for (int c = 0; c < 4; ++c) {
        __syncthreads();
#pragma unroll
        for (int i = 0; i < 4; ++i) *(u32x4*)(Kc + srow * 264 + seg * 32 + i * 8) = pre[i];
        if (c < 3) {
#pragma unroll
            for (int i = 0; i < 4; ++i) pre[i] = *(const u32x4*)(ksrc + (size_t)(c + 1) * 64 * 2048 + i * 8);
        } else {
#pragma unroll
            for (int i = 0; i < 4; ++i) pre[i] = *(const u32x4*)(vsrc + i * 8);
        }
        __syncthreads();
#pragma unroll
        for (int kt = 0; kt < 4; ++kt) {
            f32x4 a = {0.f, 0.f, 0.f, 0.f};
            const bf16_t* kp = Kc + (kt * 16 + c16) * 264 + quad * 8;
#pragma unroll
            for (int ks = 0; ks < 8; ++ks) a = mfma16(*(const bf16x8*)(kp + ks * 32), qf[ks], a);
            s[c * 4 + kt] = a;
        }
    }
    u32x2 gwv[16];
#pragma unroll
    for (int mt = 0; mt < 16; ++mt) gwv[mt] = *(const u32x2*)(H + qrow * NP + C_MG + h * 256 + mt * 16 + quad * 4);
    float mx = -INFINITY;
#pragma unroll
    for (int i = 0; i < 16; ++i)
#pragma unroll
        for (int j = 0; j < 4; ++j) mx = fmaxf(mx, s[i][j]);
    mx = fmaxf(mx, __shfl_xor(mx, 16)); mx = fmaxf(mx, __shfl_xor(mx, 32));
    float sum = 0.f;
#pragma unroll
    for (int i = 0; i < 16; ++i)
#pragma unroll
        for (int j = 0; j < 4; ++j) { const float p = __expf(s[i][j] - mx); s[i][j] = p; sum += p; }
    sum += __shfl_xor(sum, 16); sum += __shfl_xor(sum, 32);
    const float inv = __builtin_amdgcn_rcpf(sum);
    bf16x8 pbv[8];
#pragma unroll
    for (int i = 0; i < 8; ++i) pbv[i] = pack8(s[2 * i], s[2 * i + 1]);
    f32x4 o[16];
#pragma unroll
    for (int mt = 0; mt < 16; ++mt) o[mt] = (f32x4){0.f, 0.f, 0.f, 0.f};
#pragma unroll
    for (int c = 0; c < 4; ++c) {
        __syncthreads();
#pragma unroll
        for (int i = 0; i < 4; ++i)
#pragma unroll
            for (int e = 0; e < 4; ++e) {
                Vc[(w * 32 + i * 8 + 2 * e) * 72 + lane] = (bf16_t)(pre[i][e] & 0xffffu);
                Vc[(w * 32 + i * 8 + 2 * e + 1) * 72 + lane] = (bf16_t)(pre[i][e] >> 16);
            }
        if (c < 3) {
#pragma unroll
            for (int i = 0; i < 4; ++i) pre[i] = *(const u32x4*)(vsrc + (size_t)(c + 1) * 64 * 2048 + i * 8);
        }
        __syncthreads();
#pragma unroll
        for (int st = 0; st < 2; ++st) {
            const bf16x8 pb = pbv[c * 2 + st];
#pragma unroll
            for (int mt = 0; mt < 16; ++mt) {
                const bf16_t* vp = Vc + (mt * 16 + c16) * 72 + (2 * st) * 16 + quad * 4;
                o[mt] = mfma16(cat4(*(const s16x4*)vp, *(const s16x4*)(vp + 16)), pb, o[mt]);
            }
        }
    }
#pragma unroll
    for (int mt = 0; mt < 16; ++mt) {
        const int d = mt * 16 + quad * 4;
        const u32x2 gw = gwv[mt];
        u32x2 ow;
        ow.x = pk2(o[mt][0] * inv * silu(bflo(gw.x)), o[mt][1] * inv * silu(bfhi(gw.x)));
        ow.y = pk2(o[mt][2] * inv * silu(bflo(gw.y)), o[mt][3] * inv * silu(bfhi(gw.y)));
        *(u32x2*)(Gt + qrow * DM + 3072 + h * 256 + d) = ow;
    }
}

DI float logsig16(float z) { return (fminf(z, 0.f) - __logf(1.f + __expf(-fabsf(z)))) * 0.0625f; }

constexpr int GI_QS = 0, GI_AS = 17408, GI_VT = 26624, GI_BYTES = 63488, GI_IMG = 26624;
DI void gla_prep_unit(unsigned char* lds, const bf16_t* H, const float* wg, const float* bg, u32x2* Ug, float* EBLg, unsigned char* IMG, int u, int tid) {
    const int ch = u & 31, h = (u >> 5) & 3, b = u >> 7;
    bf16_t* Qs = (bf16_t*)(lds + GI_QS);
    bf16_t* As = (bf16_t*)(lds + GI_AS);
    bf16_t* Vt = (bf16_t*)(lds + GI_VT);
    bf16_t* Ks = (bf16_t*)(lds + 63488);
    bf16_t* Kt = (bf16_t*)(lds + 80896);
    float* LR = (float*)(lds + 99328);
    float* WgL = (float*)(lds + 103424);
    float* GT = (float*)(lds + 111616);
    const int lane = tid & 63, w = tid >> 6, c16 = lane & 15, quad = lane >> 4;
    const size_t row0 = (size_t)(b * SEQ + ch * 64);
    __syncthreads();
    { const int i = tid >> 3, r2 = (tid & 7) * 2; const unsigned wv = *(const unsigned*)(H + (row0 + i) * NP + C_LR + r2); LR[i * 16 + r2] = bflo(wv); LR[i * 16 + r2 + 1] = bfhi(wv); }
#pragma unroll
    for (int r = 0; r < 4; ++r) { const int idx = tid + 512 * r; WgL[idx] = wg[(idx >> 7) * 512 + h * 128 + (idx & 127)]; }
    const int dk = tid & 127, ig = tid >> 7;
    const float bgc = bg[h * 128 + dk];
    unsigned short qr[16], kr[16];
#pragma unroll
    for (int ii = 0; ii < 16; ++ii) { const bf16_t* src = H + (row0 + ig * 16 + ii) * NP + h * 128 + dk; qr[ii] = src[C_GQ]; kr[ii] = src[C_GK]; }
    u32x4 vpre[4];
#pragma unroll
    for (int i = 0; i < 4; ++i) vpre[i] = *(const u32x4*)(H + (row0 + lane) * NP + C_GV + h * 256 + w * 32 + i * 8);
    __syncthreads();
    float bb[16];
    {
        float wgc[16];
#pragma unroll
        for (int r = 0; r < 16; ++r) wgc[r] = WgL[r * 128 + dk];
        float run = 0.f;
#pragma unroll
        for (int ii = 0; ii < 16; ++ii) {
            const int i = ig * 16 + ii;
            float z = bgc;
#pragma unroll
            for (int r = 0; r < 16; ++r) z += LR[i * 16 + r] * wgc[r];
            run += logsig16(z); bb[ii] = run;
        }
        GT[ig * 128 + dk] = run;
    }
#pragma unroll
    for (int i = 0; i < 4; ++i)
#pragma unroll
        for (int e = 0; e < 4; ++e) {
            Vt[(w * 32 + i * 8 + 2 * e) * 72 + lane] = (bf16_t)(vpre[i][e] & 0xffffu);
            Vt[(w * 32 + i * 8 + 2 * e + 1) * 72 + lane] = (bf16_t)(vpre[i][e] >> 16);
        }
    __syncthreads();
    {
        const float t0 = GT[dk], t1 = GT[128 + dk], t2 = GT[256 + dk], t3 = GT[384 + dk];
        const float bl = (t0 + t1) + (t2 + t3);
        const float off = (ig > 0 ? t0 : 0.f) + (ig > 1 ? t1 : 0.f) + (ig > 2 ? t2 : 0.f);
#pragma unroll
        for (int ii = 0; ii < 16; ++ii) {
            const int i = ig * 16 + ii;
            const float bv = off + bb[ii], q = bf2f(qr[ii]), k = bf2f(kr[ii]);
            Qs[i * 136 + dk] = f2bf(q * __expf(bv));
            Ks[i * 136 + dk] = f2bf(k * __expf(-bv));
            Kt[dk * 72 + i] = f2bf(k * __expf(bl - bv));
        }
        if (ig == 0) EBLg[(size_t)u * 128 + dk] = __expf(bl);
    }
    __syncthreads();
#pragma unroll
    for (int tt = 0; tt < 2; ++tt) {
        const int t = 2 * w + tt, mt = t >> 2, nt = t & 3;
        f32x4 a = {0.f, 0.f, 0.f, 0.f};
        if (nt <= mt) {
#pragma unroll
            for (int ks = 0; ks < 4; ++ks)
                a = mfma16(*(const bf16x8*)(Qs + (mt * 16 + c16) * 136 + ks * 32 + quad * 8), *(const bf16x8*)(Ks + (nt * 16 + c16) * 136 + ks * 32 + quad * 8), a);
        }
#pragma unroll
        for (int jj = 0; jj < 4; ++jj) { const int i = mt * 16 + quad * 4 + jj, j = nt * 16 + c16; As[i * 72 + j] = f2bf(j <= i ? a[jj] : 0.f); }
    }
#pragma unroll
    for (int kt = 0; kt < 8; ++kt) {
        f32x4 s0 = {0.f, 0.f, 0.f, 0.f}, s1 = {0.f, 0.f, 0.f, 0.f};
#pragma unroll
        for (int ks = 0; ks < 2; ++ks) {
            const bf16x8 a = *(const bf16x8*)(Kt + (kt * 16 + c16) * 72 + ks * 32 + quad * 8);
            s0 = mfma16(a, *(const bf16x8*)(Vt + ((2 * w) * 16 + c16) * 72 + ks * 32 + quad * 8), s0);
            s1 = mfma16(a, *(const bf16x8*)(Vt + ((2 * w + 1) * 16 + c16) * 72 + ks * 32 + quad * 8), s1);
        }
        { u32x2 p0, p1; p0.x = pk2(s0[0], s0[1]); p0.y = pk2(s0[2], s0[3]); p1.x = pk2(s1[0], s1[1]); p1.y = pk2(s1[2], s1[3]);
          Ug[((size_t)(u * 8 + kt) * 16 + 2 * w) * 64 + lane] = p0; Ug[((size_t)(u * 8 + kt) * 16 + 2 * w + 1) * 64 + lane] = p1; }
    }
    __syncthreads();
    { u32x4* dst = (u32x4*)(IMG + (size_t)u * GI_IMG); const u32x4* srcl = (const u32x4*)lds;
      for (int i = tid; i < GI_IMG / 16; i += 512) dst[i] = srcl[i]; }
}
DI void gla_scan_task(const u32x2* Ug, const float* EBLg, u32x2* SF2, float* state_out, int t, int lane) {
    const int nt = t & 15, kt = (t >> 4) & 7, bh = t >> 7;
    const int c16 = lane & 15, quad = lane >> 4;
    f32x4 s0 = {0.f, 0.f, 0.f, 0.f};
    for (int n0 = 0; n0 < 32; n0 += 16) {
        f32x4 ev[16], uv[16];
#pragma unroll
        for (int j = 0; j < 16; ++j) {
            const size_t u = (size_t)bh * 32 + n0 + j;
            ev[j] = *(const f32x4*)(EBLg + u * 128 + kt * 16 + quad * 4);
            { const u32x2 p = Ug[((u * 8 + kt) * 16 + nt) * 64 + lane]; uv[j] = (f32x4){bflo(p.x), bfhi(p.x), bflo(p.y), bfhi(p.y)}; }
        }
#pragma unroll
        for (int j = 0; j < 16; ++j) {
            const size_t u = (size_t)bh * 32 + n0 + j;
            u32x2 pk; pk.x = pk2(s0[0], s0[1]); pk.y = pk2(s0[2], s0[3]);
            if (n0 + j > 0) SF2[(((u * 4 + (kt >> 1)) * 16 + nt) * 64 + lane) * 2 + (kt & 1)] = pk;
            s0 = s0 * ev[j] + uv[j];
        }
    }
#pragma unroll
    for (int jj = 0; jj < 4; ++jj) state_out[((size_t)bh * 128 + kt * 16 + quad * 4 + jj) * 256 + nt * 16 + c16] = s0[jj];
}
DI void gla_out_unit(unsigned char* lds, const bf16_t* H, bf16_t* Gt, const float* gng, const u32x4* SF, const unsigned char* IMG, int u, int tid) {
    const int ch = u & 31, h = (u >> 5) & 3, b = u >> 7;
    const bf16_t* Qs = (const bf16_t*)(lds + GI_QS);
    const bf16_t* As = (const bf16_t*)(lds + GI_AS);
    const bf16_t* Vt = (const bf16_t*)(lds + GI_VT);
    float* SSw = (float*)(lds + GI_BYTES);
    const int lane = tid & 63, w = tid >> 6, c16 = lane & 15, quad = lane >> 4;
    const size_t row0 = (size_t)(b * SEQ + ch * 64);
    unsigned short gtv[4][4][2];
#pragma unroll
    for (int mt = 0; mt < 4; ++mt)
#pragma unroll
        for (int jj = 0; jj < 4; ++jj)
#pragma unroll
            for (int n = 0; n < 2; ++n) gtv[mt][jj][n] = H[(row0 + mt * 16 + quad * 4 + jj) * NP + C_GG + h * 256 + (2 * w + n) * 16 + c16];
    u32x4 vpre[4];
#pragma unroll
    for (int i = 0; i < 4; ++i) vpre[i] = *(const u32x4*)(H + (row0 + lane) * NP + C_GV + h * 256 + w * 32 + i * 8);
    __syncthreads();
    { const u32x4* src = (const u32x4*)(IMG + (size_t)u * GI_IMG); u32x4* dstl = (u32x4*)lds;
      for (int i = tid; i < GI_IMG / 16; i += 512) dstl[i] = src[i]; }
    { bf16_t* Vw = (bf16_t*)(lds + GI_VT);
#pragma unroll
      for (int i = 0; i < 4; ++i)
#pragma unroll
          for (int e = 0; e < 4; ++e) {
              Vw[(w * 32 + i * 8 + 2 * e) * 72 + lane] = (bf16_t)(vpre[i][e] & 0xffffu);
              Vw[(w * 32 + i * 8 + 2 * e + 1) * 72 + lane] = (bf16_t)(vpre[i][e] >> 16);
          } }
    bf16x8 sb[4][2];
#pragma unroll
    for (int ks = 0; ks < 4; ++ks)
#pragma unroll
        for (int n = 0; n < 2; ++n) sb[ks][n] = ch == 0 ? (bf16x8){0, 0, 0, 0, 0, 0, 0, 0} : __builtin_bit_cast(bf16x8, SF[(((size_t)u * 4 + ks) * 16 + 2 * w + n) * 64 + lane]);
    __syncthreads();
    f32x4 o[4][2];
#pragma unroll
    for (int mt = 0; mt < 4; ++mt) {
        o[mt][0] = (f32x4){0.f, 0.f, 0.f, 0.f}; o[mt][1] = (f32x4){0.f, 0.f, 0.f, 0.f};
        if (ch != 0) {
#pragma unroll
        for (int ks = 0; ks < 4; ++ks) {
            const bf16_t* qp = Qs + (mt * 16 + c16) * 136 + (2 * ks) * 16 + quad * 4;
            const bf16x8 a = cat4(*(const s16x4*)qp, *(const s16x4*)(qp + 16));
            o[mt][0] = mfma16(a, sb[ks][0], o[mt][0]); o[mt][1] = mfma16(a, sb[ks][1], o[mt][1]);
        }
        }
#pragma unroll
        for (int ks = 0; ks < 2; ++ks) {
            const bf16x8 a = *(const bf16x8*)(As + (mt * 16 + c16) * 72 + ks * 32 + quad * 8);
#pragma unroll
            for (int n = 0; n < 2; ++n) o[mt][n] = mfma16(a, *(const bf16x8*)(Vt + ((2 * w + n) * 16 + c16) * 72 + ks * 32 + quad * 8), o[mt][n]);
        }
    }
#pragma unroll
    for (int mt = 0; mt < 4; ++mt)
#pragma unroll
        for (int jj = 0; jj < 4; ++jj) {
            float q = o[mt][0][jj] * o[mt][0][jj] + o[mt][1][jj] * o[mt][1][jj];
            q += __shfl_xor(q, 1); q += __shfl_xor(q, 2); q += __shfl_xor(q, 4); q += __shfl_xor(q, 8);
            if (c16 == 0) SSw[w * 64 + mt * 16 + quad * 4 + jj] = q;
        }
    __syncthreads();
    const float gn0 = gng[h * 256 + (2 * w) * 16 + c16], gn1 = gng[h * 256 + (2 * w + 1) * 16 + c16];
#pragma unroll
    for (int mt = 0; mt < 4; ++mt)
#pragma unroll
        for (int jj = 0; jj < 4; ++jj) {
            const int i = mt * 16 + quad * 4 + jj;
            float tot = 0.f;
#pragma unroll
            for (int ww = 0; ww < 8; ++ww) tot += SSw[ww * 64 + i];
            const float rs = __builtin_amdgcn_rsqf(tot * (1.f / 256.f) + EPS);
#pragma unroll
            for (int n = 0; n < 2; ++n) {
                const int dv = (2 * w + n) * 16 + c16;
                const float gate = bf2f(gtv[mt][jj][n]);
                Gt[(row0 + i) * DM + 2048 + h * 256 + dv] = f2bf(o[mt][n][jj] * rs * (n ? gn1 : gn0) * silu(gate));
            }
        }
}

DI void s_swa_unit(unsigned char* lds, const bf16_t* H, bf16_t* Gt, const float* ck, const float* cv, const float* sinks, float* kout, float* vout, int u, int tid) {
    const int kvh = u & 3, b = u >> 2;
    float* Kl = (float*)lds;
    float* Vl = Kl + 128 * 65;
    float* Ql = Vl + 128 * 64;
    float* Pl = Ql + 512;
    const int lane = tid & 63, w = tid >> 6;
    const bf16_t* hrow = H + (size_t)(TP + b) * NP;
    __syncthreads();
    {
        float kr[16], vr[16];
#pragma unroll
        for (int i = 0; i < 16; ++i) {
            const int kk = w + 8 * i;
            if (kk < 127) { const size_t o = ((size_t)(b * 128 + kk + 1) * 4 + kvh) * 64 + lane; kr[i] = ck[o]; vr[i] = cv[o]; }
            else { const int p = 2 * (lane & 31) + (lane >> 5); kr[i] = bf2f(hrow[C_SK + kvh * 64 + p]); vr[i] = bf2f(hrow[C_SV + kvh * 64 + lane]); }
        }
#pragma unroll
        for (int i = 0; i < 16; ++i) {
            const int kk = w + 8 * i;
            if (kk < 127) { const size_t oo = ((size_t)(b * 128 + kk) * 4 + kvh) * 64 + lane; kout[oo] = kr[i]; vout[oo] = vr[i]; }
            Kl[kk * 65 + lane] = kr[i]; Vl[kk * 64 + lane] = vr[i];
        }
    }
    { const int p = 2 * (lane & 31) + (lane >> 5); Ql[w * 64 + lane] = bf2f(hrow[C_SQ + (kvh * 8 + w) * 64 + p]); }
    __syncthreads();
    float s0 = 0.f, s1 = 0.f;
    for (int d = 0; d < 64; ++d) { const float qd = Ql[w * 64 + d]; s0 += qd * Kl[lane * 65 + d]; s1 += qd * Kl[(lane + 64) * 65 + d]; }
    const float sink = sinks[kvh * 8 + w];
    const float mx = fmaxf(wave_max(fmaxf(s0, s1)), sink);
    const float p0 = __expf(s0 - mx), p1 = __expf(s1 - mx);
    const float inv = __builtin_amdgcn_rcpf(wave_sum(p0 + p1) + __expf(sink - mx));
    Pl[w * 128 + lane] = p0 * inv; Pl[w * 128 + lane + 64] = p1 * inv;
    __syncthreads();
    float o = 0.f;
    for (int kk = 0; kk < 128; ++kk) o += Pl[w * 128 + kk] * Vl[kk * 64 + lane];
    const float gate = bf2f(hrow[C_SG + (kvh * 8 + w) * 64 + lane]);
    Gt[(size_t)(TP + b) * DM + (kvh * 8 + w) * 64 + lane] = f2bf(o * silu(gate));
}
DI void s_gla_unit(unsigned char* lds, const bf16_t* H, bf16_t* Gt, const float* wg, const float* bg, const float* gng, const float* sin_, float* sout, int u, int tid) {
    const int h = u & 3, b = u >> 2;
    float* gE = (float*)lds; float* qv = gE + 128; float* kv = qv + 128; float* vv = kv + 128; float* Osum = vv + 256; float* red = Osum + 2048;
    const int lane = tid & 63, w = tid >> 6;
    const bf16_t* hrow = H + (size_t)(TP + b) * NP;
    __syncthreads();
    if (tid < 128) {
        float z = bg[h * 128 + tid];
#pragma unroll
        for (int r = 0; r < 16; ++r) z += bf2f(hrow[C_LR + r]) * wg[r * 512 + h * 128 + tid];
        gE[tid] = __expf(logsig16(z)); qv[tid] = bf2f(hrow[C_GQ + h * 128 + tid]); kv[tid] = bf2f(hrow[C_GK + h * 128 + tid]);
    }
    if (tid < 256) vv[tid] = bf2f(hrow[C_GV + h * 256 + tid]);
    __syncthreads();
    const float* S0 = sin_ + (size_t)(b * 4 + h) * 128 * 256;
    float* S1 = sout + (size_t)(b * 4 + h) * 128 * 256;
    const f32x4 v4 = *(const f32x4*)(vv + lane * 4);
    f32x4 oacc = {0.f, 0.f, 0.f, 0.f};
    f32x4 srow[16];
#pragma unroll
    for (int r = 0; r < 16; ++r) srow[r] = *(const f32x4*)(S0 + (16 * w + r) * 256 + lane * 4);
#pragma unroll
    for (int r = 0; r < 16; ++r) {
        const int dk = 16 * w + r;
        const f32x4 sv = srow[r] * gE[dk] + v4 * kv[dk];
        *(f32x4*)(S1 + dk * 256 + lane * 4) = sv;
        oacc += sv * qv[dk];
    }
    *(f32x4*)(Osum + w * 256 + lane * 4) = oacc;
    __syncthreads();
    float o = 0.f;
    if (tid < 256) {
#pragma unroll
        for (int ww = 0; ww < 8; ++ww) o += Osum[ww * 256 + tid];
        const float q = wave_sum(o * o);
        if (lane == 0) red[w] = q;
    }
    __syncthreads();
    if (tid < 256) {
        const float rs = __builtin_amdgcn_rsqf((red[0] + red[1] + red[2] + red[3]) * (1.f / 256.f) + EPS);
        const float gate = bf2f(hrow[C_GG + h * 256 + tid]);
        Gt[(size_t)(TP + b) * DM + 2048 + h * 256 + tid] = f2bf(o * rs * gng[h * 256 + tid] * silu(gate));
    }
}
DI void s_mem_unit(unsigned char* lds, const bf16_t* H, bf16_t* Gt, const float* mk, const float* mv, int u, int tid) {
    const int h = u & 3, b = u >> 2;
    float* Sc = (float*)lds; float* Osum = Sc + 256;
    const int lane = tid & 63, w = tid >> 6;
    const bf16_t* hrow = H + (size_t)(TP + b) * NP;
    __syncthreads();
    const u32x2 qw = *(const u32x2*)(hrow + C_MQ + h * 256 + lane * 4);
    const f32x4 q4 = {bflo(qw.x), bfhi(qw.x), bflo(qw.y), bfhi(qw.y)};
    const float* kbase = mk + ((size_t)(b * 256 + w * 32) * 4 + h) * 256 + lane * 4;
    const float* vbase = mv + ((size_t)(b * 256 + w * 32) * 4 + h) * 256 + lane * 4;
    float vals[32];
    {
        f32x4 kr[32];
#pragma unroll
        for (int r = 0; r < 32; ++r) kr[r] = *(const f32x4*)(kbase + (size_t)r * 1024);
#pragma unroll
        for (int r = 0; r < 32; ++r) vals[r] = (q4[0] * kr[r][0] + q4[1] * kr[r][1]) + (q4[2] * kr[r][2] + q4[3] * kr[r][3]);
    }
#pragma unroll
    for (int i = 0; i < 16; ++i) { const bool hi = lane & 32; const float send = hi ? vals[i] : vals[i + 16], keep = hi ? vals[i + 16] : vals[i]; vals[i] = keep + __shfl_xor(send, 32); }
#pragma unroll
    for (int i = 0; i < 8; ++i) { const bool hi = lane & 16; const float send = hi ? vals[i] : vals[i + 8], keep = hi ? vals[i + 8] : vals[i]; vals[i] = keep + __shfl_xor(send, 16); }
#pragma unroll
    for (int i = 0; i < 4; ++i) { const bool hi = lane & 8; const float send = hi ? vals[i] : vals[i + 4], keep = hi ? vals[i + 4] : vals[i]; vals[i] = keep + __shfl_xor(send, 8); }
#pragma unroll
    for (int i = 0; i < 2; ++i) { const bool hi = lane & 4; const float send = hi ? vals[i] : vals[i + 2], keep = hi ? vals[i + 2] : vals[i]; vals[i] = keep + __shfl_xor(send, 4); }
    { const bool hi = lane & 2; const float send = hi ? vals[0] : vals[1], keep = hi ? vals[1] : vals[0]; vals[0] = keep + __shfl_xor(send, 2); }
    vals[0] += __shfl_xor(vals[0], 1);
    if ((lane & 1) == 0) Sc[w * 32 + (lane >> 1)] = vals[0];
    f32x4 vr[32];
#pragma unroll
    for (int r = 0; r < 32; ++r) vr[r] = *(const f32x4*)(vbase + (size_t)r * 1024);
    __syncthreads();
    const f32x4 sv = *(const f32x4*)(Sc + lane * 4);
    const float mx = wave_max(fmaxf(fmaxf(sv[0], sv[1]), fmaxf(sv[2], sv[3])));
    const float inv = __builtin_amdgcn_rcpf(wave_sum((__expf(sv[0] - mx) + __expf(sv[1] - mx)) + (__expf(sv[2] - mx) + __expf(sv[3] - mx))));
    f32x4 oacc = {0.f, 0.f, 0.f, 0.f};
#pragma unroll
    for (int r = 0; r < 32; ++r) oacc += vr[r] * (__expf(Sc[w * 32 + r] - mx) * inv);
    *(f32x4*)(Osum + w * 256 + lane * 4) = oacc;
    __syncthreads();
    if (tid < 256) {
        float o = 0.f;
#pragma unroll
        for (int ww = 0; ww < 8; ++ww) o += Osum[ww * 256 + tid];
        const float gate = bf2f(hrow[C_MG + h * 256 + tid]);
        Gt[(size_t)(TP + b) * DM + 3072 + h * 256 + tid] = f2bf(o * silu(gate));
    }
}

#ifndef MK_ONE_LAUNCH
#define MK_ONE_LAUNCH 1
#endif
constexpr int N_PHASES = 12;
#ifndef PH_MASK
#define PH_MASK 0xFFFF
#endif
#define PHM(b) ((PH_MASK >> (b)) & 1)
#ifndef DUP_PH
#define DUP_PH 0
#endif
#ifndef DUP_SEL
#define DUP_SEL 0
#endif
#ifndef DUP_SYNC
#define DUP_SYNC 0
#endif
#ifndef DUP_P0
#define DUP_P0 0
#endif

__global__ void __launch_bounds__(512, 2) mk_fwd(Args a) {
    extern __shared__ __attribute__((aligned(16))) unsigned char lds[];
    const int G = gridDim.x, bid = blockIdx.x;
    unsigned char* ws = a.ws;
    bf16_t* XN = (bf16_t*)(ws + WS_XN);
    bf16_t* Hb = (bf16_t*)(ws + WS_H);
    bf16_t* Gt = (bf16_t*)(ws + WS_G);
    float* X1 = (float*)(ws + WS_X1);
    float* rope = (float*)(ws + WS_ROPE);
    float* RSq = (float*)(ws + WS_RS);
    const float* x_prompt = a.in[0]; const float* mem_prompt = a.in[1]; const float* x_sample = a.in[2];
    volatile LAS unsigned* bst = (volatile LAS unsigned*)((LAS unsigned char*)lds + (LDS_BYTES - 16));
    if (threadIdx.x < 4) bst[threadIdx.x] = 0u;
    __syncthreads();
    XcdBarrier xbar = xcd_barrier_post((unsigned*)(ws + WS_CTL), bst);
#define GRID_SYNC() xcd_barrier(xbar)

    if (a.ph_lo == 0) {
        int tidp = threadIdx.x; asm volatile("" : "+v"(tidp));
        const int tid = tidp, lane = tid & 63, wave = __builtin_amdgcn_readfirstlane(tid >> 6);
        for (int rep0 = 0; rep0 <= DUP_P0; ++rep0) if (PHM(0)) {
            float* scr = (float*)(lds + wave * 16640);
            const int gw = bid * 8 + wave, NGW = G * 8;
            constexpr int I_IN = 64 * 153, I_OUT = 64 * 64, I_MEM = 64 * 32, I_L = I_IN + I_OUT + I_MEM;
            auto mk_item = [&](int it) {
                TrItem t; const int l = it / I_L; int r = it - l * I_L;
                if (r < I_IN) { t.W = a.in[9] + (size_t)l * DM * NIN; t.WT = (bf16_t*)(ws + WS_WIN + l * SZ_WIN); t.N = NIN; t.item = r; t.inmap = 1; return t; }
                r -= I_IN;
                if (r < I_OUT) { t.W = a.in[16] + (size_t)l * DM * DM; t.WT = (bf16_t*)(ws + WS_WOUT + l * SZ_WOUT); t.N = DM; t.item = r; t.inmap = 0; return t; }
                r -= I_OUT;
                t.W = a.in[15] + (size_t)l * DM * 2048; t.WT = (bf16_t*)(ws + WS_WMEM + l * SZ_WMEM); t.N = 2048; t.item = r; t.inmap = 0; return t;
            };
            {
                int it = gw;
                f32x4 tv[16];
                TrItem cur = mk_item(it < 2 * I_L ? it : 0);
                if (it < 2 * I_L) tr_load(cur, tv, lane);
                while (it < 2 * I_L) {
                    const int nx = it + NGW;
                    f32x4 tn[16]; TrItem nxt = cur;
                    if (nx < 2 * I_L) { nxt = mk_item(nx); tr_load(nxt, tn, lane); }
                    tr_store(cur, tv, scr, lane);
#pragma unroll
                    for (int i = 0; i < 16; ++i) tv[i] = tn[i];
                    cur = nxt; it = nx;
                }
            }
            for (int i = bid * 512 + tid; i < 2 * 240 * 512; i += G * 512) {
                const int l = i / (240 * 512), r = i - l * 240 * 512;
                ((u32x4*)(ws + WS_WIN + l * SZ_WIN + (size_t)NIN * DM * 2))[r] = (u32x4){0u, 0u, 0u, 0u};
            }
            for (int i = bid * 512 + tid; i < 2049 * 32; i += G * 512) rope_entry(rope, i);
            for (int i = bid * 512 + tid; i < 2 * MR; i += G * 512) RSq[i] = 0.f;
            for (int m = gw; m < MREAL + 1024; m += NGW) {
                if (m < TP) norm_row(x_prompt + (size_t)m * DM, a.in[8], XN + (size_t)m * DM, nullptr, lane);
                else if (m < MREAL) norm_row(x_sample + (size_t)(m - TP) * DM, a.in[8], XN + (size_t)m * DM, nullptr, lane);
                else { const int r = m - MREAL;
                       norm_row2(mem_prompt + (size_t)r * DM, a.in[14], a.in[14] + DM, (bf16_t*)(ws + WS_MN) + (size_t)r * DM, (bf16_t*)(ws + WS_MN + SZ_MN) + (size_t)r * DM, lane); }
            }
        }
        if (a.ph_hi > 1) GRID_SYNC();
        if (a.ph_hi > 1000) cg::this_grid().sync();
    }
    for (int ph = a.ph_lo < 1 ? 1 : a.ph_lo, rep = 0; ph < a.ph_hi; ) {
        int tidp = threadIdx.x; asm volatile("" : "+v"(tidp));
        const int tid = tidp, lane = tid & 63, wave = __builtin_amdgcn_readfirstlane(tid >> 6);
        {
            const int l = (ph - 1) / 6, k = (ph - 1) % 6;
            if (k == 5 && l == 0) { ++ph; continue; }
            if (k == 0) {
                if (PHM(1)) {
                    pg8::Gemm g{XN, (const bf16_t*)(ws + WS_WIN + l * SZ_WIN), TP, NP, DM, (const bf16_t*)(ws + WS_MN + l * SZ_MN), (const bf16_t*)(ws + WS_WMEM + l * SZ_WMEM)};
                    InMemOrder S; S.init(G, bid);
                    EpiInMem E{EpiIn{Hb, rope, a.out + O_KP + (size_t)l * 131072, a.out + O_VP + (size_t)l * 131072, l == 0 ? nullptr : RSq},
                               EpiMem{(bf16_t*)(ws + WS_MKV + l * SZ_MKV), a.out + O_MKP + (size_t)l * 1048576, a.out + O_MVP + (size_t)l * 1048576}};
                    pg8::gemm_phase<EpiInMem, InMemOrder, true, true>((PG8_LAS unsigned char*)lds, g, S, E);
                }
            } else if (k >= 1 && k <= 3) {
                const float* sinks = a.in[10] + l * 32;
                const float* wg = a.in[11] + l * 16 * 512; const float* bg = a.in[12] + l * 512; const float* gng = a.in[13] + l * 1024;
                const bf16_t* MKV = (const bf16_t*)(ws + WS_MKV + l * SZ_MKV);
                u32x2* Ug = (u32x2*)(ws + WS_U); u32x4* SF = (u32x4*)(ws + WS_SF); unsigned char* IMG = ws + WS_IMG; float* EBLg = (float*)(ws + WS_EBL);
                unsigned* qctr = (unsigned*)(ws + WS_CTL) + 8192 + (ph * 2 + rep) * 64;
#define QUEUE_LOOP_BEGIN(NTOT) { int u = bid; while (u < (NTOT)) { unsigned nxt_ = 0u; if (threadIdx.x == 0) nxt_ = atomicAdd(qctr, 1u) + (unsigned)G;
#define QUEUE_LOOP_END() __syncthreads(); if (threadIdx.x == 0) bst[2] = nxt_; __syncthreads(); u = (int)bst[2]; } }
                if (k == 1) {
                    EpiInS ES{Hb, rope, a.out + O_KS + (size_t)l * 1048576, a.out + O_VS + (size_t)l * 1048576, l == 0 ? nullptr : RSq};
                    QUEUE_LOOP_BEGIN(256 + 512 + (NIN + 31) / 32)
                        int tid = tidp; asm volatile("" : "+v"(tid));
                        if (u < 256) { if (PHM(4)) mem_unit(lds, Hb, MKV, Gt, u, tid); }
                        else if (u < 768) { if (PHM(3)) gla_prep_unit(lds, Hb, wg, bg, Ug, EBLg, IMG, u - 256, tid); }
                        else skinny_task<EpiInS>(lds, XN + (size_t)TP * DM, (const bf16_t*)(ws + WS_WIN + l * SZ_WIN), u - 768, tid, ES);
                    QUEUE_LOOP_END()
                } else if (k == 2) {
                    const bool dsel = (DUP_SEL != 0 && rep == 1 && ph == DUP_PH);
                    if (PHM(3) && (!dsel || DUP_SEL == 5)) { for (int tt = bid * 8 + wave; tt < 2048; tt += G * 8) gla_scan_task(Ug, EBLg, (u32x2*)SF, a.out + O_SP + (size_t)l * 524288, tt, lane); }
                    QUEUE_LOOP_BEGIN(256 + 384)
                        int tid = tidp; asm volatile("" : "+v"(tid));
                        const int utype = u < 256 ? 1 : (u < 384 ? 2 : (u < 512 ? 3 : 4));
                        if (dsel && utype != DUP_SEL) {}
                        else if (u < 256) { if (PHM(5)) swa_unit(lds, Hb, Gt, sinks, u, tid); }
                        else if (!PHM(6)) {}
                        else if (u < 384) s_mem_unit(lds, Hb, Gt, a.in[6] + (size_t)l * 8388608, a.in[7] + (size_t)l * 8388608, u - 256, tid);
                        else if (u < 512) s_gla_unit(lds, Hb, Gt, wg, bg, gng, a.in[5] + (size_t)l * 4194304, a.out + O_SS + (size_t)l * 4194304, u - 384, tid);
                        else s_swa_unit(lds, Hb, Gt, a.in[3] + (size_t)l * 1048576, a.in[4] + (size_t)l * 1048576, sinks, a.out + O_KS + (size_t)l * 1048576, a.out + O_VS + (size_t)l * 1048576, u - 512, tid);
                    QUEUE_LOOP_END()
                } else {
                    EpiResS ES{l == 0 ? x_sample : X1 + (size_t)TP * DM, (l == 0 ? X1 : a.out) + (size_t)TP * DM, l == 0 ? a.in[8] + DM : a.in[17], XN, RSq + l * MR, l};
                    QUEUE_LOOP_BEGIN(512 + DM / 32)
                        int tid = tidp; asm volatile("" : "+v"(tid));
                        if (u < 512) { if (PHM(3)) gla_out_unit(lds, Hb, Gt, gng, SF, IMG, u, tid); }
                        else skinny_task<EpiResS>(lds, Gt + (size_t)TP * DM, (const bf16_t*)(ws + WS_WOUT + l * SZ_WOUT), u - 512, tid, ES);
                    QUEUE_LOOP_END()
                }
                __syncthreads();
            } else if (k == 4) { if (PHM(7)) {
                pg8::Gemm g{Gt, (const bf16_t*)(ws + WS_WOUT + l * SZ_WOUT), TP, DM, DM, nullptr, nullptr};
                PanelOrder S; S.init(G, bid);
                if (l == 0) {
                    EpiRes E{x_prompt, nullptr, a.in[8] + DM, XN, RSq, 0};
                    pg8::gemm_phase<EpiRes, PanelOrder, true, true>((PG8_LAS unsigned char*)lds, g, S, E);
                } else {
                    if (bid < TS) {
                        const int row = TP + bid;
                        const float rs = __builtin_amdgcn_rsqf(RSq[MR + row] * (1.f / DM) + EPS);
                        f32x4* yr = (f32x4*)(a.out + (size_t)row * DM);
                        const f32x4 y0 = yr[tid], y1 = yr[tid + 512];
                        yr[tid] = y0 * rs; yr[tid + 512] = y1 * rs;
                    }
                    EpiFin E{XN, a.in[8] + DM, a.out, a.in[17], RSq + MR, (unsigned*)(ws + WS_CTL) + 4096};
                    pg8::gemm_phase<EpiFin, PanelOrder, true, true>((PG8_LAS unsigned char*)lds, g, S, E);
                }
            } } else if (PHM(8)) {
                const int gw = bid * 8 + wave, NGW = G * 8;
                for (int m = gw; m < MREAL; m += NGW) {
                    if (l == 0) norm_row(X1 + (size_t)m * DM, a.in[8] + DM, XN + (size_t)m * DM, nullptr, lane);
                    else {
                        const float rs = __builtin_amdgcn_rsqf(RSq[MR + m] * (1.f / DM) + EPS);
                        f32x4* yr = (f32x4*)(a.out + (size_t)m * DM) + lane;
                        f32x4 yv[16];
#pragma unroll
                        for (int j = 0; j < 16; ++j) yv[j] = yr[64 * j];
#pragma unroll
                        for (int j = 0; j < 16; ++j) yr[64 * j] = yv[j] * rs;
                    }
                }
            }
        }
        if (ph + 1 < a.ph_hi) { GRID_SYNC(); if (DUP_SYNC) { GRID_SYNC(); } }
        if (DUP_PH != 0 && ph == DUP_PH && rep == 0) rep = 1; else ++ph;
    }
}

extern "C" void kernel_launch(void* const* d_in, const int* in_sizes, int n_in, void* d_out, int out_size, void* d_ws, size_t ws_size, hipStream_t stream) {
    static int grid = 0;
    if (grid == 0) {
        if (n_in != 18 || (size_t)out_size != O_END || ws_size < WS_END) { fprintf(stderr, "kernel_launch: unexpected shapes (n_in %d, out %d, ws %zu); nothing launched\n", n_in, out_size, ws_size); grid = -1; return; }
        int dev = 0, cus = 0, per_cu = 0;
        if (hipGetDevice(&dev) != hipSuccess || hipDeviceGetAttribute(&cus, hipDeviceAttributeMultiprocessorCount, dev) != hipSuccess) { grid = -1; return; }
        if (hipFuncSetAttribute((const void*)mk_fwd, hipFuncAttributeMaxDynamicSharedMemorySize, LDS_BYTES) != hipSuccess) { fprintf(stderr, "kernel_launch: hipFuncSetAttribute failed\n"); grid = -1; return; }
        if (hipOccupancyMaxActiveBlocksPerMultiprocessor(&per_cu, (const void*)mk_fwd, 512, LDS_BYTES) != hipSuccess || per_cu < 1) { fprintf(stderr, "kernel_launch: occupancy query says %d\n", per_cu); per_cu = 1; }
        (void)hipGetLastError();
        grid = cus * per_cu;
    }
    if (grid < 0) return;
    if (hipMemsetAsync((char*)d_ws + WS_CTL, 0, CTL_BYTES, stream) != hipSuccess) { fprintf(stderr, "kernel_launch: memset failed\n"); return; }
    Args a{};
    for (int i = 0; i < 18; ++i) a.in[i] = (const float*)d_in[i];
    a.out = (float*)d_out; a.ws = (unsigned char*)d_ws;
#if MK_ONE_LAUNCH
    a.ph_lo = 0; a.ph_hi = N_PHASES;
    void* args[] = {&a};
    hipError_t e = hipLaunchCooperativeKernel((const void*)mk_fwd, dim3(grid), dim3(512), args, LDS_BYTES, stream);
    if (e != hipSuccess) fprintf(stderr, "kernel_launch: cooperative launch failed: %s (grid %d)\n", hipGetErrorString(e), grid);
#else
    for (int ph = 0; ph < N_PHASES; ++ph) {
        a.ph_lo = ph; a.ph_hi = ph + 1;
        hipLaunchKernelGGL(mk_fwd, dim3(grid), dim3(512), LDS_BYTES, stream, a);
    }
#endif
}
```
